# Optimizing an MI355X kernel written in HIP

```python
import jax
import jax.numpy as jnp
from jax import lax
import numpy as np

D_MODEL = 2048
BATCH = 8
SEQ = 2048
DEPTH = 1

MIX_WIDTH = D_MODEL
RWKV_WIDTH = MIX_WIDTH // 2
RWKV_HEAD = 64
RWKV_HEADS = RWKV_WIDTH // RWKV_HEAD
DECAY_LORA = 64
AAA_LORA = 64
GATE_LORA = 160
RWKV_LN_EPS = 64e-5
ATT_WIDTH = MIX_WIDTH - RWKV_WIDTH
ATT_HEAD = 128
ATT_HEADS = ATT_WIDTH // ATT_HEAD
ATT_KV_HEADS = 2
IDX_HEADS = 16
IDX_HEAD = 64
TOPK_MAX = 256
Q_BLOCK = 128
ROPE_THETA = 500000.0
N_MEM = 256
CROSS_HEADS = 4
CROSS_HEAD = 128
D_FF = 4 * D_MODEL
NORM_EPS = 1e-5

RWKV_SPLITS = (RWKV_WIDTH, RWKV_WIDTH, RWKV_WIDTH, DECAY_LORA, AAA_LORA, GATE_LORA)
ATT_SPLITS = (ATT_WIDTH, ATT_KV_HEADS * ATT_HEAD, ATT_KV_HEADS * ATT_HEAD,
              IDX_HEADS * IDX_HEAD, IDX_HEAD, IDX_HEADS)
RWKV_COLS = sum(RWKV_SPLITS)
ATT_COLS = sum(ATT_SPLITS)
IN_COLS = RWKV_COLS + ATT_COLS

kernel_name = 'hybrid_rwkv7_dsa_block'


def split_cols(t, sizes):
    out, start = [], 0
    for s in sizes:
        out.append(t[..., start:start + s])
        start += s
    return out


def rms_norm(x, g):
    xf = x.astype(jnp.float32)
    y = xf * lax.rsqrt(jnp.mean(xf * xf, axis=-1, keepdims=True) + NORM_EPS)
    return (y * g.astype(jnp.float32)).astype(x.dtype)


def partial_rope(x, pos):
    dh = x.shape[-1]
    rot = dh // 4
    half = rot // 2
    inv_freq = ROPE_THETA ** (-jnp.arange(half, dtype=jnp.float32) / half)
    ang = pos.astype(jnp.float32)[..., None] * inv_freq
    cos = jnp.cos(ang)[:, :, None, :]
    sin = jnp.sin(ang)[:, :, None, :]
    xr = x[..., :rot].astype(jnp.float32)
    x1, x2 = xr[..., :half], xr[..., half:]
    rotated = jnp.concatenate([x1 * cos - x2 * sin, x2 * cos + x1 * sin], axis=-1).astype(x.dtype)
    return jnp.concatenate([rotated, x[..., rot:]], axis=-1)


def rwkv7_group(p, mu, w0, w_decay_up, a0, a_up, g_up, k_k, k_a, r_k, lnx_w, lnx_b):
    B, S, _ = p.shape
    H, N = RWKV_HEADS, RWKV_HEAD
    f32 = jnp.float32
    prev = jnp.pad(p, ((0, 0), (1, 0), (0, 0)))[:, :-1]
    p = p + (prev - p) * mu
    r, k, v, xw, xa, xg = split_cols(p, RWKV_SPLITS)
    w = -jax.nn.softplus(-(w0 + jnp.tanh(xw) @ w_decay_up)) - 0.5
    decay = jnp.exp(-jnp.exp(w.astype(f32)))
    a = jax.nn.sigmoid(a0 + xa @ a_up)
    g = jax.nn.sigmoid(xg) @ g_up
    heads = lambda t: t.astype(f32).reshape(B, S, H, N)
    kk = heads(k * k_k)
    kk = kk / jnp.maximum(jnp.sqrt(jnp.sum(kk * kk, axis=-1, keepdims=True)), 1e-12)
    k = k * (1.0 + (a - 1.0) * k_a)
    r4, k4, v4, a4, w4 = heads(r), heads(k), heads(v), heads(a), decay.reshape(B, S, H, N)

    def step(state, inp):
        r_t, w_t, k_t, v_t, kk_t, a_t = inp
        sa = jnp.einsum('bhvk,bhk->bhv', state, -kk_t)
        state = (state * w_t[:, :, None, :]
                 + sa[..., None] * (kk_t * a_t)[:, :, None, :]
                 + v_t[..., None] * k_t[:, :, None, :])
        return state, jnp.einsum('bhvk,bhk->bhv', state, r_t)

    tm = lambda t: jnp.swapaxes(t, 0, 1)
    s0 = jnp.zeros((B, H, N, N), f32)
    _, y = lax.scan(step, s0, (tm(r4), tm(w4), tm(k4), tm(v4), tm(kk), tm(a4)))
    y = tm(y)
    mean = jnp.mean(y, axis=-1, keepdims=True)
    var = jnp.mean(jnp.square(y - mean), axis=-1, keepdims=True)
    yn = ((y - mean) * lax.rsqrt(var + RWKV_LN_EPS)).reshape(B, S, RWKV_WIDTH)
    yn = yn * lnx_w.astype(f32) + lnx_b.astype(f32)
    bonus = (jnp.sum(r4 * k4 * r_k.astype(f32), axis=-1, keepdims=True) * v4).reshape(B, S, RWKV_WIDTH)
    return ((yn + bonus) * g.astype(f32)).astype(p.dtype)


def dsa_group(p, pos):
    B, S, _ = p.shape
    f32 = jnp.float32
    G = ATT_HEADS // ATT_KV_HEADS
    q, k, v, qi, ki, wi = split_cols(p, ATT_SPLITS)
    q = partial_rope(q.reshape(B, S, ATT_HEADS, ATT_HEAD), pos)
    k = partial_rope(k.reshape(B, S, ATT_KV_HEADS, ATT_HEAD), pos)
    v = v.reshape(B, S, ATT_KV_HEADS, ATT_HEAD)
    qi = partial_rope(qi.reshape(B, S, IDX_HEADS, IDX_HEAD), pos)
    ki = partial_rope(ki.reshape(B, S, 1, IDX_HEAD), pos)[:, :, 0].astype(f32)
    wi = wi.astype(f32) * (IDX_HEADS ** -0.5 * IDX_HEAD ** -0.5)
    n_sel = min(TOPK_MAX, S // 4)
    nblk = S // Q_BLOCK
    key_pos = jnp.arange(S)
    gather = jax.vmap(lambda t, i: t[i])

    def to_blocks(t):
        return jnp.swapaxes(t.reshape((B, nblk, Q_BLOCK) + t.shape[2:]), 0, 1)

    def block(args):
        bi, qb, qib, wib = args
        q_pos = bi * Q_BLOCK + jnp.arange(Q_BLOCK)
        rel = jax.nn.relu(jnp.einsum('bqhd,bsd->bqhs', qib.astype(f32), ki))
        score = jnp.einsum('bqhs,bqh->bqs', rel, wib)
        causal = key_pos[None, :] <= q_pos[:, None]
        score = jnp.where(causal[None], score, -1e30)
        _, idx = lax.top_k(score, n_sel)
        valid = idx <= q_pos[None, :, None]
        kg = gather(k, idx)
        vg = gather(v, idx)
        qg = qb.reshape(B, Q_BLOCK, ATT_KV_HEADS, G, ATT_HEAD)
        s = jnp.einsum('bqhgd,bqkhd->bqhgk', qg, kg).astype(f32) * (ATT_HEAD ** -0.5)
        s = jnp.where(valid[:, :, None, None, :], s, -jnp.inf)
        prob = jax.nn.softmax(s, axis=-1).astype(vg.dtype)
        o = jnp.einsum('bqhgk,bqkhd->bqhgd', prob, vg)
        return o.reshape(B, Q_BLOCK, ATT_WIDTH)

    out = lax.map(block, (jnp.arange(nblk), to_blocks(q), to_blocks(qi), to_blocks(wi)))
    return jnp.swapaxes(out, 0, 1).reshape(B, S, ATT_WIDTH)


def memory_cross_attention(hn, mem_n, w_q, w_kv, w_o):
    B, S, _ = hn.shape
    M = mem_n.shape[1]
    q = (hn @ w_q).reshape(B, S, CROSS_HEADS, CROSS_HEAD)
    k, v = split_cols(mem_n @ w_kv, (CROSS_HEADS * CROSS_HEAD, CROSS_HEADS * CROSS_HEAD))
    k = k.reshape(B, M, CROSS_HEADS, CROSS_HEAD)
    v = v.reshape(B, M, CROSS_HEADS, CROSS_HEAD)
    s = jnp.einsum('bshd,bmhd->bhsm', q, k).astype(jnp.float32) * (CROSS_HEAD ** -0.5)
    prob = jax.nn.softmax(s, axis=-1).astype(v.dtype)
    o = jnp.einsum('bhsm,bmhd->bshd', prob, v).reshape(B, S, CROSS_HEADS * CROSS_HEAD)
    return o @ w_o


def setup_inputs(seed: int = 0) -> dict:
    key = jax.random.key(seed)
    ks = jax.random.split(key, 32)
    f32 = jnp.float32
    L = DEPTH

    def dense(k, fan_in, shape):
        return jax.random.normal(k, shape, f32) * fan_in ** -0.5

    def gain(k, shape):
        return 1.0 + 0.02 * jax.random.normal(k, shape, f32)

    return {
        'x': jax.random.normal(ks[0], (BATCH, SEQ, D_MODEL), f32),
        'mem': jax.random.normal(ks[1], (BATCH, N_MEM, D_MODEL), f32),
        'positions': jnp.tile(jnp.arange(SEQ, dtype=jnp.int32)[None, :], (BATCH, 1)),
        'norm_mix': gain(ks[2], (L, D_MODEL)),
        'w_in': dense(ks[3], D_MODEL, (L, D_MODEL, IN_COLS)),
        'rwkv_mu': jax.random.uniform(ks[4], (L, RWKV_COLS), f32),
        'w_decay0': jax.random.uniform(ks[5], (L, RWKV_WIDTH), f32, -6.0, 1.0),
        'w_decay_up': dense(ks[6], DECAY_LORA, (L, DECAY_LORA, RWKV_WIDTH)),
        'a0': 0.1 * jax.random.normal(ks[7], (L, RWKV_WIDTH), f32),
        'a_up': dense(ks[8], AAA_LORA, (L, AAA_LORA, RWKV_WIDTH)),
        'g_up': dense(ks[9], GATE_LORA, (L, GATE_LORA, RWKV_WIDTH)),
        'k_k': 0.85 + 0.05 * jax.random.normal(ks[10], (L, RWKV_WIDTH), f32),
        'k_a': 1.0 + 0.05 * jax.random.normal(ks[11], (L, RWKV_WIDTH), f32),
        'r_k': 0.1 * jax.random.normal(ks[12], (L, RWKV_HEADS, RWKV_HEAD), f32),
        'lnx_w': gain(ks[13], (L, RWKV_WIDTH)),
        'lnx_b': 0.02 * jax.random.normal(ks[14], (L, RWKV_WIDTH), f32),
        'w_mix_out': dense(ks[15], MIX_WIDTH, (L, MIX_WIDTH, D_MODEL)),
        'norm_cross': gain(ks[16], (L, D_MODEL)),
        'norm_mem': gain(ks[17], (L, D_MODEL)),
        'w_q_cross': dense(ks[18], D_MODEL, (L, D_MODEL, CROSS_HEADS * CROSS_HEAD)),
        'w_kv_cross': dense(ks[19], D_MODEL, (L, D_MODEL, 2 * CROSS_HEADS * CROSS_HEAD)),
        'w_o_cross': dense(ks[20], CROSS_HEADS * CROSS_HEAD, (L, CROSS_HEADS * CROSS_HEAD, D_MODEL)),
        'norm_mlp': gain(ks[21], (L, D_MODEL)),
        'w_up': dense(ks[22], D_MODEL, (L, D_MODEL, D_FF)),
        'w_down': dense(ks[23], D_FF, (L, D_FF, D_MODEL)),
        'norm_final': gain(ks[24], (D_MODEL,)),
    }


def reference(x, mem, positions, norm_mix, w_in, rwkv_mu, w_decay0, w_decay_up, a0, a_up, g_up,
              k_k, k_a, r_k, lnx_w, lnx_b, w_mix_out, norm_cross, norm_mem, w_q_cross,
              w_kv_cross, w_o_cross, norm_mlp, w_up, w_down, norm_final):
    h = x
    for l in range(DEPTH):
        p = rms_norm(h, norm_mix[l]) @ w_in[l]
        y_rwkv = rwkv7_group(p[..., :RWKV_COLS], rwkv_mu[l], w_decay0[l], w_decay_up[l], a0[l],
                             a_up[l], g_up[l], k_k[l], k_a[l], r_k[l], lnx_w[l], lnx_b[l])
        y_att = dsa_group(p[..., RWKV_COLS:], positions)
        h = h + jnp.concatenate([y_rwkv, y_att], axis=-1) @ w_mix_out[l]
        h = h + memory_cross_attention(rms_norm(h, norm_cross[l]), rms_norm(mem, norm_mem[l]),
                                       w_q_cross[l], w_kv_cross[l], w_o_cross[l])
        u = rms_norm(h, norm_mlp[l]) @ w_up[l]
        h = h + jnp.square(jax.nn.relu(u)) @ w_down[l]
    return rms_norm(h, norm_final)
```

```cpp
#include <hip/hip_runtime.h>
#include <hip/hip_cooperative_groups.h>
#include <cstdio>
#include <cstdint>
namespace pg8 {
#define PG8_LAS __attribute__((address_space(3)))
typedef unsigned short bf16_t;
typedef short bf16x8 __attribute__((ext_vector_type(8)));
typedef float f32x4 __attribute__((ext_vector_type(4)));
typedef unsigned u32x4 __attribute__((ext_vector_type(4)));
constexpr int BM = 256, BK = 64, HALF = 128, HTB = HALF * BK * 2  , STAGE_BYTES = 8 * HTB, NXCD = 8, WGM = 4;

__host__ __device__ __forceinline__ int lds_byte(int r, int c) { const int st = (r >> 4) * 2 + (c >> 5), rr = r & 15, cc = c & 31, ob = rr * 64 + cc * 2; return st * 1024 + (ob ^ (((ob >> 9) & 1) << 5)); }
__host__ __device__ __forceinline__ void stage_rc(int b, int& R, int& C) { const int st = b / 1024, sb = b % 1024, swz = sb ^ (((sb >> 9) & 1) << 5); R = (st >> 1) * 16 + swz / 64; C = (st & 1) * 32 + (swz % 64) / 2; }
__host__ __device__ __forceinline__ int perm32(int rho) { const int n = rho >> 4, i = rho & 15; return 8 * (i >> 2) + 4 * n + (i & 3); }

struct Unit { int pm, pn; };
struct Gemm { const bf16_t* A; const bf16_t* Bt; int M, N, K; int ld, kpn, kofs; };

struct StaticOrder {
    int nM, nN, nwg, G, c, wgm;
    __host__ __device__ void init(int M, int N, int G_, int c_, int wgm_ = WGM) { nM = M / BM; nN = N / BM; nwg = nM * nN; G = G_; c = c_; wgm = wgm_; }
    __host__ __device__ bool next(int i, Unit& u) const {
        const long L = (long)i * G + c; if (L >= nwg) return false;
        int wgid = (int)L; { const int q = nwg / NXCD, r = nwg % NXCD, xcd = wgid % NXCD, off = wgid / NXCD; wgid = (xcd < r ? xcd * (q + 1) : r * (q + 1) + (xcd - r) * q) + off; }
        const int nig = wgm * nN, gid = wgid / nig, fm = gid * wgm, gsz = (nM - fm) < wgm ? (nM - fm) : wgm;
        u.pm = fm + ((wgid % nig) % gsz); u.pn = (wgid % nig) / gsz; return true;
    }
    __device__ __forceinline__ void a_ready(const Unit&) const {}
    __device__ __forceinline__ void done(const Unit&) const {}
};

__device__ __forceinline__ unsigned cvt_pk_bf16(float lo, float hi) { unsigned r; asm volatile("v_cvt_pk_bf16_f32 %0, %1, %2" : "=v"(r) : "v"(lo), "v"(hi)); return r; }
typedef float f32x2 __attribute__((ext_vector_type(2)));
__device__ __forceinline__ float fq_sum(float v) {
    { auto rr = __builtin_amdgcn_permlane16_swap(__float_as_uint(v), __float_as_uint(v), false, false); v = __uint_as_float(rr[0]) + __uint_as_float(rr[1]); }
    { auto rr = __builtin_amdgcn_permlane32_swap(__float_as_uint(v), __float_as_uint(v), false, false); v = __uint_as_float(rr[0]) + __uint_as_float(rr[1]); }
    return v;
}
template <int ACT, bool ROWSCALE = false, bool NTS = false> struct EpiB16 {
    static constexpr bool PERM = true, AFTER_DRAIN = false;
    bf16_t* O; int ldc; const float* ss; float inv_n, eps;
    __device__ __forceinline__ void operator()(const f32x4 (&acc)[2][2][4][2], const Unit& u, int wr, int wc, int fr, int fq) const {
        const int row0 = u.pm * BM + wr * 64 + fr, col0 = u.pn * BM + wc * 32 + 8 * fq;
#pragma unroll
        for (int ai = 0; ai < 2; ++ai)
#pragma unroll
            for (int m = 0; m < 4; ++m) { const int row = row0 + ai * HALF + m * 16; bf16_t* rowp = O + (size_t)row * ldc + col0;
                float rs = 1.f; if (ROWSCALE) rs = __builtin_amdgcn_rsqf(ss[row] * inv_n + eps);
#pragma unroll
                for (int bj = 0; bj < 2; ++bj) { f32x4 v0 = acc[ai][bj][m][0], v1 = acc[ai][bj][m][1];
                    if (ROWSCALE) { v0 = v0 * rs; v1 = v1 * rs; }
                    if (ACT == 2) {
#pragma unroll
                        for (int i = 0; i < 4; ++i) { float a = fmaxf(v0[i], 0.f), b = fmaxf(v1[i], 0.f); v0[i] = a * a; v1[i] = b * b; } }
                    u32x4 w; w.x = cvt_pk_bf16(v0[0], v0[1]); w.y = cvt_pk_bf16(v0[2], v0[3]); w.z = cvt_pk_bf16(v1[0], v1[1]); w.w = cvt_pk_bf16(v1[2], v1[3]);
                    if (NTS) __builtin_nontemporal_store(w, (u32x4*)(rowp + bj * HALF)); else *(u32x4*)(rowp + bj * HALF) = w; } }
    }
};
struct EpiLora {
    static constexpr bool PERM = true, AFTER_DRAIN = false;
    bf16_t* O; int ldc; const float* w0; const float* a0;
    __device__ __forceinline__ void operator()(const f32x4 (&acc)[2][2][4][2], const Unit& u, int wr, int wc, int fr, int fq) const {
        const int row0 = u.pm * BM + wr * 64 + fr, col0 = u.pn * BM + wc * 32 + 8 * fq;
        const int type = u.pn >> 2, cb0 = (u.pn & 3) * BM + wc * 32 + 8 * fq;
        const float* bias = (type == 0) ? w0 : a0;
        const float sc = (type == 0) ? 0.6065306597126334f : 1.0f;
#pragma unroll
        for (int bj = 0; bj < 2; ++bj) {
            f32x4 b0 = {0.f, 0.f, 0.f, 0.f}, b1 = {0.f, 0.f, 0.f, 0.f};
            if (type < 2) { b0 = *(const f32x4*)(bias + cb0 + bj * HALF); b1 = *(const f32x4*)(bias + cb0 + bj * HALF + 4); }
#pragma unroll
            for (int ai = 0; ai < 2; ++ai)
#pragma unroll
                for (int m = 0; m < 4; ++m) { bf16_t* rowp = O + (size_t)(row0 + ai * HALF + m * 16) * ldc + col0;
                    f32x4 v0 = acc[ai][bj][m][0] + b0, v1 = acc[ai][bj][m][1] + b1;
                    if (type < 2) {
#pragma unroll
                        for (int i = 0; i < 4; ++i) { v0[i] = sc * __builtin_amdgcn_rcpf(1.f + __expf(-v0[i])); v1[i] = sc * __builtin_amdgcn_rcpf(1.f + __expf(-v1[i])); } }
                    u32x4 w; w.x = cvt_pk_bf16(v0[0], v0[1]); w.y = cvt_pk_bf16(v0[2], v0[3]); w.z = cvt_pk_bf16(v1[0], v1[1]); w.w = cvt_pk_bf16(v1[2], v1[3]);
                    __builtin_nontemporal_store(w, (u32x4*)(rowp + bj * HALF)); }
        }
    }
};
struct EpiResF32 {
    static constexpr bool PERM = false, AFTER_DRAIN = false;
    const float* res; float* out; int ldc;
    __device__ __forceinline__ void operator()(const f32x4 (&acc)[2][2][4][2], const Unit& u, int wr, int wc, int fr, int fq) const {
        const int row0 = u.pm * BM + wr * 64 + fr, col0 = u.pn * BM + wc * 32 + 4 * fq;
#pragma unroll
        for (int ai = 0; ai < 2; ++ai)
#pragma unroll
            for (int m = 0; m < 4; ++m) { const size_t off = (size_t)(row0 + ai * HALF + m * 16) * ldc + col0;
#pragma unroll
                for (int bj = 0; bj < 2; ++bj)
#pragma unroll
                    for (int n = 0; n < 2; ++n) { const f32x4 r = *(const f32x4*)(res + off + bj * HALF + n * 16); *(f32x4*)(out + off + bj * HALF + n * 16) = r + acc[ai][bj][m][n]; } }
    }
};
struct EpiResF32N {
    static constexpr bool PERM = false, AFTER_DRAIN = false;
    const float* res; float* out; int ldc; bf16_t* xn; float* ss;
    __device__ __forceinline__ void operator()(const f32x4 (&acc)[2][2][4][2], const Unit& u, int wr, int wc, int fr, int fq) const {
        const int row0 = u.pm * BM + wr * 64 + fr, col0 = u.pn * BM + wc * 32 + 4 * fq;
        typedef unsigned u32x2 __attribute__((ext_vector_type(2)));
#pragma unroll
        for (int ai = 0; ai < 2; ++ai)
#pragma unroll
            for (int m = 0; m < 4; ++m) { const int row = row0 + ai * HALF + m * 16; const size_t off = (size_t)row * ldc + col0; float sq = 0.f;
#pragma unroll
                for (int bj = 0; bj < 2; ++bj)
#pragma unroll
                    for (int n = 0; n < 2; ++n) { const f32x4 r = *(const f32x4*)(res + off + bj * HALF + n * 16); const f32x4 o = r + acc[ai][bj][m][n];
                        *(f32x4*)(out + off + bj * HALF + n * 16) = o; sq += (o[0] * o[0] + o[1] * o[1]) + (o[2] * o[2] + o[3] * o[3]);
                        u32x2 w; w.x = cvt_pk_bf16(o[0], o[1]); w.y = cvt_pk_bf16(o[2], o[3]); *(u32x2*)(xn + off + bj * HALF + n * 16) = w; }
                sq = fq_sum(sq);
                if (fq == 0) atomicAdd(ss + row, sq); }
    }
};
struct EpiNull {
    static constexpr bool PERM = true, AFTER_DRAIN = false;
    __device__ __forceinline__ void operator()(const f32x4 (&acc)[2][2][4][2], const Unit&, int, int, int, int) const {
#pragma unroll
        for (int ai = 0; ai < 2; ++ai)
#pragma unroll
            for (int bj = 0; bj < 2; ++bj)
#pragma unroll
                for (int m = 0; m < 4; ++m)
#pragma unroll
                    for (int n = 0; n < 2; ++n) asm volatile("" :: "v"(acc[ai][bj][m][n]));
    }
};
struct EpiResF32S {
    static constexpr bool PERM = false, AFTER_DRAIN = false;
    const float* res; float* out; int ldc; const float* ss; float inv_n, eps;
    __device__ __forceinline__ void operator()(const f32x4 (&acc)[2][2][4][2], const Unit& u, int wr, int wc, int fr, int fq) const {
        const int row0 = u.pm * BM + wr * 64 + fr, col0 = u.pn * BM + wc * 32 + 4 * fq;
#pragma unroll
        for (int ai = 0; ai < 2; ++ai)
#pragma unroll
            for (int m = 0; m < 4; ++m) { const int row = row0 + ai * HALF + m * 16; const size_t off = (size_t)row * ldc + col0;
                const float r2 = __builtin_amdgcn_rcpf(ss[row] * inv_n + eps);
#pragma unroll
                for (int bj = 0; bj < 2; ++bj)
#pragma unroll
                    for (int n = 0; n < 2; ++n) { const f32x4 r = *(const f32x4*)(res + off + bj * HALF + n * 16); *(f32x4*)(out + off + bj * HALF + n * 16) = r + acc[ai][bj][m][n] * r2; } }
    }
};
template <bool RES_BF16, bool SCALE> struct EpiResB {
    static constexpr bool PERM = true, AFTER_DRAIN = false;
    const float* resf; bf16_t* xn; int ldc; const float* ssin; float* ssout; float inv_n, eps;
    __device__ __forceinline__ void operator()(const f32x4 (&acc)[2][2][4][2], const Unit& u, int wr, int wc, int fr, int fq) const {
        const int row0 = u.pm * BM + wr * 64 + fr, col0 = u.pn * BM + wc * 32 + 8 * fq;
#pragma unroll
        for (int ai = 0; ai < 2; ++ai)
#pragma unroll
            for (int m = 0; m < 4; ++m) { const int row = row0 + ai * HALF + m * 16; const size_t off = (size_t)row * ldc + col0; float sq = 0.f;
                float s = 1.f; if (SCALE) s = __builtin_amdgcn_rcpf(ssin[row] * inv_n + eps);
#pragma unroll
                for (int bj = 0; bj < 2; ++bj) { f32x4 r0, r1;
                    if (RES_BF16) { const u32x4 w = *(const u32x4*)(xn + off + bj * HALF);
                        r0 = (f32x4){__builtin_bit_cast(float, w.x << 16), __builtin_bit_cast(float, w.x & 0xffff0000u), __builtin_bit_cast(float, w.y << 16), __builtin_bit_cast(float, w.y & 0xffff0000u)};
                        r1 = (f32x4){__builtin_bit_cast(float, w.z << 16), __builtin_bit_cast(float, w.z & 0xffff0000u), __builtin_bit_cast(float, w.w << 16), __builtin_bit_cast(float, w.w & 0xffff0000u)}; }
                    else { r0 = __builtin_nontemporal_load((const f32x4*)(resf + off + bj * HALF)); r1 = __builtin_nontemporal_load((const f32x4*)(resf + off + bj * HALF + 4)); }
                    const f32x4 o0 = r0 + acc[ai][bj][m][0] * s, o1 = r1 + acc[ai][bj][m][1] * s;
                    sq += (o0[0] * o0[0] + o0[1] * o0[1]) + (o0[2] * o0[2] + o0[3] * o0[3]) + (o1[0] * o1[0] + o1[1] * o1[1]) + (o1[2] * o1[2] + o1[3] * o1[3]);
                    u32x4 w; w.x = cvt_pk_bf16(o0[0], o0[1]); w.y = cvt_pk_bf16(o0[2], o0[3]); w.z = cvt_pk_bf16(o1[0], o1[1]); w.w = cvt_pk_bf16(o1[2], o1[3]);
                    *(u32x4*)(xn + off + bj * HALF) = w; }
                sq = fq_sum(sq);
                if (fq == 0) atomicAdd(ssout + row, sq);
                asm volatile("" ::: "memory"); }
    }
};
struct PanelOrder {
    int c;
    __device__ __forceinline__ bool next(int i, Unit& u) const { if (i >= 2 || c >= 256) return false; u.pm = 32 * i + (c & 31); u.pn = c >> 5; return true; }
    __device__ __forceinline__ void a_ready(const Unit&) const {}
    __device__ __forceinline__ void done(const Unit&) const {}
};
struct EpiFinal {
    static constexpr bool PERM = true, AFTER_DRAIN = false;
    const bf16_t* xn; int ldc; const float* ssin; float* ss3; unsigned* pcnt; const float* gain; float* out; float inv_n, eps; unsigned* tmo;
    __device__ __forceinline__ void operator()(const f32x4 (&acc_)[2][2][4][2], const Unit& u, int wr, int wc, int fr, int fq) const {
        f32x4 (&acc)[2][2][4][2] = const_cast<f32x4 (&)[2][2][4][2]>(acc_);
        const int row0 = u.pm * BM + wr * 64 + fr, col0 = u.pn * BM + wc * 32 + 8 * fq;
#pragma unroll
        for (int ai = 0; ai < 2; ++ai)
#pragma unroll
            for (int m = 0; m < 4; ++m) { const int row = row0 + ai * HALF + m * 16; const size_t off = (size_t)row * ldc + col0; float sq = 0.f;
                const float s = __builtin_amdgcn_rcpf(ssin[row] * inv_n + eps);
#pragma unroll
                for (int bj = 0; bj < 2; ++bj) { const u32x4 w = *(const u32x4*)(xn + off + bj * HALF);
                    const f32x4 r0 = {__builtin_bit_cast(float, w.x << 16), __builtin_bit_cast(float, w.x & 0xffff0000u), __builtin_bit_cast(float, w.y << 16), __builtin_bit_cast(float, w.y & 0xffff0000u)};
                    const f32x4 r1 = {__builtin_bit_cast(float, w.z << 16), __builtin_bit_cast(float, w.z & 0xffff0000u), __builtin_bit_cast(float, w.w << 16), __builtin_bit_cast(float, w.w & 0xffff0000u)};
                    const f32x4 o0 = r0 + acc[ai][bj][m][0] * s, o1 = r1 + acc[ai][bj][m][1] * s; acc[ai][bj][m][0] = o0; acc[ai][bj][m][1] = o1;
                    sq += (o0[0] * o0[0] + o0[1] * o0[1]) + (o0[2] * o0[2] + o0[3] * o0[3]) + (o1[0] * o1[0] + o1[1] * o1[1]) + (o1[2] * o1[2] + o1[3] * o1[3]); }
                sq = fq_sum(sq);
                if (fq == 0) atomicAdd(ss3 + row, sq);
                asm volatile("" ::: "memory"); }
        asm volatile("s_waitcnt vmcnt(0)" ::: "memory"); __syncthreads();
        unsigned* cw = pcnt + 64 * u.pm;
        if (wr == 0 && wc == 0) {
            if (fr == 0 && fq == 0) { __builtin_amdgcn_fence(__ATOMIC_RELEASE, "agent"); asm volatile("s_waitcnt vmcnt(0)" ::: "memory"); __hip_atomic_fetch_add(cw, 1u, __ATOMIC_RELAXED, __HIP_MEMORY_SCOPE_AGENT); }
            unsigned spins = 0;
            while ((unsigned)__builtin_amdgcn_readfirstlane(__hip_atomic_load(cw, __ATOMIC_RELAXED, __HIP_MEMORY_SCOPE_AGENT)) < 8u) {
                __builtin_amdgcn_s_sleep(2);
                if (++spins > (1u << 22)) { if (fr == 0 && fq == 0) __hip_atomic_store(tmo, 1u, __ATOMIC_RELAXED, __HIP_MEMORY_SCOPE_AGENT); break; } }
            __builtin_amdgcn_fence(__ATOMIC_ACQUIRE, "agent"); asm volatile("s_waitcnt vmcnt(0)" ::: "memory");
        }
        __syncthreads();
#pragma unroll
        for (int ai = 0; ai < 2; ++ai)
#pragma unroll
            for (int m = 0; m < 4; ++m) { const int row = row0 + ai * HALF + m * 16; const size_t off = (size_t)row * ldc + col0;
                const float rs = __builtin_amdgcn_rsqf(__hip_atomic_load(ss3 + row, __ATOMIC_RELAXED, __HIP_MEMORY_SCOPE_AGENT) * inv_n + eps);
#pragma unroll
                for (int bj = 0; bj < 2; ++bj) { const f32x4 g0 = *(const f32x4*)(gain + col0 + bj * HALF), g1 = *(const f32x4*)(gain + col0 + bj * HALF + 4);
                    __builtin_nontemporal_store(acc[ai][bj][m][0] * rs * g0, (f32x4*)(out + off + bj * HALF));
                    __builtin_nontemporal_store(acc[ai][bj][m][1] * rs * g1, (f32x4*)(out + off + bj * HALF + 4)); } }
    }
};
template <class Epi, class Sched, bool ALIGN_EPI = false, bool SP2 = false>
__device__ __forceinline__ void gemm_phase(PG8_LAS unsigned char* lds, const Gemm g, const Sched& S, const Epi& E, const int wv  ) {
    int tid_ = wv * 64 + (int)__builtin_amdgcn_mbcnt_hi(~0u, __builtin_amdgcn_mbcnt_lo(~0u, 0u)); asm volatile("" : "+v"(tid_));
    const int tid = tid_, wid = __builtin_amdgcn_readfirstlane(tid >> 6), lane = tid & 63, wr = wid >> 2, wc = wid & 3, fr = lane & 15, fq = lane >> 4;
    const int K = g.K, nt = K / BK, LD = g.ld ? g.ld : g.K;
    unsigned voffA[2], voffB[2];
#pragma unroll
    for (int i = 0; i < 2; ++i) { int R, C; stage_rc(tid * 16 + i * 8192, R, C); const int Rb = Epi::PERM ? ((R & ~31) + perm32(R & 31)) : R;
        voffA[i] = (unsigned)(R * LD + C) * 2u; voffB[i] = (unsigned)(Rb * LD + C) * 2u; }
    const size_t kstep = (size_t)(BK * 2);
    const size_t hstep = (size_t)HALF * LD * 2;
    const size_t tstep = 2 * hstep;
    const unsigned ldsw = (unsigned)wid * 1024u;
    const int aoff = lds_byte(wr * 64 + fr, fq * 8), boff = lds_byte(wc * 32 + fr, fq * 8);
#define PG8_SA(b, h) (((b) * 2 + (h)) * HTB)
#define PG8_SB(b, h) ((4 + (b) * 2 + (h)) * HTB)
#define PG8_STAGE(bufoff, gbase, voff) do { _Pragma("unroll") for (int _i = 0; _i < 2; ++_i) \
        __builtin_amdgcn_global_load_lds((const unsigned*)((const char*)(gbase) + (voff)[_i]), (PG8_LAS unsigned*)(lds + (bufoff) + ldsw + _i * 8192), 16, 0, 0); } while (0)
#define PG8_LDA(dst, b, h) do { _Pragma("unroll") for (int m = 0; m < 4; ++m) _Pragma("unroll") for (int k = 0; k < 2; ++k) dst[m][k] = *(const PG8_LAS bf16x8*)(lds + PG8_SA(b, h) + aoff + m * 2048 + k * 1024); } while (0)
#define PG8_LDB(dst, b, h) do { _Pragma("unroll") for (int n = 0; n < 2; ++n) _Pragma("unroll") for (int k = 0; k < 2; ++k) dst[n][k] = *(const PG8_LAS bf16x8*)(lds + PG8_SB(b, h) + boff + n * 2048 + k * 1024); } while (0)
#define PG8_MMA(ai, bj, At, Bt) do { __builtin_amdgcn_s_setprio(1); _Pragma("unroll") for (int m = 0; m < 4; ++m) _Pragma("unroll") for (int n = 0; n < 2; ++n) _Pragma("unroll") for (int k = 0; k < 2; ++k) \
        acc[ai][bj][m][n] = __builtin_amdgcn_mfma_f32_16x16x32_bf16(Bt[n][k], At[m][k], acc[ai][bj][m][n], 0, 0, 0); __builtin_amdgcn_s_setprio(0); } while (0)
#define PG8_WAIT_V(n) asm volatile("s_waitcnt vmcnt(" #n ")" ::: "memory")
#define PG8_WAIT_L(n) asm volatile("s_waitcnt lgkmcnt(" #n ")" ::: "memory")
#define PG8_BAR __builtin_amdgcn_s_barrier()
#define PG8_SCHED __builtin_amdgcn_sched_barrier(0)
    Unit cur, nxt; int ui = 0;
    if (!S.next(0, cur)) return;
    f32x4 acc[2][2][4][2];
#pragma unroll
    for (int a = 0; a < 2; ++a)
#pragma unroll
        for (int b = 0; b < 2; ++b)
#pragma unroll
            for (int m = 0; m < 4; ++m)
#pragma unroll
                for (int n = 0; n < 2; ++n) acc[a][b][m][n] = (f32x4){0.f, 0.f, 0.f, 0.f};
    bf16x8 At[4][2], B0[2][2], B1[2][2];
#define PG8_KOF(u) ((size_t)((g.kofs && (u).pn >= g.kpn) ? g.kofs : 0))
    const char* cA = (const char*)g.A + (size_t)cur.pm * tstep + PG8_KOF(cur); const char* cB = (const char*)g.Bt + (size_t)cur.pn * tstep + PG8_KOF(cur);
    S.a_ready(cur);
    if constexpr (SP2) {
        PG8_STAGE(PG8_SB(0, 0), cB, voffB); PG8_STAGE(PG8_SB(0, 1), cB + hstep, voffB); PG8_STAGE(PG8_SA(0, 0), cA, voffA); PG8_STAGE(PG8_SA(0, 1), cA + hstep, voffA);
        if (wr == 1) PG8_BAR;
        PG8_WAIT_V(2); PG8_BAR;
        PG8_STAGE(PG8_SB(1, 0), cB + kstep, voffB); PG8_STAGE(PG8_SA(1, 0), cA + kstep, voffA); PG8_STAGE(PG8_SB(1, 1), cB + hstep + kstep, voffB);
        PG8_WAIT_V(6); PG8_BAR;
    } else {
        PG8_STAGE(PG8_SB(0, 0), cB, voffB); PG8_STAGE(PG8_SA(0, 0), cA, voffA); PG8_STAGE(PG8_SB(0, 1), cB + hstep, voffB); PG8_STAGE(PG8_SA(0, 1), cA + hstep, voffA);
        if (wr == 1) PG8_BAR;
        PG8_WAIT_V(4); PG8_BAR;
        PG8_STAGE(PG8_SB(1, 0), cB + kstep, voffB); PG8_STAGE(PG8_SA(1, 0), cA + kstep, voffA); PG8_STAGE(PG8_SB(1, 1), cB + hstep + kstep, voffB);
        PG8_WAIT_V(6); PG8_BAR;
    }
    for (;;) {
        const bool has_next = S.next(ui + 1, nxt);
        const char* nA = has_next ? (const char*)g.A + (size_t)nxt.pm * tstep + PG8_KOF(nxt) : cA; const char* nB = has_next ? (const char*)g.Bt + (size_t)nxt.pn * tstep + PG8_KOF(nxt) : cB;
        for (int t = 0; t < nt; t += 2) {
            const bool last = (t == nt - 2);
            const char* a1 = cA + (size_t)(t + 1) * kstep;
            const char* a2 = last ? nA : cA + (size_t)(t + 2) * kstep; const char* b2 = last ? nB : cB + (size_t)(t + 2) * kstep;
            const char* a3 = a2 + kstep; const char* b3 = b2 + kstep;
            if (last && has_next) S.a_ready(nxt);
            if constexpr (SP2) {
            PG8_LDB(B0, 0, 0); PG8_LDB(B1, 0, 1); PG8_SCHED; PG8_LDA(At, 0, 0); PG8_STAGE(PG8_SA(1, 1), a1 + hstep, voffA);
            PG8_WAIT_V(8); PG8_WAIT_L(0); PG8_BAR; PG8_MMA(0, 0, At, B0); PG8_MMA(0, 1, At, B1); PG8_BAR; PG8_SCHED;
            PG8_LDA(At, 0, 1); PG8_STAGE(PG8_SB(0, 0), b2, voffB); PG8_STAGE(PG8_SB(0, 1), b2 + hstep, voffB); PG8_STAGE(PG8_SA(0, 0), a2, voffA);
            PG8_WAIT_V(8); PG8_WAIT_L(0); PG8_BAR; PG8_MMA(1, 0, At, B0); PG8_MMA(1, 1, At, B1); PG8_BAR; PG8_SCHED;
            PG8_LDB(B0, 1, 0); PG8_LDB(B1, 1, 1); PG8_SCHED; PG8_LDA(At, 1, 0); PG8_STAGE(PG8_SA(0, 1), a2 + hstep, voffA);
            PG8_WAIT_V(8); PG8_WAIT_L(0); PG8_BAR; PG8_MMA(0, 0, At, B0); PG8_MMA(0, 1, At, B1); PG8_BAR; PG8_SCHED;
            PG8_LDA(At, 1, 1); PG8_STAGE(PG8_SB(1, 0), b3, voffB); PG8_STAGE(PG8_SB(1, 1), b3 + hstep, voffB); PG8_STAGE(PG8_SA(1, 0), a3, voffA);
            PG8_WAIT_V(8); PG8_WAIT_L(0); PG8_BAR; PG8_MMA(1, 0, At, B0); PG8_MMA(1, 1, At, B1); PG8_BAR; PG8_SCHED;
            } else {
            PG8_LDB(B0, 0, 0); PG8_SCHED; PG8_LDA(At, 0, 0); PG8_STAGE(PG8_SA(1, 1), a1 + hstep, voffA);
            PG8_WAIT_L(8); PG8_BAR; PG8_WAIT_L(0); PG8_MMA(0, 0, At, B0); PG8_BAR; PG8_SCHED;
            PG8_LDB(B1, 0, 1); PG8_STAGE(PG8_SB(0, 0), b2, voffB);
            PG8_BAR; PG8_WAIT_L(0); PG8_MMA(0, 1, At, B1); PG8_BAR;
            PG8_LDA(At, 0, 1); PG8_STAGE(PG8_SA(0, 0), a2, voffA);
            PG8_BAR; PG8_WAIT_L(0); PG8_MMA(1, 0, At, B0); PG8_BAR; PG8_SCHED;
            PG8_STAGE(PG8_SB(0, 1), b2 + hstep, voffB);
            PG8_WAIT_V(6); PG8_BAR; PG8_MMA(1, 1, At, B1); PG8_BAR;
            PG8_LDB(B0, 1, 0); PG8_SCHED; PG8_LDA(At, 1, 0); PG8_STAGE(PG8_SA(0, 1), a2 + hstep, voffA);
            PG8_WAIT_L(8); PG8_BAR; PG8_WAIT_L(0); PG8_MMA(0, 0, At, B0); PG8_BAR; PG8_SCHED;
            PG8_LDB(B1, 1, 1); PG8_STAGE(PG8_SB(1, 0), b3, voffB);
            PG8_BAR; PG8_WAIT_L(0); PG8_MMA(0, 1, At, B1); PG8_BAR;
            PG8_LDA(At, 1, 1); PG8_STAGE(PG8_SA(1, 0), a3, voffA);
            PG8_BAR; PG8_WAIT_L(0); PG8_MMA(1, 0, At, B0); PG8_BAR; PG8_SCHED;
            PG8_STAGE(PG8_SB(1, 1), b3 + hstep, voffB);
            PG8_WAIT_V(6); PG8_BAR; PG8_MMA(1, 1, At, B1); PG8_BAR;
            }
        }
        if constexpr (ALIGN_EPI) { if (wr == 0) PG8_BAR; }
        if constexpr (!Epi::AFTER_DRAIN) { E(acc, cur, wr, wc, fr, fq); S.done(cur); }
        if (!has_next) break;
#pragma unroll
        for (int a = 0; a < 2; ++a)
#pragma unroll
            for (int b = 0; b < 2; ++b)
#pragma unroll
                for (int m = 0; m < 4; ++m)
#pragma unroll
                    for (int n = 0; n < 2; ++n) acc[a][b][m][n] = (f32x4){0.f, 0.f, 0.f, 0.f};
        cur = nxt; cA = nA; cB = nB; ++ui;
        if constexpr (ALIGN_EPI) { if (wr == 1) PG8_BAR; }
    }
    PG8_WAIT_V(0);
    if constexpr (!ALIGN_EPI) { if (wr == 0) PG8_BAR; }
    PG8_BAR;
    if constexpr (Epi::AFTER_DRAIN) { E.fused(acc, cur, wr, wc, fr, fq, lds, wid, lane); S.done(cur); }
#undef PG8_KOF
#undef PG8_SA
#undef PG8_SB
#undef PG8_STAGE
#undef PG8_LDA
#undef PG8_LDB
#undef PG8_MMA
#undef PG8_WAIT_V
#undef PG8_WAIT_L
#undef PG8_BAR
#undef PG8_SCHED
}
}
namespace att {
typedef unsigned short bf16;
constexpr int   D = 128, NW = 8, QBLK = 32, KVBLK = 64;
constexpr float SCALE = 0.088388347648318440f;
constexpr float THR = 8.f;
constexpr size_t SHM_V = KVBLK * D * 2, SHM_K = KVBLK * D * 2, SHM_ATTN = 2 * SHM_V + 2 * SHM_K + NW * 64 * 4;
using bf16x8 = __attribute__((ext_vector_type(8))) short;
using s16x4  = __attribute__((ext_vector_type(4))) short;
using f32x16 = __attribute__((ext_vector_type(16))) float;
using u32x4  = __attribute__((ext_vector_type(4))) unsigned;
using u32x2  = __attribute__((ext_vector_type(2))) unsigned;
#define KSWZ(row, colB) ((row) * 256 + ((colB) ^ (((row) & 7) << 4)))
#define SBAR() __builtin_amdgcn_sched_barrier(0)
__device__ __forceinline__ int crow(int r, int hi) { return (r & 3) + 8 * (r >> 2) + 4 * hi; }
__device__ __forceinline__ unsigned cvtpk(float lo, float hi) { unsigned r; asm volatile("v_cvt_pk_bf16_f32 %0, %1, %2" : "=v"(r) : "v"(lo), "v"(hi)); return r; }
__device__ __forceinline__ void mask16(f32x16& p, unsigned mw) {
#pragma unroll
  for (int r = 0; r < 16; ++r) { const int cr = (r & 3) + 8 * (r >> 2); const int m = __builtin_amdgcn_sbfe((int)mw, cr, 1); p[r] = __uint_as_float(__float_as_uint(p[r]) & (unsigned)m); }
}
template <bool MASKED>
__device__ __forceinline__ void partialSM(f32x16& p0, f32x16& p1, float& m_reg, float& mn, float& alpha) {
  constexpr float C = SCALE * 1.4426950408889634f;
  float pmax = p0[0];
#pragma unroll
  for (int r = 1; r < 16; ++r) pmax = fmaxf(pmax, p0[r]);
#pragma unroll
  for (int r = 0; r < 16; ++r) pmax = fmaxf(pmax, p1[r]);
  { auto rr = __builtin_amdgcn_permlane32_swap(__float_as_uint(pmax), __float_as_uint(pmax), false, false);
    pmax = fmaxf(__uint_as_float(rr[0]), __uint_as_float(rr[1])); }
  if (__builtin_expect(__all(pmax - m_reg <= THR / SCALE), 1)) { mn = m_reg; alpha = 1.f; }
  else { mn = fmaxf(m_reg, pmax); alpha = __builtin_amdgcn_exp2f((m_reg - mn) * C); m_reg = mn; }
  float mnC = -mn * C;
#pragma unroll
  for (int r = 0; r < 16; ++r) p0[r] = fmaf(p0[r], C, mnC);
#pragma unroll
  for (int r = 0; r < 16; ++r) p1[r] = fmaf(p1[r], C, mnC);
#pragma unroll
  for (int r = 0; r < 16; ++r) p0[r] = __builtin_amdgcn_exp2f(p0[r]);
}
template <bool MASKED>
__device__ __forceinline__ void finishSM(f32x16& p0, f32x16& p1, float alpha, float& l_reg, bf16x8& pa0, bf16x8& pa1, bf16x8& pa2, bf16x8& pa3, unsigned mw0, unsigned mw1) {
#pragma unroll
  for (int r = 0; r < 16; ++r) p1[r] = __builtin_amdgcn_exp2f(p1[r]);
  if (MASKED) { mask16(p0, mw0); mask16(p1, mw1); }
  float ps = 0;
#pragma unroll
  for (int r = 0; r < 16; ++r) ps += p0[r];
#pragma unroll
  for (int r = 0; r < 16; ++r) ps += p1[r];
  { auto rr = __builtin_amdgcn_permlane32_swap(__float_as_uint(ps), __float_as_uint(ps), false, false);
    ps = __uint_as_float(rr[0]) + __uint_as_float(rr[1]); }
  l_reg = l_reg * alpha + ps;
#define PK4(P, BASE, OUT) do { unsigned a0 = cvtpk(P[BASE + 0], P[BASE + 1]), a1 = cvtpk(P[BASE + 2], P[BASE + 3]);   \
    unsigned b0 = cvtpk(P[BASE + 4], P[BASE + 5]), b1 = cvtpk(P[BASE + 6], P[BASE + 7]);                              \
    auto r0 = __builtin_amdgcn_permlane32_swap(a0, b0, false, false); auto r1 = __builtin_amdgcn_permlane32_swap(a1, b1, false, false); \
    u32x4 w = {r0[0], r1[0], r0[1], r1[1]}; OUT = *reinterpret_cast<bf16x8*>(&w); } while (0)
  PK4(p0, 0, pa0); PK4(p0, 8, pa1); PK4(p1, 0, pa2); PK4(p1, 8, pa3);
#undef PK4
}
__device__ __forceinline__ void qkt(f32x16& p0, f32x16& p1, const bf16* Ks, const bf16x8* qr, int r32, int hi) {
  p0 = f32x16{}; p1 = f32x16{};
#pragma unroll
  for (int d0 = 0; d0 < 8; ++d0) { int cb = (d0 * 16 + hi * 8) * 2;
    bf16x8 b0 = *reinterpret_cast<const bf16x8*>((const char*)Ks + KSWZ(r32, cb));
    bf16x8 b1 = *reinterpret_cast<const bf16x8*>((const char*)Ks + KSWZ(32 + r32, cb));
    p0 = __builtin_amdgcn_mfma_f32_32x32x16_bf16(b0, qr[d0], p0, 0, 0, 0);
    p1 = __builtin_amdgcn_mfma_f32_32x32x16_bf16(b1, qr[d0], p1, 0, 0, 0); }
}
__device__ __forceinline__ int v_st(int k, int c) { const int kk = (k & ~0xC) | ((k & 4) << 1) | ((k & 8) >> 1); return ((kk >> 3) * 4 + (c >> 5)) * 512 + ((kk & 7) * 32 + (c & 31)) * 2; }
__device__ __forceinline__ int v_rd_base(int lane) { return ((lane & 3) << 3) | (((lane >> 2) & 3) << 6) | (((lane >> 4) & 1) << 5) | (((lane >> 5) & 1) << 8); }
constexpr int v_rd_off(int d0, int ks, int half) { return d0 * 512 + ks * 4096 + half * 2048; }
template <int OFF> __device__ __forceinline__ s16x4 tr_read(int vb) {
  s16x4 r; asm volatile("ds_read_b64_tr_b16 %0, %1 offset:%2" : "=&v"(r) : "v"(vb), "i"(OFF) : "memory"); return r;
}
template <int D0> __device__ __forceinline__ void pv_one(f32x16& od, int vb, bf16x8 pa0, bf16x8 pa1, bf16x8 pa2, bf16x8 pa3) {
  const s16x4 l0 = tr_read<v_rd_off(D0, 0, 0)>(vb), h0 = tr_read<v_rd_off(D0, 0, 1)>(vb), l1 = tr_read<v_rd_off(D0, 1, 0)>(vb), h1 = tr_read<v_rd_off(D0, 1, 1)>(vb);
  const s16x4 l2 = tr_read<v_rd_off(D0, 2, 0)>(vb), h2 = tr_read<v_rd_off(D0, 2, 1)>(vb), l3 = tr_read<v_rd_off(D0, 3, 0)>(vb), h3 = tr_read<v_rd_off(D0, 3, 1)>(vb);
  asm volatile("s_waitcnt lgkmcnt(0)" ::: "memory"); SBAR();
#define PK(L, H) (bf16x8){L[0], L[1], L[2], L[3], H[0], H[1], H[2], H[3]}
  od = __builtin_amdgcn_mfma_f32_32x32x16_bf16(pa0, PK(l0, h0), od, 0, 0, 0);
  od = __builtin_amdgcn_mfma_f32_32x32x16_bf16(pa1, PK(l1, h1), od, 0, 0, 0);
  od = __builtin_amdgcn_mfma_f32_32x32x16_bf16(pa2, PK(l2, h2), od, 0, 0, 0);
  od = __builtin_amdgcn_mfma_f32_32x32x16_bf16(pa3, PK(l3, h3), od, 0, 0, 0);
#undef PK
}
__device__ __forceinline__ void pv_d0(f32x16* o, int vb, bf16x8 pa0, bf16x8 pa1, bf16x8 pa2, bf16x8 pa3) {
  pv_one<0>(o[0], vb, pa0, pa1, pa2, pa3); pv_one<1>(o[1], vb, pa0, pa1, pa2, pa3); pv_one<2>(o[2], vb, pa0, pa1, pa2, pa3); pv_one<3>(o[3], vb, pa0, pa1, pa2, pa3);
}
template <int LDQ, int LDK, int LDO, bool MASKED, int SDEPTH>
__device__ __forceinline__ void attn_body(const bf16* __restrict__ Qb, const bf16* __restrict__ Kh, const bf16* __restrict__ Vh,
                                          bf16* __restrict__ Ob, const unsigned* __restrict__ mrow0, int seq, char* lds, const int wv) {
  int tid_ = wv * 64 + (int)__builtin_amdgcn_mbcnt_hi(~0u, __builtin_amdgcn_mbcnt_lo(~0u, 0u)); asm volatile("" : "+v"(tid_));
  const int tid = tid_, wid = tid >> 6, lane = tid & 63, r32 = lane & 31, hi = lane >> 5;
  bf16* V_lds = (bf16*)lds; bf16* K_lds = (bf16*)(lds + 2 * SHM_V);
  float* ws = (float*)(lds + 2 * SHM_V + 2 * SHM_K) + wid * 64; float* li_l = ws; float* al_l = ws + 32;
  float m_reg = -1e30f, l_reg = 0; f32x16 o[4] = {}; bf16x8 qr[8];
  const bf16* Qw = Qb + (long)(wid * QBLK + r32) * LDQ + hi * 8;
#pragma unroll
  for (int d0 = 0; d0 < 8; ++d0) qr[d0] = *reinterpret_cast<const bf16x8*>(Qw + d0 * 16);
  const int msh = 4 * hi;
  u32x2* mlds = (u32x2*)(lds + SHM_ATTN);
  if (MASKED) {
#pragma unroll 4
    for (int i = 0; i < 16; ++i) { const int idx = tid + 512 * i; mlds[(idx >> 5) * 33 + (idx & 31)] = *reinterpret_cast<const u32x2*>(mrow0 + 2 * idx); }
  }
  const int mro = (wid * QBLK + r32) * 33;
#define MLOAD(j) (MASKED ? mlds[mro + (j)] : (u32x2){0u, 0u})
  const int sr = tid >> 4, sc = (tid & 15) * 8, vst0 = v_st(sr, sc), vst1 = v_st(32 + sr, sc);
  const int vb0 = (int)(uintptr_t)V_lds + v_rd_base(lane);
  struct { bf16x8 vs0, vs1, ks0, ks1; } sr_[SDEPTH];
#define SLOAD(i, k0) do { sr_[i].vs0 = *reinterpret_cast<const bf16x8*>(&Vh[(long)((k0) + sr) * LDK + sc]); sr_[i].vs1 = *reinterpret_cast<const bf16x8*>(&Vh[(long)((k0) + 32 + sr) * LDK + sc]); \
    sr_[i].ks0 = *reinterpret_cast<const bf16x8*>(&Kh[(long)((k0) + sr) * LDK + sc]); sr_[i].ks1 = *reinterpret_cast<const bf16x8*>(&Kh[(long)((k0) + 32 + sr) * LDK + sc]); } while (0)
#define SWRITE(b, i) do { *(bf16x8*)((char*)V_lds + (b) * SHM_V + vst0) = sr_[i].vs0;          \
    *(bf16x8*)((char*)V_lds + (b) * SHM_V + vst1) = sr_[i].vs1; int kc = sc * 2;               \
    *(bf16x8*)((char*)K_lds + (b) * SHM_K + KSWZ(sr, kc)) = sr_[i].ks0;                       \
    *(bf16x8*)((char*)K_lds + (b) * SHM_K + KSWZ(32 + sr, kc)) = sr_[i].ks1; } while (0)
#define SWAIT() do { if constexpr (SDEPTH == 2) asm volatile("s_waitcnt vmcnt(4)" ::: "memory"); else asm volatile("s_waitcnt vmcnt(0)" ::: "memory"); } while (0)
#define RESC(a) do { if (__any((a) < 1.f)) { if (hi == 0) al_l[r32] = (a); asm volatile("s_waitcnt lgkmcnt(0)" ::: "memory"); \
    _Pragma("unroll") for (int d = 0; d < 4; ++d) _Pragma("unroll") for (int r = 0; r < 16; ++r) o[d][r] *= al_l[crow(r, hi)]; } } while (0)
  f32x16 pA0, pA1, pB0, pB1; float mnA, mnB, alA, alB; bf16x8 pa0, pa1, pa2, pa3; const int NT = seq / KVBLK;
  u32x2 mwA, mwB;
  constexpr int SE = 0, SO = SDEPTH - 1;
  SLOAD(SE, 0); asm volatile("s_waitcnt vmcnt(0)" ::: "memory"); SWRITE(0, SE); __syncthreads();
  qkt(pA0, pA1, K_lds, qr, r32, hi); partialSM<MASKED>(pA0, pA1, m_reg, mnA, alA);
  SLOAD(SO, KVBLK); if constexpr (SDEPTH == 2) { if (2 < NT) SLOAD(SE, 2 * KVBLK); }
  SWAIT(); SWRITE(1, SO); __syncthreads();
  for (int j = 1; j + 1 < NT; j += 2) {
    mwA = MLOAD(j - 1);
    SBAR(); qkt(pB0, pB1, (bf16*)((char*)K_lds + SHM_K), qr, r32, hi);
    finishSM<MASKED>(pA0, pA1, alA, l_reg, pa0, pa1, pa2, pa3, mwA[0] >> msh, mwA[1] >> msh); SBAR();
    SLOAD(SO, (j + SDEPTH) * KVBLK); SBAR();
    pv_d0(o, vb0, pa0, pa1, pa2, pa3); partialSM<MASKED>(pB0, pB1, m_reg, mnB, alB);
    __syncthreads(); SWAIT(); SWRITE(0, SE);
    RESC(alB); __syncthreads();
    mwB = MLOAD(j);
    SBAR(); qkt(pA0, pA1, K_lds, qr, r32, hi);
    finishSM<MASKED>(pB0, pB1, alB, l_reg, pa0, pa1, pa2, pa3, mwB[0] >> msh, mwB[1] >> msh); SBAR();
    if (SDEPTH == 1 || j + 3 < NT) SLOAD(SE, (j + 1 + SDEPTH) * KVBLK); SBAR();
    pv_d0(o, vb0 + (int)SHM_V, pa0, pa1, pa2, pa3); partialSM<MASKED>(pA0, pA1, m_reg, mnA, alA);
    __syncthreads(); SWAIT(); SWRITE(1, SO);
    RESC(alA); __syncthreads();
  }
  mwA = MLOAD(NT - 2);
  SBAR(); qkt(pB0, pB1, (bf16*)((char*)K_lds + SHM_K), qr, r32, hi);
  finishSM<MASKED>(pA0, pA1, alA, l_reg, pa0, pa1, pa2, pa3, mwA[0] >> msh, mwA[1] >> msh); SBAR();
  pv_d0(o, vb0, pa0, pa1, pa2, pa3); partialSM<MASKED>(pB0, pB1, m_reg, mnB, alB);
  __syncthreads(); RESC(alB);
  mwB = MLOAD(NT - 1);
  finishSM<MASKED>(pB0, pB1, alB, l_reg, pa0, pa1, pa2, pa3, mwB[0] >> msh, mwB[1] >> msh); SBAR();
  pv_d0(o, vb0 + (int)SHM_V, pa0, pa1, pa2, pa3);
  if (hi == 0) li_l[r32] = l_reg; asm volatile("s_waitcnt lgkmcnt(0)" ::: "memory");
  float rli[16];
#pragma unroll
  for (int r = 0; r < 16; ++r) rli[r] = __builtin_amdgcn_rcpf(li_l[crow(r, hi)]);
  bf16* Ow = Ob + (long)(wid * QBLK) * LDO;
#pragma unroll
  for (int r = 0; r < 16; ++r) { int orow = crow(r, hi);
#pragma unroll
    for (int d0 = 0; d0 < 4; ++d0) { const float v = o[d0][r] * rli[r]; unsigned u = __float_as_uint(v); u = (u + 0x7fffu + ((u >> 16) & 1u)) >> 16;
      Ow[(long)orow * LDO + d0 * 32 + r32] = (bf16)u; } }
  __syncthreads();
#undef SLOAD
#undef SWRITE
#undef SWAIT
#undef RESC
#undef MLOAD
}
#undef KSWZ
#undef SBAR
}
namespace cg = cooperative_groups;
constexpr int NWAVES = 8;
#ifndef WGM_P1
#define WGM_P1 4
#endif
#ifndef WGM_P11
#define WGM_P11 4
#endif
#ifndef WGM_P5
#define WGM_P5 2
#endif
#ifndef PROBE_PH
#define PROBE_PH -1
#endif
#ifndef ATT_SD
#define ATT_SD 2
#endif
#ifndef MK_ONE_LAUNCH
#define MK_ONE_LAUNCH 1
#endif
constexpr int NB = 8, SEQ = 2048, DM = 2048, T = NB * SEQ, NMEM = 256, TM = NB * NMEM;
constexpr int NIN = 6000, NP = 6144;
constexpr int C_R = 0, C_K = 1024, C_V = 2048, C_XW = 3072, C_XA = 3136, C_XG = 3200, C_Q = 3360, C_AK = 4384, C_AV = 4640, C_QI = 4896, C_KI = 5920, C_WI = 5984;
constexpr int DFF = 8192, NL = 3072, KL = 384;
constexpr float NORM_EPS = 1e-5f, RWKV_LN_EPS = 64e-5f;
constexpr size_t MiB = 1u << 20;
constexpr size_t WS_CTL = 0, CTL_ZERO_BYTES = 384 * 1024;
constexpr size_t WS_WIN = 2 * MiB, WS_WMIX = 26 * MiB, WS_WQ = 34 * MiB, WS_WKV = 36 * MiB, WS_WO = 40 * MiB, WS_WUP = 42 * MiB, WS_WDN = 74 * MiB, WS_WL = 106 * MiB;
constexpr size_t WS_XN = 110 * MiB, WS_MEMN = 174 * MiB, WS_MEMKV = 182 * MiB, WS_AL = 186 * MiB, WS_MASK = 198 * MiB, WS_QC = 202 * MiB, WS_OC = 218 * MiB;
constexpr size_t WS_Y = 236 * MiB, WS_P = 300 * MiB, WS_ACT = 236 * MiB, WS_END = 492 * MiB;
static_assert(WS_WL + (size_t)NL * KL * 2 <= WS_XN && WS_AL + (size_t)T * KL * 2 <= WS_MASK && WS_P + (size_t)T * NP * 2 <= WS_END && WS_ACT + (size_t)T * DFF * 2 <= WS_END, "ws map");
constexpr int CW_QUEUE = 64;
constexpr int CW_BAR = 4096;
constexpr int CW_SS1 = 32768, CW_SS2 = CW_SS1 + T, CW_SS3 = CW_SS2 + T, CW_PCNT = CW_SS3 + T + 64, CW_TMO = 2048;
static_assert((CW_PCNT + 64 * 64) * 4 <= (int)CTL_ZERO_BYTES, "control words inside the memset");
constexpr int RING_BYTES = 131072, LDS_BYTES = 147456, MISC_OFF = LDS_BYTES - 256;

#define GAS __attribute__((address_space(1)))
#define LAS __attribute__((address_space(3)))
typedef unsigned short bf16;
typedef unsigned v4u __attribute__((ext_vector_type(4)));
typedef unsigned v2u __attribute__((ext_vector_type(2)));
typedef float f32x4 __attribute__((ext_vector_type(4)));
typedef float f32x16 __attribute__((ext_vector_type(16)));
typedef short bf16x8 __attribute__((ext_vector_type(8)));
typedef GAS unsigned gu32;
#define RLX_AGENT __ATOMIC_RELAXED, __HIP_MEMORY_SCOPE_AGENT
#define LDS_WAIT() asm volatile("s_waitcnt lgkmcnt(0)" ::: "memory")
#define VM_WAIT() asm volatile("s_waitcnt vmcnt(0)" ::: "memory")
__device__ __forceinline__ unsigned f2bf(float f) { unsigned u = __builtin_bit_cast(unsigned, f); return (u + 0x7fffu + ((u >> 16) & 1u)) >> 16; }
__device__ __forceinline__ unsigned pk2(float lo, float hi) { return f2bf(lo) | (f2bf(hi) << 16); }
__device__ __forceinline__ float bf2f(unsigned short h) { return __builtin_bit_cast(float, (unsigned)h << 16); }
__device__ __forceinline__ float bflo(unsigned w) { return __builtin_bit_cast(float, w << 16); }
__device__ __forceinline__ float bfhi(unsigned w) { return __builtin_bit_cast(float, w & 0xffff0000u); }
__device__ __forceinline__ float wave_sum(float v) {
#pragma unroll
    for (int o = 1; o < 64; o <<= 1) v += __shfl_xor(v, o);
    return v;
}
__device__ __forceinline__ float quad_sum(float v) {
    v += __builtin_bit_cast(float, __builtin_amdgcn_update_dpp(0, __builtin_bit_cast(int, v), 0xB1, 0xF, 0xF, false));
    v += __builtin_bit_cast(float, __builtin_amdgcn_update_dpp(0, __builtin_bit_cast(int, v), 0x4E, 0xF, 0xF, false));
    return v;
}

struct Args { const void* in[26]; float* out; unsigned char* ws; int ph_lo, ph_hi; };

struct Frame {
    LAS unsigned char* lds; int tid, lane, wave, G, bid, wv;
    const float *x, *mem; const int* pos;
    const float *norm_mix, *w_in, *mu, *w0, *wd_up, *a0, *a_up, *g_up, *k_k, *k_a, *r_k, *lnx_w, *lnx_b, *w_mix, *norm_cross, *norm_mem, *w_q, *w_kv, *w_o, *norm_mlp, *w_up, *w_dn, *norm_final;
    float* out; unsigned* ctl;
    bf16 *WIN, *WMIX, *WQ, *WKV, *WO, *WUP, *WDN, *WL, *XN, *MEMN, *MEMKV, *AL, *QC, *OC, *Y, *P, *ACT, *EWAG; unsigned* MASK;
};

__device__ __forceinline__ void p0_transpose_item(const float* W, int K, int N, int NPAD, bf16* WT, LAS float* scr, int item, int lane, const float* gain = nullptr) {
    const int nblk = NPAD / 64, kb = item / nblk, nb = item % nblk, k0 = 64 * kb, n0 = 64 * nb;
    const int c4 = (lane & 15) * 4, kr = lane >> 4; const bool ok = (n0 + c4) < N;
    f32x4 v[16];
#pragma unroll
    for (int i = 0; i < 16; ++i) v[i] = ok ? __builtin_nontemporal_load((const f32x4*)(W + (size_t)(k0 + kr + 4 * i) * N + n0 + c4)) : (f32x4){0.f, 0.f, 0.f, 0.f};
#pragma unroll
    for (int i = 0; i < 16; ++i) { LAS float* s = scr + (kr + 4 * i) * 65 + c4; const float gk = gain ? gain[k0 + kr + 4 * i] : 1.f; s[0] = v[i].x * gk; s[1] = v[i].y * gk; s[2] = v[i].z * gk; s[3] = v[i].w * gk; }
    LDS_WAIT(); asm volatile("" ::: "memory");
    const int c = lane & 7;
#pragma unroll
    for (int j = 0; j < 8; ++j) { const int n = (lane >> 3) + 8 * j; const LAS float* s = scr + (8 * c) * 65 + n;
        v4u o; o.x = pk2(s[0 * 65], s[1 * 65]); o.y = pk2(s[2 * 65], s[3 * 65]); o.z = pk2(s[4 * 65], s[5 * 65]); o.w = pk2(s[6 * 65], s[7 * 65]);
        *(v4u*)(WT + (size_t)(n0 + n) * K + k0 + 8 * c) = o; }
    LDS_WAIT(); asm volatile("" ::: "memory");
}
__device__ __forceinline__ void rms_row_to_bf16(const float* xrow, const float* g, bf16* orow, int lane) {
    const f32x4* xr = (const f32x4*)xrow + lane; const f32x4* gr = (const f32x4*)g + lane;
    f32x4 v[8]; float s = 0.f;
#pragma unroll
    for (int j = 0; j < 8; ++j) { v[j] = __builtin_nontemporal_load(xr + 64 * j); s += (v[j].x * v[j].x + v[j].y * v[j].y) + (v[j].z * v[j].z + v[j].w * v[j].w); }
    const float rstd = 1.f / sqrtf(wave_sum(s) * (1.f / DM) + NORM_EPS);
    v2u* o8 = (v2u*)orow + lane;
#pragma unroll
    for (int j = 0; j < 8; ++j) { const f32x4 gg = gr[64 * j]; v2u w; w.x = pk2(v[j].x * rstd * gg.x, v[j].y * rstd * gg.y); w.y = pk2(v[j].z * rstd * gg.z, v[j].w * rstd * gg.w); o8[64 * j] = w; }
}
__device__ __forceinline__ void p0_prologue(Frame& F, int part = 3) {
    LAS float* scr = (LAS float*)(F.lds + F.wave * 16640);
    const int gw = F.bid * NWAVES + F.wave, NGW = F.G * NWAVES;
    constexpr int I_IN = (DM / 64) * (NP / 64), I_MIX = (DM / 64) * (DM / 64), I_Q = (DM / 64) * (512 / 64), I_KV = (DM / 64) * (1024 / 64), I_O = (512 / 64) * (DM / 64),
                  I_UP = (DM / 64) * (DFF / 64), I_DN = (DFF / 64) * (DM / 64);
    constexpr int NITEMS = I_IN + I_MIX + I_Q + I_KV + I_O;
    if (part & 1)
    for (int it = gw; it < NITEMS; it += NGW) {
        int r = it;
        if (r < I_IN) { p0_transpose_item(F.w_in, DM, NIN, NP, F.WIN, scr, r, F.lane); continue; } r -= I_IN;
        if (r < I_MIX) { p0_transpose_item(F.w_mix, DM, DM, DM, F.WMIX, scr, r, F.lane); continue; } r -= I_MIX;
        if (r < I_Q) { p0_transpose_item(F.w_q, DM, 512, 512, F.WQ, scr, r, F.lane, F.norm_cross); continue; } r -= I_Q;
        if (r < I_KV) { p0_transpose_item(F.w_kv, DM, 1024, 1024, F.WKV, scr, r, F.lane); continue; } r -= I_KV;
        if (r < I_O) { p0_transpose_item(F.w_o, 512, DM, DM, F.WO, scr, r, F.lane); continue; } r -= I_O;
    }
    if (part & 1)
    for (int idx = F.bid * 512 + F.tid; idx < NL * (KL / 8); idx += F.G * 512) {
        const int n = idx % NL, k0 = (idx / NL) * 8, ty = n >> 10, c = n & 1023; float v[8];
#pragma unroll
        for (int i = 0; i < 8; ++i) { const int k = k0 + i; float x = 0.f;
            if (ty == 0) { if (k < 64) x = F.wd_up[(size_t)k * 1024 + c]; }
            else if (ty == 1) { if (k >= 64 && k < 128) x = F.a_up[(size_t)(k - 64) * 1024 + c]; }
            else { if (k >= 128 && k < 288) x = F.g_up[(size_t)(k - 128) * 1024 + c]; }
            v[i] = x; }
        v4u o; o.x = pk2(v[0], v[1]); o.y = pk2(v[2], v[3]); o.z = pk2(v[4], v[5]); o.w = pk2(v[6], v[7]);
        *(v4u*)(F.WL + (size_t)n * KL + k0) = o;
    }
    if (part & 2)
    for (int m = gw; m < T; m += NGW) rms_row_to_bf16(F.x + (size_t)m * DM, F.norm_mix, F.XN + (size_t)m * DM, F.lane);
    for (int m = gw; m < TM; m += NGW) rms_row_to_bf16(F.mem + (size_t)m * DM, F.norm_mem, F.MEMN + (size_t)m * DM, F.lane);
}
__device__ __forceinline__ void p7_mlp_weights(Frame& F, int blk0, int nblk) {
    const int me = F.bid - blk0; if (me < 0 || me >= nblk) return;
    LAS float* scr = (LAS float*)(F.lds + F.wave * 16640);
    constexpr int I_UP = (DM / 64) * (DFF / 64), I_DN = (DFF / 64) * (DM / 64);
    for (int it = me * NWAVES + F.wave; it < I_UP + I_DN; it += nblk * NWAVES) {
        if (it < I_UP) p0_transpose_item(F.w_up, DM, DFF, DFF, F.WUP, scr, it, F.lane, F.norm_mlp);
        else p0_transpose_item(F.w_dn, DFF, DM, DM, F.WDN, scr, it - I_UP, F.lane);
    }
}
__device__ __forceinline__ void norm_phase(Frame& F, const float* g) {
    const int gw = F.bid * NWAVES + F.wave, NGW = F.G * NWAVES;
    for (int m = gw; m < T; m += NGW) rms_row_to_bf16(F.out + (size_t)m * DM, g, F.XN + (size_t)m * DM, F.lane);
}
__device__ __forceinline__ void final_norm_phase(Frame& F) {
    const int gw = F.bid * NWAVES + F.wave, NGW = F.G * NWAVES;
    for (int m = gw; m < T; m += NGW) {
        const v4u* xr = (const v4u*)(F.XN + (size_t)m * DM) + F.lane; f32x4* orow = (f32x4*)(F.out + (size_t)m * DM); const f32x4* gr = (const f32x4*)F.norm_final;
        v4u w[4]; float s = 0.f;
#pragma unroll
        for (int j = 0; j < 4; ++j) { w[j] = __builtin_nontemporal_load(xr + 64 * j);
            const float a0 = bflo(w[j].x), a1 = bfhi(w[j].x), a2 = bflo(w[j].y), a3 = bfhi(w[j].y), a4 = bflo(w[j].z), a5 = bfhi(w[j].z), a6 = bflo(w[j].w), a7 = bfhi(w[j].w);
            s += (a0 * a0 + a1 * a1) + (a2 * a2 + a3 * a3) + (a4 * a4 + a5 * a5) + (a6 * a6 + a7 * a7); }
        const float rstd = 1.f / sqrtf(wave_sum(s) * (1.f / DM) + NORM_EPS);
#pragma unroll
        for (int j = 0; j < 4; ++j) { const int c4 = (64 * j + F.lane) * 2; const f32x4 g0 = gr[c4], g1 = gr[c4 + 1];
            __builtin_nontemporal_store((f32x4){bflo(w[j].x) * rstd * g0.x, bfhi(w[j].x) * rstd * g0.y, bflo(w[j].y) * rstd * g0.z, bfhi(w[j].y) * rstd * g0.w}, orow + c4);
            __builtin_nontemporal_store((f32x4){bflo(w[j].z) * rstd * g1.x, bfhi(w[j].z) * rstd * g1.y, bflo(w[j].w) * rstd * g1.z, bfhi(w[j].w) * rstd * g1.w}, orow + c4 + 1); }
    }
}

__device__ __forceinline__ void prep_phase(Frame& F) {
    const int gw = F.bid * NWAVES + F.wave, NGW = F.G * NWAVES, lane = F.lane;
    LAS float* cs0 = (LAS float*)(F.lds + F.wave * 512);
    int c1 = 0, c2 = 0, fi0 = 0;
    if (lane < 16) { c1 = C_Q + (lane >> 1) * 128 + (lane & 1) * 8; c2 = c1 + 16; fi0 = (lane & 1) * 8; }
    else if (lane < 20) { const int j = lane - 16; c1 = C_AK + (j >> 1) * 128 + (j & 1) * 8; c2 = c1 + 16; fi0 = (j & 1) * 8; }
    else if (lane < 36) { c1 = C_QI + (lane - 20) * 64; c2 = c1 + 8; fi0 = 16; }
    else { c1 = C_KI; c2 = c1 + 8; fi0 = 16; }
    const bool rope_l = lane < 37, lora_l = lane < 36, pad_l = lane < 48;
    const int j0 = lane * 8;
    f32x4 mu0 = {0.f, 0.f, 0.f, 0.f}, mu1 = mu0;
    if (lora_l) { mu0 = *(const f32x4*)(F.mu + C_XW + j0); mu1 = *(const f32x4*)(F.mu + C_XW + j0 + 4); }
    const float fe = (lane < 16) ? (float)lane * (1.f / 16.f) : (float)(lane - 16) * (1.f / 8.f);
    const float invf = exp2f(-fe * 18.931568569324174f);
    for (int mb = gw; mb < T; mb += 2 * NGW) {
        v4u x1[2], x2[2], cu[2], pv[2]; float posf[2]; bool val[2];
#pragma unroll
        for (int u = 0; u < 2; ++u) { const int mm = mb + u * NGW; val[u] = mm < T; const int ms = val[u] ? mm : mb; bf16* prow = F.P + (size_t)ms * NP;
            x1[u] = (v4u){0u, 0u, 0u, 0u}; x2[u] = x1[u]; cu[u] = x1[u]; pv[u] = x1[u];
            if (rope_l) { x1[u] = *(const v4u*)(prow + c1); x2[u] = *(const v4u*)(prow + c2); }
            if (lora_l) { cu[u] = *(const v4u*)(prow + C_XW + j0); if ((ms & (SEQ - 1)) > 0) pv[u] = *(const v4u*)(prow - NP + C_XW + j0); }
            posf[u] = (float)F.pos[ms]; }
#pragma unroll
        for (int u = 0; u < 2; ++u) if (lane < 24) {
            const float ang = posf[u] * invf; const float k = rintf(ang * 0.15915494309189535f);
            float r = fmaf(-k, 6.2831854820251465f, ang); r = fmaf(-k, -1.7484555e-7f, r);
            cs0[u * 64 + lane] = __cosf(r); cs0[u * 64 + 32 + lane] = __sinf(r); }
        LDS_WAIT(); asm volatile("" ::: "memory");
#pragma unroll
        for (int u = 0; u < 2; ++u) { const int mm = mb + u * NGW; if (!val[u]) continue; bf16* prow = F.P + (size_t)mm * NP;
            if (rope_l) { const LAS float* cs = cs0 + u * 64 + fi0;
                const f32x4 ca = *(const LAS f32x4*)(cs), cb = *(const LAS f32x4*)(cs + 4), sa = *(const LAS f32x4*)(cs + 32), sb = *(const LAS f32x4*)(cs + 36);
                const float co[8] = {ca.x, ca.y, ca.z, ca.w, cb.x, cb.y, cb.z, cb.w}, si[8] = {sa.x, sa.y, sa.z, sa.w, sb.x, sb.y, sb.z, sb.w};
                const unsigned a[4] = {x1[u].x, x1[u].y, x1[u].z, x1[u].w}, bq[4] = {x2[u].x, x2[u].y, x2[u].z, x2[u].w}; unsigned o1[4], o2[4];
#pragma unroll
                for (int e = 0; e < 4; ++e) { const float p0 = bflo(a[e]), p1 = bfhi(a[e]), q0 = bflo(bq[e]), q1 = bfhi(bq[e]);
                    o1[e] = pk2(p0 * co[2 * e] - q0 * si[2 * e], p1 * co[2 * e + 1] - q1 * si[2 * e + 1]);
                    o2[e] = pk2(q0 * co[2 * e] + p0 * si[2 * e], q1 * co[2 * e + 1] + p1 * si[2 * e + 1]); }
                *(v4u*)(prow + c1) = (v4u){o1[0], o1[1], o1[2], o1[3]}; *(v4u*)(prow + c2) = (v4u){o2[0], o2[1], o2[2], o2[3]}; }
            if (pad_l) { unsigned o[4] = {0u, 0u, 0u, 0u};
                if (lora_l) { const unsigned cw[4] = {cu[u].x, cu[u].y, cu[u].z, cu[u].w}, pw_[4] = {pv[u].x, pv[u].y, pv[u].z, pv[u].w};
                    const float mu8[8] = {mu0.x, mu0.y, mu0.z, mu0.w, mu1.x, mu1.y, mu1.z, mu1.w};
#pragma unroll
                    for (int e = 0; e < 4; ++e) { float v2[2];
#pragma unroll
                        for (int q = 0; q < 2; ++q) { const float xc = q ? bfhi(cw[e]) : bflo(cw[e]), xp = q ? bfhi(pw_[e]) : bflo(pw_[e]); const float xm = xc + (xp - xc) * mu8[2 * e + q];
                            float v = xm;
                            if (j0 < 64) v = 1.f - 2.f * __builtin_amdgcn_rcpf(1.f + __expf(2.f * xm));
                            else if (j0 >= 128) v = __builtin_amdgcn_rcpf(1.f + __expf(-xm));
                            v2[q] = v; }
                        o[e] = pk2(v2[0], v2[1]); } }
                *(v4u*)(F.AL + (size_t)mm * KL + j0) = (v4u){o[0], o[1], o[2], o[3]}; }
        }
        LDS_WAIT(); asm volatile("" ::: "memory");
    }
}

__device__ __forceinline__ void indexer_unit(Frame& F, int b, int qblk) {
    int t_ = F.wv * 64 + (int)__builtin_amdgcn_mbcnt_hi(~0u, __builtin_amdgcn_mbcnt_lo(~0u, 0u)); asm volatile("" : "+v"(t_));
    const int tid = t_, lane = tid & 63, wave = F.wv, col = lane & 31, hf = lane >> 5;
    const int q0 = qblk * 16, t0 = q0 + 2 * wave, my_t = t0 + hf;
    const bf16* Pb = F.P + (size_t)b * SEQ * NP;
    LAS unsigned char* L = F.lds;
    bf16x8 af[4];
    { const int rho = col, sel = (rho >> 2) & 1, head = (rho & 3) + 4 * (rho >> 3);
      const bf16* qrow = Pb + (size_t)(t0 + sel) * NP + C_QI + head * 64 + hf * 8;
#pragma unroll
      for (int s = 0; s < 4; ++s) af[s] = *(const bf16x8*)(qrow + 16 * s); }
    float wq[16];
    { const v4u* wr = (const v4u*)(Pb + (size_t)my_t * NP + C_WI); const v4u a = wr[0], c = wr[1];
      wq[0] = bflo(a.x); wq[1] = bfhi(a.x); wq[2] = bflo(a.y); wq[3] = bfhi(a.y); wq[4] = bflo(a.z); wq[5] = bfhi(a.z); wq[6] = bflo(a.w); wq[7] = bfhi(a.w);
      wq[8] = bflo(c.x); wq[9] = bfhi(c.x); wq[10] = bflo(c.y); wq[11] = bfhi(c.y); wq[12] = bflo(c.z); wq[13] = bfhi(c.z); wq[14] = bflo(c.w); wq[15] = bfhi(c.w); }
    const int nch = (q0 + 15) / 128 + 1;
    const int srow = tid >> 3, sc16 = tid & 7;
    const bf16* ksrc = Pb + (size_t)srow * NP + C_KI + sc16 * 8;
    v4u st0 = *(const v4u*)(ksrc), st1 = *(const v4u*)(ksrc + (size_t)64 * NP);
    *(LAS v4u*)(L + srow * 144 + sc16 * 16) = st0; *(LAS v4u*)(L + (srow + 64) * 144 + sc16 * 16) = st1;
    __syncthreads();
    unsigned key[64];
#pragma unroll
    for (int ch = 0; ch < 16; ++ch) {
        if (ch < nch) {
            const bool more = (ch + 1 < nch);
            if (more) { st0 = *(const v4u*)(ksrc + (size_t)(128 * (ch + 1)) * NP); st1 = *(const v4u*)(ksrc + (size_t)(128 * (ch + 1) + 64) * NP); }
            const LAS unsigned char* kb0 = L + (ch & 1) * 18432 + col * 144 + hf * 16;
#pragma unroll
            for (int sub = 0; sub < 4; ++sub) { const int kb = 4 * ch + sub;
                f32x16 c = {};
#pragma unroll
                for (int s = 0; s < 4; ++s) { const bf16x8 bfr = *(const LAS bf16x8*)(kb0 + sub * 32 * 144 + s * 32); c = __builtin_amdgcn_mfma_f32_32x32x16_bf16(af[s], bfr, c, 0, 0, 0); }
                float sc = 0.f;
#pragma unroll
                for (int r = 0; r < 16; ++r) sc = fmaf(fmaxf(c[r], 0.f), wq[r], sc);
                unsigned u = __float_as_uint(sc); u = (u & 0x80000000u) ? ~u : (u | 0x80000000u);
                key[kb] = (kb * 32 + col <= my_t) ? u : 0u; }
            if (more) { LAS unsigned char* dst = L + ((ch + 1) & 1) * 18432; *(LAS v4u*)(dst + srow * 144 + sc16 * 16) = st0; *(LAS v4u*)(dst + (srow + 64) * 144 + sc16 * 16) = st1; }
            __syncthreads();
        } else {
#pragma unroll
            for (int sub = 0; sub < 4; ++sub) key[4 * ch + sub] = 0u;
        }
    }
    bool done = (my_t + 1 <= 256);
    unsigned tau = done ? 1u : 0u;
    const int nch8 = (q0 + 15) / 256 + 1;
    for (int bit = 31; bit >= 0; --bit) {
        if (__all(done)) break;
        const unsigned cand = tau | (1u << bit);
        int cnt = 0;
#pragma unroll
        for (int g8 = 0; g8 < 8; ++g8) if (g8 < nch8) {
#pragma unroll
            for (int j = 0; j < 8; ++j) cnt += (key[8 * g8 + j] >= cand) ? 1 : 0; }
        cnt += __builtin_amdgcn_update_dpp(0, cnt, 0xB1, 0xF, 0xF, false); cnt += __builtin_amdgcn_update_dpp(0, cnt, 0x4E, 0xF, 0xF, false);
        cnt += __builtin_amdgcn_update_dpp(0, cnt, 0x141, 0xF, 0xF, false); cnt += __builtin_amdgcn_update_dpp(0, cnt, 0x140, 0xF, 0xF, false);
        { auto rr = __builtin_amdgcn_permlane16_swap((unsigned)cnt, (unsigned)cnt, false, false); cnt = (int)(rr[0] + rr[1]); }
        if (!done && cnt >= 256) { tau = cand; if (cnt == 256) done = true; }
    }
    unsigned* ma = F.MASK + (size_t)(b * SEQ + t0) * 64;
    unsigned wa = 0u, wb = 0u;
#pragma unroll
    for (int kb = 0; kb < 64; ++kb) {
        const unsigned long long bal = __ballot(key[kb] >= tau);
        asm volatile("s_nop 4\n\tv_writelane_b32 %0, %2, %4\n\tv_writelane_b32 %1, %3, %4" : "+v"(wa), "+v"(wb) : "s"((unsigned)bal), "s"((unsigned)(bal >> 32)), "i"(kb));
    }
    ma[lane] = wa; ma[64 + lane] = wb;
    __syncthreads();
}
__device__ __forceinline__ void indexer_phase(Frame& F) {
    for (int i = 0; i < (NB * (SEQ / 16) + F.G - 1) / F.G; ++i) {
        const int j = i * F.G + ((i & 1) ? (F.G - 1 - F.bid) : F.bid);
        if (j < NB * (SEQ / 16)) indexer_unit(F, j & 7, j >> 3);
    }
}

template <int CTRL> __device__ __forceinline__ float dppx(float v) { return __builtin_bit_cast(float, __builtin_amdgcn_update_dpp(0, __builtin_bit_cast(int, v), CTRL, 0xF, 0xF, false)); }
__device__ __forceinline__ float row16_sum(float v) {
    v += dppx<0xB1>(v); v += dppx<0x4E>(v); v += dppx<0x141>(v); v += dppx<0x140>(v); return v;
}
__device__ __forceinline__ void row16_sum2(float& a, float& b) {
    asm volatile("s_nop 1\n\t"
        "v_add_f32_dpp %0, %0, %0 quad_perm:[1,0,3,2] row_mask:0xf bank_mask:0xf\n\t"
        "v_add_f32_dpp %1, %1, %1 quad_perm:[1,0,3,2] row_mask:0xf bank_mask:0xf\n\t"
        "s_nop 0\n\t"
        "v_add_f32_dpp %0, %0, %0 quad_perm:[2,3,0,1] row_mask:0xf bank_mask:0xf\n\t"
        "v_add_f32_dpp %1, %1, %1 quad_perm:[2,3,0,1] row_mask:0xf bank_mask:0xf\n\t"
        "s_nop 0\n\t"
        "v_add_f32_dpp %0, %0, %0 row_half_mirror row_mask:0xf bank_mask:0xf\n\t"
        "v_add_f32_dpp %1, %1, %1 row_half_mirror row_mask:0xf bank_mask:0xf\n\t"
        "s_nop 0\n\t"
        "v_add_f32_dpp %0, %0, %0 row_mirror row_mask:0xf bank_mask:0xf\n\t"
        "v_add_f32_dpp %1, %1, %1 row_mirror row_mask:0xf bank_mask:0xf\n\t"
        "s_nop 1"
        : "+v"(a), "+v"(b));
}
__device__ __forceinline__ float wave_sum_d(float v) { v = row16_sum(v); v += __shfl_xor(v, 16); v += __shfl_xor(v, 32); return v; }
namespace rw {
typedef short bf16x8 __attribute__((ext_vector_type(8)));
typedef short s16x4 __attribute__((ext_vector_type(4)));
typedef float f32x16 __attribute__((ext_vector_type(16)));
constexpr int KAP = 0, RH = 13824, KBT = 27648, BBT = 43008, VT = 58368, KH = 78848, BH = 88064, MATS = 97280, YB = 122880, GC = 139264, WTOT = 140032, BON = 144128;
constexpr int I64 = 4608, I32 = 5120, M32 = 2560, MSET = 12800;
constexpr int AKK = 0, AKR = 2560, ABR = 5120, TT = 7680, SCR = 10240;
constexpr int S64 = 144, S32 = 80;
typedef float f32x2_t __attribute__((ext_vector_type(2))); typedef __bf16 bf16x2_t __attribute__((ext_vector_type(2)));
__device__ __forceinline__ unsigned cvtpk(float lo, float hi) { f32x2_t v = {lo, hi}; bf16x2_t b = __builtin_convertvector(v, bf16x2_t); return __builtin_bit_cast(unsigned, b); }
__device__ __forceinline__ unsigned short cvt1(float x) { return (unsigned short)cvtpk(x, 0.f); }
__device__ __forceinline__ bf16x8 frag_nat(const LAS unsigned char* base, int stride, int row, int kb, int h) { return *(const LAS bf16x8*)(base + row * stride + (kb + 8 * h) * 2); }
__device__ __forceinline__ bf16x8 frag_perm(const LAS unsigned char* base, int stride, int row, int kb, int h) {
    const s16x4 lo = *(const LAS s16x4*)(base + row * stride + (kb + 4 * h) * 2), hi = *(const LAS s16x4*)(base + row * stride + (kb + 8 + 4 * h) * 2);
    return (bf16x8){lo[0], lo[1], lo[2], lo[3], hi[0], hi[1], hi[2], hi[3]};
}
__device__ __forceinline__ bf16x8 acc_frag(const f32x16& x, int s) {
    typedef unsigned u32x4 __attribute__((ext_vector_type(4)));
    u32x4 w; w.x = cvtpk(x[8 * s + 0], x[8 * s + 1]); w.y = cvtpk(x[8 * s + 2], x[8 * s + 3]); w.z = cvtpk(x[8 * s + 4], x[8 * s + 5]); w.w = cvtpk(x[8 * s + 6], x[8 * s + 7]);
    return __builtin_bit_cast(bf16x8, w);
}
__device__ __forceinline__ int crow(int r, int hi) { return (r & 3) + 8 * (r >> 2) + 4 * hi; }
}

#ifndef PROBE_VAR
#define PROBE_VAR 0
#endif
__device__ __forceinline__ void wave_sum2(float& a, float& b) {
    row16_sum2(a, b);
    const float a1 = __shfl_xor(a, 16), b1 = __shfl_xor(b, 16); a += a1; b += b1;
    const float a2 = __shfl_xor(a, 32), b2 = __shfl_xor(b, 32); a += a2; b += b2;
}
template <int N> __device__ __forceinline__ void wave_sum_n(float (&v)[N]) {
#pragma unroll
    for (int i = 0; i < N; ++i) v[i] += dppx<0xB1>(v[i]);
#pragma unroll
    for (int i = 0; i < N; ++i) v[i] += dppx<0x4E>(v[i]);
#pragma unroll
    for (int i = 0; i < N; ++i) v[i] += dppx<0x141>(v[i]);
#pragma unroll
    for (int i = 0; i < N; ++i) v[i] += dppx<0x140>(v[i]);
#pragma unroll
    for (int i = 0; i < N; ++i) { auto rr = __builtin_amdgcn_permlane16_swap(__float_as_uint(v[i]), __float_as_uint(v[i]), false, false);
        v[i] = __uint_as_float(rr[0]) + __uint_as_float(rr[1]); }
#pragma unroll
    for (int i = 0; i < N; ++i) { auto rr = __builtin_amdgcn_permlane32_swap(__float_as_uint(v[i]), __float_as_uint(v[i]), false, false);
        v[i] = __uint_as_float(rr[0]) + __uint_as_float(rr[1]); }
}
__device__ __forceinline__ void rwkv_unit(Frame& F, int b, int h, const int pv = 0) {
    using namespace rw;
    int t_ = F.wv * 64 + (int)__builtin_amdgcn_mbcnt_hi(~0u, __builtin_amdgcn_mbcnt_lo(~0u, 0u)); asm volatile("" : "+v"(t_));
    const int lane = t_ & 63, wave = __builtin_amdgcn_readfirstlane(t_ >> 6), l31 = lane & 31, hi = lane >> 5;
    LAS unsigned char* L = F.lds;
    const int c = lane, col = h * 64 + c;
    const float mu_r = F.mu[C_R + col], mu_k = F.mu[C_K + col], mu_v = F.mu[C_V + col];
    const float kkc = F.k_k[col], kac = F.k_a[col], rkc = F.r_k[col], lw = F.lnx_w[col], lb = F.lnx_b[col];
    const size_t m0 = (size_t)b * SEQ;
    const int vh = wave & 1;
    constexpr int NCH = SEQ / 32;
    float st[40];
#pragma unroll
    for (int i = 0; i < 40; ++i) st[i] = 0.f;
#define rm(j) st[(j)]
#define kt(j) st[8 + (j)]
#define kk(j) st[16 + (j)]
#define bb(j) st[24 + (j)]
#define cs(j) st[32 + (j)]
    unsigned raw[8][5]; unsigned rawp[3]; unsigned gq[8];
#define RW_LOAD(ch) do { { const int tk0 = (ch) * 32 + 8 * wave; const bf16* pp = F.P + (m0 + tk0 - (tk0 > 0 ? 1 : 0)) * NP; rawp[0] = pp[C_R + col]; rawp[1] = pp[C_K + col]; rawp[2] = pp[C_V + col]; } \
        _Pragma("unroll") for (int j = 0; j < 8; ++j) { const size_t m = m0 + (ch) * 32 + 8 * wave + j; const bf16* pr = F.P + m * NP; const bf16* er = F.EWAG + m * NL; \
        raw[j][0] = __builtin_nontemporal_load(pr + C_R + col); raw[j][1] = __builtin_nontemporal_load(pr + C_K + col); raw[j][2] = __builtin_nontemporal_load(pr + C_V + col); \
        raw[j][3] = __builtin_nontemporal_load(er + col); raw[j][4] = __builtin_nontemporal_load(er + 1024 + col); } } while (0)
    if (pv & 128) return;
    if (wave < 4) RW_LOAD(0);
    for (int it = 0; it < NCH + 4; ++it) {
        if (wave < 4) {
            bf16x8 vv = {}; float bon8[8];
#pragma unroll
            for (int j = 0; j < 8; ++j) bon8[j] = 0.f;
            if (it >= 4) { const int ch = it - 4; vv = *(const LAS bf16x8*)(L + VT + (ch & 3) * I32 + c * S32 + 16 * wave);
#pragma unroll
                for (int j = 0; j < 8; ++j) bon8[j] = ((const LAS float*)(L + BON + (ch & 3) * 128))[8 * wave + j]; }
            if (it >= 1 && it <= NCH && !(pv & 32)) { const int ch = it - 1; const LAS float* wt = (const LAS float*)(L + WTOT + (ch & 1) * 2048);
                float off = 0.f, tot = 0.f;
#pragma unroll
                for (int w2 = 0; w2 < 4; ++w2) { const float x = wt[w2 * 64 + c]; tot += x; off += (w2 < wave) ? x : 0.f; }
                const float lgC = -tot;
                LAS unsigned char* pK = L + KAP + (ch % 3) * I64; LAS unsigned char* pR = L + RH + (ch % 3) * I64; LAS unsigned char* pKH = L + KH + (ch & 1) * I64; LAS unsigned char* pBH = L + BH + (ch & 1) * I64;
                LAS unsigned char* pKB = L + KBT + (ch % 3) * I32; LAS unsigned char* pBB = L + BBT + (ch % 3) * I32;
                const float eC = __expf(lgC); float egp = __expf(-off);
                unsigned kb4[4], bb4[4];
#pragma unroll
                for (int j = 0; j < 8; ++j) { const int i = 8 * wave + j;
                    const float e_g = __expf(-(off + cs(j))), e_m = __builtin_amdgcn_rcpf(e_g), e_c = eC * e_m;
                    *(LAS bf16*)(pK + i * S64 + 2 * c) = cvt1(kk(j) * egp); *(LAS bf16*)(pR + i * S64 + 2 * c) = cvt1(rm(j) * e_g);
                    *(LAS bf16*)(pKH + i * S64 + 2 * c) = cvt1(kt(j) * e_m); *(LAS bf16*)(pBH + i * S64 + 2 * c) = cvt1(bb(j) * e_m);
                    const float kbv = kt(j) * e_c, bbv = -bb(j) * e_c;
                    if (j & 1) { kb4[j >> 1] = cvtpk(__uint_as_float(kb4[j >> 1]), kbv); bb4[j >> 1] = cvtpk(__uint_as_float(bb4[j >> 1]), bbv); }
                    else { kb4[j >> 1] = __float_as_uint(kbv); bb4[j >> 1] = __float_as_uint(bbv); }
                    egp = e_g; }
                *(LAS v4u*)(pKB + c * S32 + 16 * wave) = (v4u){kb4[0], kb4[1], kb4[2], kb4[3]};
                *(LAS v4u*)(pBB + c * S32 + 16 * wave) = (v4u){bb4[0], bb4[1], bb4[2], bb4[3]};
                if (wave == 0) ((LAS float*)(L + GC + (ch % 3) * 256))[c] = eC;
            }
            if (it < NCH && !(pv & 64)) { const int ch = it;
                float kkr8[8], a8[8], red[16]; unsigned vt4[4];
#pragma unroll
                for (int j = 0; j < 8; ++j) { const int tk = ch * 32 + 8 * wave + j; const bool hp = tk > 0;
                    const float r0 = bf2f((unsigned short)raw[j][0]), k0 = bf2f((unsigned short)raw[j][1]), v0 = bf2f((unsigned short)raw[j][2]);
                    const float r1 = !hp ? 0.f : bf2f((unsigned short)(j ? raw[j ? j - 1 : 0][0] : rawp[0])), k1 = !hp ? 0.f : bf2f((unsigned short)(j ? raw[j ? j - 1 : 0][1] : rawp[1])),
                                v1 = !hp ? 0.f : bf2f((unsigned short)(j ? raw[j ? j - 1 : 0][2] : rawp[2]));
                    rm(j) = r0 + (r1 - r0) * mu_r; const float km = k0 + (k1 - k0) * mu_k; const float vmj = v0 + (v1 - v0) * mu_v;
                    if (j & 1) vt4[j >> 1] = cvtpk(__uint_as_float(vt4[j >> 1]), vmj); else vt4[j >> 1] = __float_as_uint(vmj);
                    const float ew = bf2f((unsigned short)raw[j][3]); a8[j] = bf2f((unsigned short)raw[j][4]);
                    kkr8[j] = km * kkc; kt(j) = km * (1.f + (a8[j] - 1.f) * kac);
                    red[j] = kkr8[j] * kkr8[j]; red[8 + j] = rm(j) * kt(j) * rkc;
                    cs(j) = (j ? cs(j ? j - 1 : 0) : 0.f) + ew; }
                *(LAS v4u*)(L + VT + (ch & 3) * I32 + c * S32 + 16 * wave) = (v4u){vt4[0], vt4[1], vt4[2], vt4[3]};
                wave_sum_n<16>(red);
#pragma unroll
                for (int j = 0; j < 8; ++j) { kk(j) = kkr8[j] * __builtin_amdgcn_rsqf(fmaxf(red[j], 1e-24f)); bb(j) = kk(j) * a8[j]; }
                if (lane < 8) { float bo = red[8];
#pragma unroll
                    for (int j = 1; j < 8; ++j) bo = (lane == j) ? red[8 + j] : bo;
                    ((LAS float*)(L + BON + (ch & 3) * 128))[8 * wave + lane] = bo; }
                ((LAS float*)(L + WTOT + (ch & 1) * 2048))[wave * 64 + c] = cs(7);
            }
            if (!(pv & 2) && it + 1 < NCH) RW_LOAD(it + 1);
            if (it >= 4 && !(pv & 4)) { const int ch = it - 4;
                const LAS float* yb = (const LAS float*)(L + YB + (ch & 1) * 8192);
                float y8[8], sm[16];
#pragma unroll
                for (int j = 0; j < 8; ++j) { y8[j] = yb[(8 * wave + j) * 64 + c]; sm[j] = y8[j]; sm[8 + j] = y8[j] * y8[j]; }
                wave_sum_n<16>(sm);
#pragma unroll
                for (int j = 0; j < 8; ++j) { const int i = 8 * wave + j;
                    const float mean = sm[j] * (1.f / 64.f), var = fmaxf(sm[8 + j] * (1.f / 64.f) - mean * mean, 0.f);
                    const float yn = (y8[j] - mean) * __builtin_amdgcn_rsqf(var + RWKV_LN_EPS) * lw + lb;
                    const float o = (yn + bon8[j] * bf2f((unsigned short)vv[j])) * bf2f((unsigned short)gq[j]);
                    F.Y[(m0 + ch * 32 + i) * DM + col] = cvt1(o); }
            }
            if (!(pv & 2) && it + 1 >= 4 && it + 1 < NCH + 4) {
#pragma unroll
                for (int j = 0; j < 8; ++j) gq[j] = __builtin_nontemporal_load(F.EWAG + (m0 + (it - 3) * 32 + 8 * wave + j) * NL + 2048 + col); }
        } else if (wave < 6) {
            if (it >= 3 && it < NCH + 3 && !(pv & 8)) { const int ch = it - 3;
                const LAS unsigned char* pK = L + KAP + (ch % 3) * I64; const LAS unsigned char* pR = L + RH + (ch % 3) * I64; const LAS unsigned char* pKB = L + KBT + (ch % 3) * I32;
                const LAS unsigned char* pBB = L + BBT + (ch % 3) * I32; const LAS unsigned char* pV = L + VT + (ch & 3) * I32; const LAS unsigned char* pM = L + MATS + (ch & 1) * MSET;
                f32x16 X0, X1;
#pragma unroll
                for (int r = 0; r < 16; ++r) { X0[r] = st[r]; X1[r] = st[16 + r]; }
                f32x16 RHS = {}, YT = {}; bf16x8 xb[4];
                xb[0] = acc_frag(X0, 0); xb[1] = acc_frag(X0, 1); xb[2] = acc_frag(X1, 0); xb[3] = acc_frag(X1, 1);
#pragma unroll
                for (int q = 0; q < 4; ++q) { RHS = __builtin_amdgcn_mfma_f32_32x32x16_bf16(frag_perm(pK, S64, l31, 16 * q, hi), xb[q], RHS, 0, 0, 0);
                                              YT = __builtin_amdgcn_mfma_f32_32x32x16_bf16(frag_perm(pR, S64, l31, 16 * q, hi), xb[q], YT, 0, 0, 0); }
                const bf16x8 vf0 = frag_nat(pV, S32, 32 * vh + l31, 0, hi), vf1 = frag_nat(pV, S32, 32 * vh + l31, 16, hi);
                RHS = __builtin_amdgcn_mfma_f32_32x32x16_bf16(frag_nat(pM + AKK, S32, l31, 0, hi), vf0, RHS, 0, 0, 0);
                RHS = __builtin_amdgcn_mfma_f32_32x32x16_bf16(frag_nat(pM + AKK, S32, l31, 16, hi), vf1, RHS, 0, 0, 0);
                YT = __builtin_amdgcn_mfma_f32_32x32x16_bf16(frag_nat(pM + AKR, S32, l31, 0, hi), vf0, YT, 0, 0, 0);
                YT = __builtin_amdgcn_mfma_f32_32x32x16_bf16(frag_nat(pM + AKR, S32, l31, 16, hi), vf1, YT, 0, 0, 0);
                f32x16 U = {};
                { const bf16x8 r0 = acc_frag(RHS, 0), r1 = acc_frag(RHS, 1);
                  U = __builtin_amdgcn_mfma_f32_32x32x16_bf16(frag_perm(pM + TT, S32, l31, 0, hi), r0, U, 0, 0, 0);
                  U = __builtin_amdgcn_mfma_f32_32x32x16_bf16(frag_perm(pM + TT, S32, l31, 16, hi), r1, U, 0, 0, 0); }
                const bf16x8 u0 = acc_frag(U, 0), u1 = acc_frag(U, 1);
                YT = __builtin_amdgcn_mfma_f32_32x32x16_bf16(frag_perm(pM + ABR, S32, l31, 0, hi), u0, YT, 0, 0, 0);
                YT = __builtin_amdgcn_mfma_f32_32x32x16_bf16(frag_perm(pM + ABR, S32, l31, 16, hi), u1, YT, 0, 0, 0);
                LAS float* yb = (LAS float*)(L + YB + (ch & 1) * 8192);
#pragma unroll
                for (int r = 0; r < 16; ++r) yb[crow(r, hi) * 64 + 32 * vh + l31] = YT[r];
                const LAS float* gc = (const LAS float*)(L + GC + (ch % 3) * 256);
#pragma unroll
                for (int r = 0; r < 16; ++r) { X0[r] *= gc[crow(r, hi)]; X1[r] *= gc[32 + crow(r, hi)]; }
                X0 = __builtin_amdgcn_mfma_f32_32x32x16_bf16(frag_nat(pKB, S32, l31, 0, hi), vf0, X0, 0, 0, 0);
                X1 = __builtin_amdgcn_mfma_f32_32x32x16_bf16(frag_nat(pKB, S32, 32 + l31, 0, hi), vf0, X1, 0, 0, 0);
                X0 = __builtin_amdgcn_mfma_f32_32x32x16_bf16(frag_nat(pKB, S32, l31, 16, hi), vf1, X0, 0, 0, 0);
                X1 = __builtin_amdgcn_mfma_f32_32x32x16_bf16(frag_nat(pKB, S32, 32 + l31, 16, hi), vf1, X1, 0, 0, 0);
                X0 = __builtin_amdgcn_mfma_f32_32x32x16_bf16(frag_perm(pBB, S32, l31, 0, hi), u0, X0, 0, 0, 0);
                X1 = __builtin_amdgcn_mfma_f32_32x32x16_bf16(frag_perm(pBB, S32, 32 + l31, 0, hi), u0, X1, 0, 0, 0);
                X0 = __builtin_amdgcn_mfma_f32_32x32x16_bf16(frag_perm(pBB, S32, l31, 16, hi), u1, X0, 0, 0, 0);
                X1 = __builtin_amdgcn_mfma_f32_32x32x16_bf16(frag_perm(pBB, S32, 32 + l31, 16, hi), u1, X1, 0, 0, 0);
#pragma unroll
                for (int r = 0; r < 16; ++r) { st[r] = X0[r]; st[16 + r] = X1[r]; }
            }
        } else {
            if (it >= 2 && it < NCH + 2 && !(pv & 16)) { const int ch = it - 2;
                const LAS unsigned char* pK = L + KAP + (ch % 3) * I64; const LAS unsigned char* pR = L + RH + (ch % 3) * I64; const LAS unsigned char* pKH = L + KH + (ch & 1) * I64; const LAS unsigned char* pBH = L + BH + (ch & 1) * I64;
                LAS unsigned char* pM = L + MATS + (ch & 1) * MSET;
                if (wave == 6) {
#pragma unroll
                    for (int w3 = 0; w3 < 3; ++w3) { const LAS unsigned char* Aimg = (w3 == 0) ? pK : pR; const LAS unsigned char* Bimg = (w3 == 2) ? pBH : pKH;
                        f32x16 d = {};
#pragma unroll
                        for (int q = 0; q < 4; ++q) d = __builtin_amdgcn_mfma_f32_32x32x16_bf16(frag_nat(Aimg, S64, l31, 16 * q, hi), frag_nat(Bimg, S64, l31, 16 * q, hi), d, 0, 0, 0);
                        const int dst = (w3 == 0) ? AKK : (w3 == 1) ? AKR : ABR; const float sg = (w3 == 2) ? -1.f : 1.f;
#pragma unroll
                        for (int r = 0; r < 16; ++r) { const int t = crow(r, hi); const bool keep = (w3 == 0) ? (l31 < t) : (l31 <= t);
                            *(LAS bf16*)(pM + dst + t * S32 + 2 * l31) = cvt1(keep ? sg * d[r] : 0.f); } }
                } else {
                    f32x16 pw = {}, pT = {};
#pragma unroll
                    for (int q = 0; q < 4; ++q) { const bf16x8 fk = frag_nat(pK, S64, l31, 16 * q, hi), fb = frag_nat(pBH, S64, l31, 16 * q, hi);
                        pw = __builtin_amdgcn_mfma_f32_32x32x16_bf16(fk, fb, pw, 0, 0, 0);
                        pT = __builtin_amdgcn_mfma_f32_32x32x16_bf16(fb, fk, pT, 0, 0, 0); }
#pragma unroll
                    for (int r = 0; r < 16; ++r) { pw[r] = (l31 < crow(r, hi)) ? pw[r] : 0.f; pT[r] = (crow(r, hi) < l31) ? pT[r] : 0.f; }
                    f32x16 P;
#pragma unroll
                    for (int r = 0; r < 16; ++r) P[r] = ((crow(r, hi) == l31) ? 1.f : 0.f) - pw[r];
                    if (!(pv & 1))
#pragma unroll
                    for (int k2 = 0; k2 < 5; ++k2) {
                        const bf16x8 t0 = acc_frag(pT, 0), t1 = acc_frag(pT, 1);
                        if (k2 > 0) { const bf16x8 p0 = acc_frag(P, 0), p1 = acc_frag(P, 1);
                            P = __builtin_amdgcn_mfma_f32_32x32x16_bf16(t0, p0, P, 0, 0, 0); P = __builtin_amdgcn_mfma_f32_32x32x16_bf16(t1, p1, P, 0, 0, 0); }
                        if (k2 < 4) { const bf16x8 w0 = acc_frag(pw, 0), w1 = acc_frag(pw, 1); f32x16 nw = {}, nT = {};
                            nw = __builtin_amdgcn_mfma_f32_32x32x16_bf16(t0, w0, nw, 0, 0, 0); nw = __builtin_amdgcn_mfma_f32_32x32x16_bf16(t1, w1, nw, 0, 0, 0);
                            nT = __builtin_amdgcn_mfma_f32_32x32x16_bf16(w0, t0, nT, 0, 0, 0); nT = __builtin_amdgcn_mfma_f32_32x32x16_bf16(w1, t1, nT, 0, 0, 0);
                            pw = nw; pT = nT; }
                    }
#pragma unroll
                    for (int r = 0; r < 16; ++r) *(LAS bf16*)(pM + TT + crow(r, hi) * S32 + 2 * l31) = cvt1(P[r]);
                }
            }
        }
        __syncthreads();
    }
#undef RW_LOAD
#undef rm
#undef kt
#undef kk
#undef bb
#undef cs
}
__device__ __forceinline__ void mix_phase(Frame& F, int qword = CW_QUEUE, int only = 0) {
    LAS int* slot = (LAS int*)(F.lds + LDS_BYTES - 64);
    for (;;) {
        __syncthreads();
        if (F.tid == 0) slot[0] = (int)__hip_atomic_fetch_add(F.ctl + qword, 1u, RLX_AGENT);
        __syncthreads();
        const int it = slot[0];
        if (it >= 128 + 512) break;
        if (it < 128 && only == 2) continue;
        if (it >= 128 && only == 1) break;
        if (it < 128) {
#ifndef SKIP_RWKV
            rwkv_unit(F, it >> 4, it & 15, only ? (PROBE_VAR) : 0);
#endif
        }
        else {
            const int u = it - 128;
            const int qb = 7 - (u >> 6), bh = u & 63, b = bh >> 3, h = bh & 7, g = h >> 2;
            const size_t m0 = (size_t)b * SEQ, q0 = (size_t)qb * 256;
#ifndef SKIP_ATT
            att::attn_body<NP, NP, DM, true, ATT_SD>(F.P + (m0 + q0) * NP + C_Q + h * 128, F.P + m0 * NP + C_AK + g * 128, F.P + m0 * NP + C_AV + g * 128,
                                             F.Y + (m0 + q0) * DM + 1024 + h * 128, F.MASK + (m0 + q0) * 64, (int)q0 + 256, (char*)F.lds, F.wv);
#endif
        }
    }
}
__device__ __forceinline__ void cross_phase(Frame& F) {
    for (int u = F.bid; u < NB * 4 * 8; u += F.G) {
        const int b = u >> 5, h = (u >> 3) & 3, qb = u & 7;
        const size_t m0 = (size_t)b * SEQ + (size_t)qb * 256, k0 = (size_t)b * NMEM;
        att::attn_body<512, 1024, 512, false, 2>(F.QC + m0 * 512 + h * 128, F.MEMKV + k0 * 1024 + h * 128, F.MEMKV + k0 * 1024 + 512 + h * 128,
                                              F.OC + m0 * 512 + h * 128, nullptr, NMEM, (char*)F.lds, F.wv);
    }
}

#define XB_TMO      128
#define XB_XCNT(j)  (256  + 64 * (j))
#define XB_XSUB(j)  (1280 + 64 * (j))
#define XB_XGEN(j)  (2304 + 64 * (j))
#define XB_TOP      3328
#define XB_TOPGEN   3392
#define XCD_BAR_WORDS 3456
#define XB_SPIN_CAP (1u << 18)

__device__ __forceinline__ unsigned xb_ld(unsigned* p)              { return __hip_atomic_load(p, __ATOMIC_RELAXED, __HIP_MEMORY_SCOPE_AGENT); }
__device__ __forceinline__ unsigned xb_add(unsigned* p, unsigned v) { return __hip_atomic_fetch_add(p, v, __ATOMIC_RELAXED, __HIP_MEMORY_SCOPE_AGENT); }
__device__ __forceinline__ unsigned xb_xcc_id() { return (unsigned)__builtin_amdgcn_s_getreg((3 << 11) | 20) & 0xFu; }
#define XB_SPIN(cond, bar) do { unsigned _sp = 0; while (cond) { __builtin_amdgcn_s_sleep(1); \
    if ((++_sp & 255u) == 0u) { if (xb_ld(&(bar)[XB_TMO])) break; if (_sp > XB_SPIN_CAP) { atomicAdd(&(bar)[XB_TMO], 1u); break; } } } } while (0)

struct XcdBarrier {
    unsigned* bar; unsigned x;
    volatile LAS unsigned* st;
};

__device__ __forceinline__ XcdBarrier xcd_barrier_post(unsigned* bar, volatile LAS unsigned* st, const bool leader) {
    XcdBarrier b; b.bar = bar; b.x = xb_xcc_id(); b.st = st;
    if (leader) (void)xb_add(&bar[XB_XCNT(b.x)], 1u);
    return b;
}
__device__ __forceinline__ void xcd_barrier_complete(unsigned* bar, unsigned x, unsigned& nloc, unsigned& nx) {
    const unsigned G = gridDim.x * gridDim.y * gridDim.z;
    unsigned sum, cnt, mine, sp = 0u;
    for (;;) {
        sum = 0u; cnt = 0u; mine = 0u;
#pragma unroll
        for (unsigned j = 0; j < 16; ++j) { const unsigned c = xb_ld(&bar[XB_XCNT(j)]); sum += c; cnt += (c > 0u) ? 1u : 0u; mine = (j == x) ? c : mine; }
        if (sum == G) break;
        __builtin_amdgcn_s_sleep(1);
        if ((++sp & 255u) == 0u) { if (xb_ld(&bar[XB_TMO])) break; if (sp > XB_SPIN_CAP) { atomicAdd(&bar[XB_TMO], 1u); break; } }
    }
    nloc = mine > 0u ? mine : 1u; nx = cnt > 0u ? cnt : 1u;
}

__device__ __forceinline__ void xcd_barrier(const XcdBarrier& b, const bool leader) {
    asm volatile("s_waitcnt vmcnt(0)" ::: "memory");
    __syncthreads();
    if (leader) {
        unsigned* bar = b.bar;
        __builtin_amdgcn_s_waitcnt(0);
        unsigned nloc = b.st[0], nx = b.st[1];
        if (nloc == 0u) { xcd_barrier_complete(bar, b.x, nloc, nx); b.st[0] = nloc; b.st[1] = nx; }
        const unsigned old = xb_add(&bar[XB_XSUB(b.x)], 1u);
        const unsigned gen = old / nloc;
        if (old + 1u == (gen + 1u) * nloc) {
            __builtin_amdgcn_fence(__ATOMIC_RELEASE, "agent");
            asm volatile("s_waitcnt vmcnt(0)" ::: "memory");
            const unsigned og = xb_add(&bar[XB_TOP], 1u);
            const unsigned tg = og / nx;
            if (og + 1u == (tg + 1u) * nx) xb_add(&bar[XB_TOPGEN], 1u);
            else XB_SPIN(xb_ld(&bar[XB_TOPGEN]) == tg, bar);
            __builtin_amdgcn_fence(__ATOMIC_ACQUIRE, "agent");
            xb_add(&bar[XB_XGEN(b.x)], 1u);
            asm volatile("s_waitcnt vmcnt(0)" ::: "memory");
        } else {
            XB_SPIN(xb_ld(&bar[XB_XGEN(b.x)]) == gen, bar);
            __builtin_amdgcn_fence(__ATOMIC_ACQUIRE, "agent");
            asm volatile("s_waitcnt vmcnt(0)" ::: "memory");
        }
    }
    __syncthreads();
}

template <typename Tp> __device__ __forceinline__ Tp* inp_ptr(int i) {
    asm volatile("" : "+s"(i));
    typedef __attribute__((address_space(1))) Tp* gptr_t;
    Tp* p = (Tp*)(gptr_t)(((const __attribute__((address_space(4))) unsigned long long*)__builtin_amdgcn_kernarg_segment_ptr())[i]);
    return p;
}
constexpr int N_PHASES = 14;
__global__ void __launch_bounds__(NWAVES * 64, 2) mk_fwd(Args args) {
    extern __shared__ __attribute__((aligned(16))) unsigned char lds[];
    Frame F;
    F.lds = (LAS unsigned char*)lds;
    F.wv = __builtin_amdgcn_readfirstlane((int)threadIdx.x >> 6);
    F.lane = (int)__builtin_amdgcn_mbcnt_hi(~0u, __builtin_amdgcn_mbcnt_lo(~0u, 0u)); F.tid = F.wv * 64 + F.lane; F.wave = F.wv;
    F.G = gridDim.x; F.bid = blockIdx.x;
#define INP(i) inp_ptr<const float>(i)
#define WSP(off) ((bf16*)(inp_ptr<unsigned char>(27) + (off)))
    F.out = inp_ptr<float>(26); F.ctl = (unsigned*)inp_ptr<unsigned char>(27);
    for (int u = F.tid; u < 32; u += NWAVES * 64) ((LAS unsigned*)(F.lds + MISC_OFF))[u] = 0u;
    __syncthreads();
    XcdBarrier bar = xcd_barrier_post(F.ctl + CW_BAR, (volatile LAS unsigned*)(F.lds + MISC_OFF) + 8, F.tid == 0);
    const int lo = args.ph_lo, hi = args.ph_hi;
#ifndef PHMASK
#define PHMASK 0xFFFF
#endif
#define IN(k) ((((PHMASK) >> (k)) & 1) && lo <= (k) && (k) < hi)
#define SEAM(k) do { if (IN(k) && IN((k) + 1)) xcd_barrier(bar, F.wv == 0 && (int)__builtin_amdgcn_mbcnt_hi(~0u, __builtin_amdgcn_mbcnt_lo(~0u, 0u)) == 0); { int t_ = F.wv * 64 + (int)__builtin_amdgcn_mbcnt_hi(~0u, __builtin_amdgcn_mbcnt_lo(~0u, 0u)); asm volatile("" : "+v"(t_)); F.tid = t_; F.lane = t_ & 63; F.wave = F.wv; } } while (0)
#define PRB(k) ((PROBE_PH) == (k) || ((k) == 11 && (PROBE_PH) == 110) || ((k) == 4 && ((PROBE_PH) == 40 || (PROBE_PH) == 41)) || ((k) == 0 && ((PROBE_PH) == 100 || (PROBE_PH) == 101)))
#define REP(k) for (int rep_ = 0; rep_ < (PRB(k) ? 2 : 1); ++rep_, (PRB(k) && rep_ < 2) ? xcd_barrier(bar, F.wv == 0 && (int)__builtin_amdgcn_mbcnt_hi(~0u, __builtin_amdgcn_mbcnt_lo(~0u, 0u)) == 0) : (void)0)
    using pg8::Gemm; using pg8::StaticOrder;
    REP(0) if (IN(0)) {
        F.x = INP(0); F.mem = INP(1); F.norm_mix = INP(3); F.w_in = INP(4); F.wd_up = INP(7); F.a_up = INP(9); F.g_up = INP(10); F.w_mix = INP(16); F.norm_mem = INP(18);
        F.norm_cross = INP(17); F.norm_mlp = INP(22); F.w_q = INP(19); F.w_kv = INP(20); F.w_o = INP(21); F.w_up = INP(23); F.w_dn = INP(24);
        F.WIN = WSP(WS_WIN); F.WMIX = WSP(WS_WMIX); F.WQ = WSP(WS_WQ); F.WKV = WSP(WS_WKV); F.WO = WSP(WS_WO); F.WUP = WSP(WS_WUP); F.WDN = WSP(WS_WDN); F.WL = WSP(WS_WL);
        F.XN = WSP(WS_XN); F.MEMN = WSP(WS_MEMN);
        p0_prologue(F, rep_ ? (PROBE_PH) - 99 : 3); } SEAM(0);
    REP(1) if (IN(1)) {
        F.XN = WSP(WS_XN); F.WIN = WSP(WS_WIN); F.P = WSP(WS_P); F.MEMN = WSP(WS_MEMN); F.WKV = WSP(WS_WKV); F.MEMKV = WSP(WS_MEMKV);
        { Gemm g{F.XN, F.WIN, T, NP, DM}; StaticOrder S; S.init(T, NP, F.G, F.bid, WGM_P1); pg8::EpiB16<0> E{F.P, NP, nullptr, 0.f, 0.f};
          pg8::gemm_phase<pg8::EpiB16<0>, StaticOrder, true, true>(F.lds, g, S, E, F.wv); }
    } SEAM(1);
    if (IN(2)) { F.P = WSP(WS_P); F.AL = WSP(WS_AL); F.pos = (const int*)INP(2); F.mu = INP(5); prep_phase(F); } SEAM(2);
    REP(3) if (IN(3)) {
        F.AL = WSP(WS_AL); F.WL = WSP(WS_WL); F.EWAG = (bf16*)F.out; F.w0 = INP(6); F.a0 = INP(8); F.P = WSP(WS_P); F.MASK = (unsigned*)WSP(WS_MASK);
#ifndef SKIP_LORA
        { int kl = 256; asm volatile("" : "+s"(kl)); Gemm g{F.AL, F.WL, T, NL, kl, KL, 8, 256}; StaticOrder S; S.init(T, NL, F.G, F.bid); pg8::EpiLora E{F.EWAG, NL, F.w0, F.a0};
          pg8::gemm_phase<pg8::EpiLora, StaticOrder, true, true>(F.lds, g, S, E, F.wv); }
#endif
#ifndef SKIP_IDX
#if PROBE_PH == 30
        { int nrep = 2; asm volatile("" : "+s"(nrep)); for (int rp = 0; rp < nrep; ++rp) indexer_phase(F); }
#else
        indexer_phase(F);
#endif
#endif
    } SEAM(3);
    REP(4) if (IN(4)) { F.P = WSP(WS_P); F.EWAG = (bf16*)F.out; F.MASK = (unsigned*)WSP(WS_MASK); F.Y = WSP(WS_Y); F.mu = INP(5); F.k_k = INP(11); F.k_a = INP(12); F.r_k = INP(13);
        F.lnx_w = INP(14); F.lnx_b = INP(15); if (rep_) F.Y = WSP(WS_XN);
        mix_phase(F, CW_QUEUE + 64 * rep_, rep_ ? (PROBE_PH) - 39 : 0); } SEAM(4);
    if (IN(5)) { F.Y = WSP(WS_Y); F.WMIX = WSP(WS_WMIX); F.x = INP(0); F.XN = WSP(WS_XN); Gemm g{F.Y, F.WMIX, T, DM, DM}; StaticOrder S; S.init(T, DM, F.G, F.bid, WGM_P5); pg8::EpiResB<false, false> E{F.x, F.XN, DM, nullptr, (float*)(F.ctl + CW_SS1), 0.f, 0.f};
        pg8::gemm_phase<pg8::EpiResB<false, false>, StaticOrder, true, true>(F.lds, g, S, E, F.wv); } SEAM(5);
    if (IN(7)) { F.XN = WSP(WS_XN); F.WQ = WSP(WS_WQ); F.QC = WSP(WS_QC); Gemm g{F.XN, F.WQ, T, 512, DM}; StaticOrder S; S.init(T, 512, F.G, F.bid); pg8::EpiB16<0, true> E{F.QC, 512, (const float*)(F.ctl + CW_SS1), 1.f / DM, NORM_EPS};
        pg8::gemm_phase<pg8::EpiB16<0, true>, StaticOrder, true, true>(F.lds, g, S, E, F.wv);
        F.MEMN = WSP(WS_MEMN); F.WKV = WSP(WS_WKV); F.MEMKV = WSP(WS_MEMKV);
        { Gemm g{F.MEMN, F.WKV, TM, 1024, DM}; StaticOrder S; S.init(TM, 1024, F.G, (F.bid + F.G / 2) % F.G); pg8::EpiB16<0> E{F.MEMKV, 1024, nullptr, 0.f, 0.f};
          pg8::gemm_phase<pg8::EpiB16<0>, StaticOrder, true, true>(F.lds, g, S, E, F.wv); }
        F.w_up = INP(23); F.w_dn = INP(24); F.norm_mlp = INP(22); F.WUP = WSP(WS_WUP); F.WDN = WSP(WS_WDN);
        p7_mlp_weights(F, 160, F.G - 160);
    } SEAM(7);
    if (IN(8)) { F.QC = WSP(WS_QC); F.MEMKV = WSP(WS_MEMKV); F.OC = WSP(WS_OC); cross_phase(F); } SEAM(8);
    if (IN(9)) { F.OC = WSP(WS_OC); F.WO = WSP(WS_WO); int kl = 512; asm volatile("" : "+s"(kl)); F.XN = WSP(WS_XN); Gemm g{F.OC, F.WO, T, DM, kl}; StaticOrder S; S.init(T, DM, F.G, F.bid); pg8::EpiResB<true, false> E{nullptr, F.XN, DM, nullptr, (float*)(F.ctl + CW_SS2), 0.f, 0.f};
        pg8::gemm_phase<pg8::EpiResB<true, false>, StaticOrder, true, true>(F.lds, g, S, E, F.wv); } SEAM(9);
    REP(11) if (IN(11)) { F.XN = WSP(WS_XN); F.WUP = WSP(WS_WUP); F.ACT = WSP(WS_ACT); Gemm g{F.XN, F.WUP, T, DFF, DM}; StaticOrder S; S.init(T, DFF, F.G, F.bid, WGM_P11); pg8::EpiB16<2, false, true> E{F.ACT, DFF, nullptr, 0.f, 0.f};
        #if PROBE_PH == 110
        if (rep_) { pg8::EpiNull EN{}; pg8::gemm_phase<pg8::EpiNull, StaticOrder, true, true>(F.lds, g, S, EN, F.wv); } else
#endif
        pg8::gemm_phase<pg8::EpiB16<2, false, true>, StaticOrder, true, true>(F.lds, g, S, E, F.wv); } SEAM(11);
    if (IN(12)) { F.ACT = WSP(WS_ACT); F.WDN = WSP(WS_WDN); F.XN = WSP(WS_XN); F.norm_final = INP(25);
        Gemm g{F.ACT, F.WDN, T, DM, DFF}; pg8::PanelOrder S{F.bid};
        pg8::EpiFinal E{F.XN, DM, (const float*)(F.ctl + CW_SS2), (float*)(F.ctl + CW_SS3), F.ctl + CW_PCNT, F.norm_final, F.out, 1.f / DM, NORM_EPS, F.ctl + CW_TMO};
        pg8::gemm_phase<pg8::EpiFinal, pg8::PanelOrder, true, true>(F.lds, g, S, E, F.wv); }
#undef IN
#undef SEAM
}

extern "C" void kernel_launch(void* const* d_in, const int* in_sizes, int n_in, void* d_out, int out_size, void* d_ws, size_t ws_size, hipStream_t stream) {
    static int grid = 0;
    if (grid == 0) {
        if (n_in != 26 || in_sizes[0] != T * DM || out_size != T * DM || ws_size < WS_END) {
            fprintf(stderr, "kernel_launch: unexpected shapes: n_in %d in0 %d out %d ws %zu (need %zu)\n", n_in, n_in > 0 ? in_sizes[0] : -1, out_size, ws_size, (size_t)WS_END); grid = -1; return; }
        int dev = 0, cus = 0, per_cu = 0;
        if (hipGetDevice(&dev) != hipSuccess || hipDeviceGetAttribute(&cus, hipDeviceAttributeMultiprocessorCount, dev) != hipSuccess) { grid = -1; return; }
        if (hipFuncSetAttribute((const void*)mk_fwd, hipFuncAttributeMaxDynamicSharedMemorySize, LDS_BYTES) != hipSuccess) { fprintf(stderr, "kernel_launch: hipFuncSetAttribute failed\n"); grid = -1; return; }
        if (hipOccupancyMaxActiveBlocksPerMultiprocessor(&per_cu, (const void*)mk_fwd, NWAVES * 64, LDS_BYTES) != hipSuccess || per_cu < 1) { fprintf(stderr, "kernel_launch: occupancy query says %d\n", per_cu); per_cu = 1; }
        (void)hipGetLastError();
        grid = cus;
    }
    if (grid < 0) return;
    (void)hipMemsetAsync((char*)d_ws + WS_CTL, 0, CTL_ZERO_BYTES, stream);
    Args a{};
    for (int i = 0; i < 26; ++i) a.in[i] = d_in[i];
    a.out = (float*)d_out; a.ws = (unsigned char*)d_ws;
#if MK_ONE_LAUNCH
    a.ph_lo = 0; a.ph_hi = N_PHASES;
    void* kargs[] = {&a};
    hipError_t e = hipLaunchCooperativeKernel((const void*)mk_fwd, dim3(grid), dim3(NWAVES * 64), kargs, LDS_BYTES, stream);
    if (e != hipSuccess) fprintf(stderr, "kernel_launch: cooperative launch failed: %s (grid %d)\n", hipGetErrorString(e), grid);
#else
    for (int p = 0; p < N_PHASES; ++p) { a.ph_lo = p; a.ph_hi = p + 1; hipLaunchKernelGGL(mk_fwd, dim3(grid), dim3(NWAVES * 64), LDS_BYTES, stream, a); }
#endif
}
```

```cpp
#include <hip/hip_runtime.h>
#include <hip/hip_cooperative_groups.h>
#include <cstdio>
#include <cstdint>
namespace pg8 {
#define PG8_LAS __attribute__((address_space(3)))
typedef unsigned short bf16_t;
typedef short bf16x8 __attribute__((ext_vector_type(8)));
typedef float f32x4 __attribute__((ext_vector_type(4)));
typedef unsigned u32x4 __attribute__((ext_vector_type(4)));
constexpr int BM = 256, BK = 64, HALF = 128, HTB = HALF * BK * 2  , STAGE_BYTES = 8 * HTB, NXCD = 8, WGM = 4;

__host__ __device__ __forceinline__ int lds_byte(int r, int c) { const int st = (r >> 4) * 2 + (c >> 5), rr = r & 15, cc = c & 31, ob = rr * 64 + cc * 2; return st * 1024 + (ob ^ (((ob >> 9) & 1) << 5)); }
__host__ __device__ __forceinline__ void stage_rc(int b, int& R, int& C) { const int st = b / 1024, sb = b % 1024, swz = sb ^ (((sb >> 9) & 1) << 5); R = (st >> 1) * 16 + swz / 64; C = (st & 1) * 32 + (swz % 64) / 2; }
__host__ __device__ __forceinline__ int perm32(int rho) { const int n = rho >> 4, i = rho & 15; return 8 * (i >> 2) + 4 * n + (i & 3); }

struct Unit { int pm, pn; };
struct Gemm { const bf16_t* A; const bf16_t* Bt; int M, N, K; int ld, kpn, kofs; };

struct StaticOrder {
    int nM, nN, nwg, G, c, wgm;
    __host__ __device__ void init(int M, int N, int G_, int c_, int wgm_ = WGM) { nM = M / BM; nN = N / BM; nwg = nM * nN; G = G_; c = c_; wgm = wgm_; }
    __host__ __device__ bool next(int i, Unit& u) const {
        const long L = (long)i * G + c; if (L >= nwg) return false;
        int wgid = (int)L; { const int q = nwg / NXCD, r = nwg % NXCD, xcd = wgid % NXCD, off = wgid / NXCD; wgid = (xcd < r ? xcd * (q + 1) : r * (q + 1) + (xcd - r) * q) + off; }
        const int nig = wgm * nN, gid = wgid / nig, fm = gid * wgm, gsz = (nM - fm) < wgm ? (nM - fm) : wgm;
        u.pm = fm + ((wgid % nig) % gsz); u.pn = (wgid % nig) / gsz; return true;
    }
    __device__ __forceinline__ void a_ready(const Unit&) const {}
    __device__ __forceinline__ void done(const Unit&) const {}
};

__device__ __forceinline__ unsigned cvt_pk_bf16(float lo, float hi) { unsigned r; asm volatile("v_cvt_pk_bf16_f32 %0, %1, %2" : "=v"(r) : "v"(lo), "v"(hi)); return r; }
typedef float f32x2 __attribute__((ext_vector_type(2)));
__device__ __forceinline__ float fq_sum(float v) {
    { auto rr = __builtin_amdgcn_permlane16_swap(__float_as_uint(v), __float_as_uint(v), false, false); v = __uint_as_float(rr[0]) + __uint_as_float(rr[1]); }
    { auto rr = __builtin_amdgcn_permlane32_swap(__float_as_uint(v), __float_as_uint(v), false, false); v = __uint_as_float(rr[0]) + __uint_as_float(rr[1]); }
    return v;
}
__device__ __forceinline__ void xch8(const u32x4 a, const u32x4 b, const bool lo  , u32x4& d0, u32x4& d1) {
#pragma unroll
    for (int i = 0; i < 4; ++i) {
        const unsigned give = lo ? b[i] : a[i];
        const unsigned r = (unsigned)__builtin_amdgcn_update_dpp(0, (int)give, 0x128  , 0xF, 0xF, false);
        d0[i] = lo ? a[i] : r; d1[i] = lo ? r : b[i]; }
}
__device__ __forceinline__ u32x4 pack8(const f32x4 v0, const f32x4 v1) { u32x4 w; w.x = cvt_pk_bf16(v0[0], v0[1]); w.y = cvt_pk_bf16(v0[2], v0[3]); w.z = cvt_pk_bf16(v1[0], v1[1]); w.w = cvt_pk_bf16(v1[2], v1[3]); return w; }
template <int ACT, bool ROWSCALE = false, bool NTS = false> struct EpiB16 {
    static constexpr bool PERM = true, AFTER_DRAIN = false;
    bf16_t* O; int ldc; const float* ss; float inv_n, eps;
    __device__ __forceinline__ void operator()(const f32x4 (&acc)[2][2][4][2], const Unit& u, int wr, int wc, int fr, int fq) const {
        const int rowg = u.pm * BM + wr * 64; const bool lo = fr < 8;
        bf16_t* sp = O + (size_t)(rowg + (fr & 7)) * ldc + u.pn * BM + wc * 64 + (fr >> 3) * 32 + 8 * fq;
#pragma unroll
        for (int ai = 0; ai < 2; ++ai)
#pragma unroll
            for (int m = 0; m < 4; ++m) {
                float rs = 1.f; if (ROWSCALE) rs = __builtin_amdgcn_rsqf(ss[rowg + ai * HALF + m * 16 + fr] * inv_n + eps);
                u32x4 w[2];
#pragma unroll
                for (int bj = 0; bj < 2; ++bj) { f32x4 v0 = acc[ai][bj][m][0], v1 = acc[ai][bj][m][1];
                    if (ROWSCALE) { v0 = v0 * rs; v1 = v1 * rs; }
                    if (ACT == 2) {
#pragma unroll
                        for (int i = 0; i < 4; ++i) { float a = fmaxf(v0[i], 0.f), b = fmaxf(v1[i], 0.f); v0[i] = a * a; v1[i] = b * b; } }
                    w[bj] = pack8(v0, v1); }
                u32x4 d0, d1; xch8(w[0], w[1], lo, d0, d1);
                bf16_t* p = sp + (size_t)(ai * HALF + m * 16) * ldc;
                if (NTS) { __builtin_nontemporal_store(d0, (u32x4*)p); __builtin_nontemporal_store(d1, (u32x4*)(p + (size_t)8 * ldc)); }
                else { *(u32x4*)p = d0; *(u32x4*)(p + (size_t)8 * ldc) = d1; } }
    }
};
struct EpiLora {
    static constexpr bool PERM = true, AFTER_DRAIN = false;
    bf16_t* O; int ldc; const float* w0; const float* a0;
    __device__ __forceinline__ void operator()(const f32x4 (&acc)[2][2][4][2], const Unit& u, int wr, int wc, int fr, int fq) const {
        const int rowg = u.pm * BM + wr * 64; const bool lo = fr < 8;
        const int type = u.pn >> 2, cb0 = (u.pn & 3) * BM + wc * 64 + 8 * fq;
        const float* bias = (type == 0) ? w0 : a0;
        const float sc = (type == 0) ? 0.6065306597126334f : 1.0f;
        f32x4 bz[2][2] = {{{0.f, 0.f, 0.f, 0.f}, {0.f, 0.f, 0.f, 0.f}}, {{0.f, 0.f, 0.f, 0.f}, {0.f, 0.f, 0.f, 0.f}}};
        if (type < 2) {
#pragma unroll
            for (int bj = 0; bj < 2; ++bj) { bz[bj][0] = *(const f32x4*)(bias + cb0 + bj * 32); bz[bj][1] = *(const f32x4*)(bias + cb0 + bj * 32 + 4); } }
        bf16_t* sp = O + (size_t)(rowg + (fr & 7)) * ldc + u.pn * BM + wc * 64 + (fr >> 3) * 32 + 8 * fq;
#pragma unroll
        for (int ai = 0; ai < 2; ++ai)
#pragma unroll
            for (int m = 0; m < 4; ++m) { u32x4 w[2];
#pragma unroll
                for (int bj = 0; bj < 2; ++bj) {
                    f32x4 v0 = acc[ai][bj][m][0] + bz[bj][0], v1 = acc[ai][bj][m][1] + bz[bj][1];
                    if (type < 2) {
#pragma unroll
                        for (int i = 0; i < 4; ++i) { v0[i] = sc * __builtin_amdgcn_rcpf(1.f + __expf(-v0[i])); v1[i] = sc * __builtin_amdgcn_rcpf(1.f + __expf(-v1[i])); } }
                    w[bj] = pack8(v0, v1); }
                u32x4 d0, d1; xch8(w[0], w[1], lo, d0, d1);
                bf16_t* p = sp + (size_t)(ai * HALF + m * 16) * ldc;
                __builtin_nontemporal_store(d0, (u32x4*)p); __builtin_nontemporal_store(d1, (u32x4*)(p + (size_t)8 * ldc)); }
    }
};
struct EpiNull {
    static constexpr bool PERM = true, AFTER_DRAIN = false;
    __device__ __forceinline__ void operator()(const f32x4 (&acc)[2][2][4][2], const Unit&, int, int, int, int) const {
#pragma unroll
        for (int ai = 0; ai < 2; ++ai)
#pragma unroll
            for (int bj = 0; bj < 2; ++bj)
#pragma unroll
                for (int m = 0; m < 4; ++m)
#pragma unroll
                    for (int n = 0; n < 2; ++n) asm volatile("" :: "v"(acc[ai][bj][m][n]));
    }
};
template <bool RES_BF16, bool SCALE> struct EpiResB {
    static constexpr bool PERM = true, AFTER_DRAIN = false;
    const float* resf; bf16_t* xn; int ldc; const float* ssin; float* ssout; float inv_n, eps;
    __device__ __forceinline__ void operator()(const f32x4 (&acc)[2][2][4][2], const Unit& u, int wr, int wc, int fr, int fq) const {
        const int row0 = u.pm * BM + wr * 64 + fr, col0 = u.pn * BM + wc * 64 + 8 * fq; const bool lo = fr < 8;
        bf16_t* sp = xn + (size_t)(row0 - fr + (fr & 7)) * ldc + u.pn * BM + wc * 64 + (fr >> 3) * 32 + 8 * fq;
#pragma unroll
        for (int ai = 0; ai < 2; ++ai)
#pragma unroll
            for (int m = 0; m < 4; ++m) { const int row = row0 + ai * HALF + m * 16; const size_t off = (size_t)row * ldc + col0; float sq = 0.f;
                float s = 1.f; if (SCALE) s = __builtin_amdgcn_rcpf(ssin[row] * inv_n + eps);
                u32x4 wo[2];
#pragma unroll
                for (int bj = 0; bj < 2; ++bj) { f32x4 r0, r1;
                    if (RES_BF16) { const u32x4 w = *(const u32x4*)(xn + off + bj * 32);
                        r0 = (f32x4){__builtin_bit_cast(float, w.x << 16), __builtin_bit_cast(float, w.x & 0xffff0000u), __builtin_bit_cast(float, w.y << 16), __builtin_bit_cast(float, w.y & 0xffff0000u)};
                        r1 = (f32x4){__builtin_bit_cast(float, w.z << 16), __builtin_bit_cast(float, w.z & 0xffff0000u), __builtin_bit_cast(float, w.w << 16), __builtin_bit_cast(float, w.w & 0xffff0000u)}; }
                    else { r0 = __builtin_nontemporal_load((const f32x4*)(resf + off + bj * 32)); r1 = __builtin_nontemporal_load((const f32x4*)(resf + off + bj * 32 + 4)); }
                    const f32x4 o0 = r0 + acc[ai][bj][m][0] * s, o1 = r1 + acc[ai][bj][m][1] * s;
                    sq += (o0[0] * o0[0] + o0[1] * o0[1]) + (o0[2] * o0[2] + o0[3] * o0[3]) + (o1[0] * o1[0] + o1[1] * o1[1]) + (o1[2] * o1[2] + o1[3] * o1[3]);
                    wo[bj] = pack8(o0, o1); }
                u32x4 d0, d1; xch8(wo[0], wo[1], lo, d0, d1);
                bf16_t* p = sp + (size_t)(ai * HALF + m * 16) * ldc;
                *(u32x4*)p = d0; *(u32x4*)(p + (size_t)8 * ldc) = d1;
                sq = fq_sum(sq);
                if (fq == 0) atomicAdd(ssout + row, sq);
                asm volatile("" ::: "memory"); }
    }
};
struct PanelOrder {
    int c;
    __device__ __forceinline__ bool next(int i, Unit& u) const { if (i >= 2 || c >= 256) return false; u.pm = 32 * i + (c & 31); u.pn = c >> 5; return true; }
    __device__ __forceinline__ void a_ready(const Unit&) const {}
    __device__ __forceinline__ void done(const Unit&) const {}
};
struct EpiFinal {
    static constexpr bool PERM = true, AFTER_DRAIN = false;
    const bf16_t* xn; int ldc; const float* ssin; float* ss3; unsigned* pcnt; const float* gain; float* out; float inv_n, eps; unsigned* tmo;
    __device__ __forceinline__ void operator()(const f32x4 (&acc_)[2][2][4][2], const Unit& u, int wr, int wc, int fr, int fq) const {
        f32x4 (&acc)[2][2][4][2] = const_cast<f32x4 (&)[2][2][4][2]>(acc_);
        const int row0 = u.pm * BM + wr * 64 + fr, col0 = u.pn * BM + wc * 64 + 8 * fq; const bool lo = fr < 8;
#pragma unroll
        for (int ai = 0; ai < 2; ++ai)
#pragma unroll
            for (int m = 0; m < 4; ++m) { const int row = row0 + ai * HALF + m * 16; const size_t off = (size_t)row * ldc + col0; float sq = 0.f;
                const float s = __builtin_amdgcn_rcpf(ssin[row] * inv_n + eps);
#pragma unroll
                for (int bj = 0; bj < 2; ++bj) { const u32x4 w = *(const u32x4*)(xn + off + bj * 32);
                    const f32x4 r0 = {__builtin_bit_cast(float, w.x << 16), __builtin_bit_cast(float, w.x & 0xffff0000u), __builtin_bit_cast(float, w.y << 16), __builtin_bit_cast(float, w.y & 0xffff0000u)};
                    const f32x4 r1 = {__builtin_bit_cast(float, w.z << 16), __builtin_bit_cast(float, w.z & 0xffff0000u), __builtin_bit_cast(float, w.w << 16), __builtin_bit_cast(float, w.w & 0xffff0000u)};
                    const f32x4 o0 = r0 + acc[ai][bj][m][0] * s, o1 = r1 + acc[ai][bj][m][1] * s; acc[ai][bj][m][0] = o0; acc[ai][bj][m][1] = o1;
                    sq += (o0[0] * o0[0] + o0[1] * o0[1]) + (o0[2] * o0[2] + o0[3] * o0[3]) + (o1[0] * o1[0] + o1[1] * o1[1]) + (o1[2] * o1[2] + o1[3] * o1[3]); }
                sq = fq_sum(sq);
                if (fq == 0) atomicAdd(ss3 + row, sq);
                asm volatile("" ::: "memory"); }
        asm volatile("s_waitcnt vmcnt(0)" ::: "memory"); __syncthreads();
        unsigned* cw = pcnt + 64 * u.pm;
        if (wr == 0 && wc == 0) {
            if (fr == 0 && fq == 0) { __builtin_amdgcn_fence(__ATOMIC_RELEASE, "agent"); asm volatile("s_waitcnt vmcnt(0)" ::: "memory"); __hip_atomic_fetch_add(cw, 1u, __ATOMIC_RELAXED, __HIP_MEMORY_SCOPE_AGENT); }
            unsigned spins = 0;
            while ((unsigned)__builtin_amdgcn_readfirstlane(__hip_atomic_load(cw, __ATOMIC_RELAXED, __HIP_MEMORY_SCOPE_AGENT)) < 8u) {
                __builtin_amdgcn_s_sleep(2);
                if (++spins > (1u << 22)) { if (fr == 0 && fq == 0) __hip_atomic_store(tmo, 1u, __ATOMIC_RELAXED, __HIP_MEMORY_SCOPE_AGENT); break; } }
            __builtin_amdgcn_fence(__ATOMIC_ACQUIRE, "agent"); asm volatile("s_waitcnt vmcnt(0)" ::: "memory");
        }
        __syncthreads();
#pragma unroll
        for (int ai = 0; ai < 2; ++ai)
#pragma unroll
            for (int m = 0; m < 4; ++m) { const int row = row0 + ai * HALF + m * 16;
                const float rs = __builtin_amdgcn_rsqf(__hip_atomic_load(ss3 + row, __ATOMIC_RELAXED, __HIP_MEMORY_SCOPE_AGENT) * inv_n + eps);
                float* p = out + (size_t)(row - fr + (fr & 7)) * ldc + col0 + (fr >> 3) * 4;
#pragma unroll
                for (int bj = 0; bj < 2; ++bj) { const f32x4 g0 = *(const f32x4*)(gain + col0 + bj * 32), g1 = *(const f32x4*)(gain + col0 + bj * 32 + 4);
                    const f32x4 y0 = acc[ai][bj][m][0] * rs * g0, y1 = acc[ai][bj][m][1] * rs * g1;
                    u32x4 d0, d1; xch8(__builtin_bit_cast(u32x4, y0), __builtin_bit_cast(u32x4, y1), lo, d0, d1);
                    __builtin_nontemporal_store(d0, (u32x4*)(p + bj * 32));
                    __builtin_nontemporal_store(d1, (u32x4*)(p + bj * 32 + (size_t)8 * ldc)); } }
    }
};
template <class Epi, class Sched, bool ALIGN_EPI = false, bool SP2 = false>
__device__ __forceinline__ void gemm_phase(PG8_LAS unsigned char* lds, const Gemm g, const Sched& S, const Epi& E, const int wv  ) {
    int tid_ = wv * 64 + (int)__builtin_amdgcn_mbcnt_hi(~0u, __builtin_amdgcn_mbcnt_lo(~0u, 0u)); asm volatile("" : "+v"(tid_));
    const int tid = tid_, wid = __builtin_amdgcn_readfirstlane(tid >> 6), lane = tid & 63, wr = wid >> 2, wc = wid & 3, fr = lane & 15, fq = lane >> 4;
    const int K = g.K, nt = K / BK, LD = g.ld ? g.ld : g.K;
    unsigned voffA[2], voffB[2];
#pragma unroll
    for (int i = 0; i < 2; ++i) { int R, C; stage_rc(tid * 16 + i * 8192, R, C); const int Rb = (R >> 5) * 64 + (Epi::PERM ? perm32(R & 31) : (R & 31));
        voffA[i] = (unsigned)(R * LD + C) * 2u; voffB[i] = (unsigned)(Rb * LD + C) * 2u; }
    const size_t kstep = (size_t)(BK * 2);
    const size_t hstep = (size_t)HALF * LD * 2;
    const size_t tstep = 2 * hstep;
    const size_t hstepB = (size_t)32 * LD * 2;
    const unsigned ldsw = (unsigned)wid * 1024u;
    const int aoff = lds_byte(wr * 64 + fr, fq * 8), boff = lds_byte(wc * 32 + fr, fq * 8);
#define PG8_SA(b, h) (((b) * 2 + (h)) * HTB)
#define PG8_SB(b, h) ((4 + (b) * 2 + (h)) * HTB)
#define PG8_STAGE(bufoff, gbase, voff) do { _Pragma("unroll") for (int _i = 0; _i < 2; ++_i) \
        __builtin_amdgcn_global_load_lds((const unsigned*)((const char*)(gbase) + (voff)[_i]), (PG8_LAS unsigned*)(lds + (bufoff) + ldsw + _i * 8192), 16, 0, 0); } while (0)
#define PG8_LDA(dst, b, h) do { _Pragma("unroll") for (int m = 0; m < 4; ++m) _Pragma("unroll") for (int k = 0; k < 2; ++k) dst[m][k] = *(const PG8_LAS bf16x8*)(lds + PG8_SA(b, h) + aoff + m * 2048 + k * 1024); } while (0)
#define PG8_LDB(dst, b, h) do { _Pragma("unroll") for (int n = 0; n < 2; ++n) _Pragma("unroll") for (int k = 0; k < 2; ++k) dst[n][k] = *(const PG8_LAS bf16x8*)(lds + PG8_SB(b, h) + boff + n * 2048 + k * 1024); } while (0)
#define PG8_MMA(ai, bj, At, Bt) do { __builtin_amdgcn_s_setprio(1); _Pragma("unroll") for (int m = 0; m < 4; ++m) _Pragma("unroll") for (int n = 0; n < 2; ++n) _Pragma("unroll") for (int k = 0; k < 2; ++k) \
        acc[ai][bj][m][n] = __builtin_amdgcn_mfma_f32_16x16x32_bf16(Bt[n][k], At[m][k], acc[ai][bj][m][n], 0, 0, 0); __builtin_amdgcn_s_setprio(0); } while (0)
#define PG8_WAIT_V(n) asm volatile("s_waitcnt vmcnt(" #n ")" ::: "memory")
#define PG8_WAIT_L(n) asm volatile("s_waitcnt lgkmcnt(" #n ")" ::: "memory")
#define PG8_BAR __builtin_amdgcn_s_barrier()
#define PG8_SCHED __builtin_amdgcn_sched_barrier(0)
    Unit cur, nxt; int ui = 0;
    if (!S.next(0, cur)) return;
    f32x4 acc[2][2][4][2];
#pragma unroll
    for (int a = 0; a < 2; ++a)
#pragma unroll
        for (int b = 0; b < 2; ++b)
#pragma unroll
            for (int m = 0; m < 4; ++m)
#pragma unroll
                for (int n = 0; n < 2; ++n) acc[a][b][m][n] = (f32x4){0.f, 0.f, 0.f, 0.f};
    bf16x8 At[4][2], B0[2][2], B1[2][2];
#define PG8_KOF(u) ((size_t)((g.kofs && (u).pn >= g.kpn) ? g.kofs : 0))
    const char* cA = (const char*)g.A + (size_t)cur.pm * tstep + PG8_KOF(cur); const char* cB = (const char*)g.Bt + (size_t)cur.pn * tstep + PG8_KOF(cur);
    S.a_ready(cur);
    if constexpr (SP2) {
        PG8_STAGE(PG8_SB(0, 0), cB, voffB); PG8_STAGE(PG8_SB(0, 1), cB + hstepB, voffB); PG8_STAGE(PG8_SA(0, 0), cA, voffA); PG8_STAGE(PG8_SA(0, 1), cA + hstep, voffA);
        if (wr == 1) PG8_BAR;
        PG8_WAIT_V(2); PG8_BAR;
        PG8_STAGE(PG8_SB(1, 0), cB + kstep, voffB); PG8_STAGE(PG8_SA(1, 0), cA + kstep, voffA); PG8_STAGE(PG8_SB(1, 1), cB + hstepB + kstep, voffB);
        PG8_WAIT_V(6); PG8_BAR;
    } else {
        PG8_STAGE(PG8_SB(0, 0), cB, voffB); PG8_STAGE(PG8_SA(0, 0), cA, voffA); PG8_STAGE(PG8_SB(0, 1), cB + hstepB, voffB); PG8_STAGE(PG8_SA(0, 1), cA + hstep, voffA);
        if (wr == 1) PG8_BAR;
        PG8_WAIT_V(4); PG8_BAR;
        PG8_STAGE(PG8_SB(1, 0), cB + kstep, voffB); PG8_STAGE(PG8_SA(1, 0), cA + kstep, voffA); PG8_STAGE(PG8_SB(1, 1), cB + hstepB + kstep, voffB);
        PG8_WAIT_V(6); PG8_BAR;
    }
    for (;;) {
        const bool has_next = S.next(ui + 1, nxt);
        const char* nA = has_next ? (const char*)g.A + (size_t)nxt.pm * tstep + PG8_KOF(nxt) : cA; const char* nB = has_next ? (const char*)g.Bt + (size_t)nxt.pn * tstep + PG8_KOF(nxt) : cB;
        for (int t = 0; t < nt; t += 2) {
            const bool last = (t == nt - 2);
            const char* a1 = cA + (size_t)(t + 1) * kstep;
            const char* a2 = last ? nA : cA + (size_t)(t + 2) * kstep; const char* b2 = last ? nB : cB + (size_t)(t + 2) * kstep;
            const char* a3 = a2 + kstep; const char* b3 = b2 + kstep;
            if (last && has_next) S.a_ready(nxt);
            if constexpr (SP2) {
            PG8_LDB(B0, 0, 0); PG8_LDB(B1, 0, 1); PG8_SCHED; PG8_LDA(At, 0, 0); PG8_STAGE(PG8_SA(1, 1), a1 + hstep, voffA);
            PG8_WAIT_V(8); PG8_WAIT_L(0); PG8_BAR; PG8_MMA(0, 0, At, B0); PG8_MMA(0, 1, At, B1); PG8_BAR; PG8_SCHED;
            PG8_LDA(At, 0, 1); PG8_STAGE(PG8_SB(0, 0), b2, voffB); PG8_STAGE(PG8_SB(0, 1), b2 + hstepB, voffB); PG8_STAGE(PG8_SA(0, 0), a2, voffA);
            PG8_WAIT_V(8); PG8_WAIT_L(0); PG8_BAR; PG8_MMA(1, 0, At, B0); PG8_MMA(1, 1, At, B1); PG8_BAR; PG8_SCHED;
            PG8_LDB(B0, 1, 0); PG8_LDB(B1, 1, 1); PG8_SCHED; PG8_LDA(At, 1, 0); PG8_STAGE(PG8_SA(0, 1), a2 + hstep, voffA);
            PG8_WAIT_V(8); PG8_WAIT_L(0); PG8_BAR; PG8_MMA(0, 0, At, B0); PG8_MMA(0, 1, At, B1); PG8_BAR; PG8_SCHED;
            PG8_LDA(At, 1, 1); PG8_STAGE(PG8_SB(1, 0), b3, voffB); PG8_STAGE(PG8_SB(1, 1), b3 + hstepB, voffB); PG8_STAGE(PG8_SA(1, 0), a3, voffA);
            PG8_WAIT_V(8); PG8_WAIT_L(0); PG8_BAR; PG8_MMA(1, 0, At, B0); PG8_MMA(1, 1, At, B1); PG8_BAR; PG8_SCHED;
            } else {
            PG8_LDB(B0, 0, 0); PG8_SCHED; PG8_LDA(At, 0, 0); PG8_STAGE(PG8_SA(1, 1), a1 + hstep, voffA);
            PG8_WAIT_L(8); PG8_BAR; PG8_WAIT_L(0); PG8_MMA(0, 0, At, B0); PG8_BAR; PG8_SCHED;
            PG8_LDB(B1, 0, 1); PG8_STAGE(PG8_SB(0, 0), b2, voffB);
            PG8_BAR; PG8_WAIT_L(0); PG8_MMA(0, 1, At, B1); PG8_BAR;
            PG8_LDA(At, 0, 1); PG8_STAGE(PG8_SA(0, 0), a2, voffA);
            PG8_BAR; PG8_WAIT_L(0); PG8_MMA(1, 0, At, B0); PG8_BAR; PG8_SCHED;
            PG8_STAGE(PG8_SB(0, 1), b2 + hstepB, voffB);
            PG8_WAIT_V(6); PG8_BAR; PG8_MMA(1, 1, At, B1); PG8_BAR;
            PG8_LDB(B0, 1, 0); PG8_SCHED; PG8_LDA(At, 1, 0); PG8_STAGE(PG8_SA(0, 1), a2 + hstep, voffA);
            PG8_WAIT_L(8); PG8_BAR; PG8_WAIT_L(0); PG8_MMA(0, 0, At, B0); PG8_BAR; PG8_SCHED;
            PG8_LDB(B1, 1, 1); PG8_STAGE(PG8_SB(1, 0), b3, voffB);
            PG8_BAR; PG8_WAIT_L(0); PG8_MMA(0, 1, At, B1); PG8_BAR;
            PG8_LDA(At, 1, 1); PG8_STAGE(PG8_SA(1, 0), a3, voffA);
            PG8_BAR; PG8_WAIT_L(0); PG8_MMA(1, 0, At, B0); PG8_BAR; PG8_SCHED;
            PG8_STAGE(PG8_SB(1, 1), b3 + hstepB, voffB);
            PG8_WAIT_V(6); PG8_BAR; PG8_MMA(1, 1, At, B1); PG8_BAR;
            }
        }
        if constexpr (ALIGN_EPI) { if (wr == 0) PG8_BAR; }
        if constexpr (!Epi::AFTER_DRAIN) { E(acc, cur, wr, wc, fr, fq); S.done(cur); }
        if (!has_next) break;
#pragma unroll
        for (int a = 0; a < 2; ++a)
#pragma unroll
            for (int b = 0; b < 2; ++b)
#pragma unroll
                for (int m = 0; m < 4; ++m)
#pragma unroll
                    for (int n = 0; n < 2; ++n) acc[a][b][m][n] = (f32x4){0.f, 0.f, 0.f, 0.f};
        cur = nxt; cA = nA; cB = nB; ++ui;
        if constexpr (ALIGN_EPI) { if (wr == 1) PG8_BAR; }
    }
    PG8_WAIT_V(0);
    if constexpr (!ALIGN_EPI) { if (wr == 0) PG8_BAR; }
    PG8_BAR;
    if constexpr (Epi::AFTER_DRAIN) { E.fused(acc, cur, wr, wc, fr, fq, lds, wid, lane); S.done(cur); }
#undef PG8_KOF
#undef PG8_SA
#undef PG8_SB
#undef PG8_STAGE
#undef PG8_LDA
#undef PG8_LDB
#undef PG8_MMA
#undef PG8_WAIT_V
#undef PG8_WAIT_L
#undef PG8_BAR
#undef PG8_SCHED
}
}
namespace att {
typedef unsigned short bf16;
constexpr int   D = 128, NW = 8, QBLK = 32, KVBLK = 64;
constexpr float SCALE = 0.088388347648318440f;
constexpr float THR = 8.f;
constexpr size_t SHM_V = KVBLK * D * 2, SHM_K = KVBLK * D * 2, SHM_ATTN = 2 * SHM_V + 2 * SHM_K + NW * 64 * 4;
using bf16x8 = __attribute__((ext_vector_type(8))) short;
using s16x4  = __attribute__((ext_vector_type(4))) short;
using f32x16 = __attribute__((ext_vector_type(16))) float;
using u32x4  = __attribute__((ext_vector_type(4))) unsigned;
using u32x2  = __attribute__((ext_vector_type(2))) unsigned;
#define KSWZ(row, colB) ((row) * 256 + ((colB) ^ (((row) & 7) << 4)))
#define SBAR() __builtin_amdgcn_sched_barrier(0)
__device__ __forceinline__ int crow(int r, int hi) { return (r & 3) + 8 * (r >> 2) + 4 * hi; }
__device__ __forceinline__ unsigned cvtpk(float lo, float hi) { unsigned r; asm volatile("v_cvt_pk_bf16_f32 %0, %1, %2" : "=v"(r) : "v"(lo), "v"(hi)); return r; }
__device__ __forceinline__ void mask16(f32x16& p, unsigned mw) {
#pragma unroll
  for (int r = 0; r < 16; ++r) { const int cr = (r & 3) + 8 * (r >> 2); const int m = __builtin_amdgcn_sbfe((int)mw, cr, 1); p[r] = __uint_as_float(__float_as_uint(p[r]) & (unsigned)m); }
}
template <bool MASKED>
__device__ __forceinline__ void partialSM(f32x16& p0, f32x16& p1, float& m_reg, float& mn, float& alpha) {
  constexpr float C = SCALE * 1.4426950408889634f;
  float pmax = p0[0];
#pragma unroll
  for (int r = 1; r < 16; ++r) pmax = fmaxf(pmax, p0[r]);
#pragma unroll
  for (int r = 0; r < 16; ++r) pmax = fmaxf(pmax, p1[r]);
  { auto rr = __builtin_amdgcn_permlane32_swap(__float_as_uint(pmax), __float_as_uint(pmax), false, false);
    pmax = fmaxf(__uint_as_float(rr[0]), __uint_as_float(rr[1])); }
  if (__builtin_expect(__all(pmax - m_reg <= THR / SCALE), 1)) { mn = m_reg; alpha = 1.f; }
  else { mn = fmaxf(m_reg, pmax); alpha = __builtin_amdgcn_exp2f((m_reg - mn) * C); m_reg = mn; }
  float mnC = -mn * C;
#pragma unroll
  for (int r = 0; r < 16; ++r) p0[r] = fmaf(p0[r], C, mnC);
#pragma unroll
  for (int r = 0; r < 16; ++r) p1[r] = fmaf(p1[r], C, mnC);
#pragma unroll
  for (int r = 0; r < 16; ++r) p0[r] = __builtin_amdgcn_exp2f(p0[r]);
}
template <bool MASKED>
__device__ __forceinline__ void finishSM(f32x16& p0, f32x16& p1, float alpha, float& l_reg, bf16x8& pa0, bf16x8& pa1, bf16x8& pa2, bf16x8& pa3, unsigned mw0, unsigned mw1) {
#pragma unroll
  for (int r = 0; r < 16; ++r) p1[r] = __builtin_amdgcn_exp2f(p1[r]);
  if (MASKED) { mask16(p0, mw0); mask16(p1, mw1); }
  float ps = 0;
#pragma unroll
  for (int r = 0; r < 16; ++r) ps += p0[r];
#pragma unroll
  for (int r = 0; r < 16; ++r) ps += p1[r];
  { auto rr = __builtin_amdgcn_permlane32_swap(__float_as_uint(ps), __float_as_uint(ps), false, false);
    ps = __uint_as_float(rr[0]) + __uint_as_float(rr[1]); }
  l_reg = l_reg * alpha + ps;
#define PK4(P, BASE, OUT) do { unsigned a0 = cvtpk(P[BASE + 0], P[BASE + 1]), a1 = cvtpk(P[BASE + 2], P[BASE + 3]);   \
    unsigned b0 = cvtpk(P[BASE + 4], P[BASE + 5]), b1 = cvtpk(P[BASE + 6], P[BASE + 7]);                              \
    auto r0 = __builtin_amdgcn_permlane32_swap(a0, b0, false, false); auto r1 = __builtin_amdgcn_permlane32_swap(a1, b1, false, false); \
    u32x4 w = {r0[0], r1[0], r0[1], r1[1]}; OUT = *reinterpret_cast<bf16x8*>(&w); } while (0)
  PK4(p0, 0, pa0); PK4(p0, 8, pa1); PK4(p1, 0, pa2); PK4(p1, 8, pa3);
#undef PK4
}
__device__ __forceinline__ void qkt(f32x16& p0, f32x16& p1, const bf16* Ks, const bf16x8* qr, int r32, int hi) {
  p0 = f32x16{}; p1 = f32x16{};
#pragma unroll
  for (int d0 = 0; d0 < 8; ++d0) { int cb = (d0 * 16 + hi * 8) * 2;
    bf16x8 b0 = *reinterpret_cast<const bf16x8*>((const char*)Ks + KSWZ(r32, cb));
    bf16x8 b1 = *reinterpret_cast<const bf16x8*>((const char*)Ks + KSWZ(32 + r32, cb));
    p0 = __builtin_amdgcn_mfma_f32_32x32x16_bf16(b0, qr[d0], p0, 0, 0, 0);
    p1 = __builtin_amdgcn_mfma_f32_32x32x16_bf16(b1, qr[d0], p1, 0, 0, 0); }
}
__device__ __forceinline__ int v_st(int k, int c) { const int kk = (k & ~0xC) | ((k & 4) << 1) | ((k & 8) >> 1); return ((kk >> 3) * 4 + (c >> 5)) * 512 + ((kk & 7) * 32 + (c & 31)) * 2; }
__device__ __forceinline__ int v_rd_base(int lane) { return ((lane & 3) << 3) | (((lane >> 2) & 3) << 6) | (((lane >> 4) & 1) << 5) | (((lane >> 5) & 1) << 8); }
constexpr int v_rd_off(int d0, int ks, int half) { return d0 * 512 + ks * 4096 + half * 2048; }
template <int OFF> __device__ __forceinline__ s16x4 tr_read(int vb) {
  s16x4 r; asm volatile("ds_read_b64_tr_b16 %0, %1 offset:%2" : "=&v"(r) : "v"(vb), "i"(OFF) : "memory"); return r;
}
template <int D0> __device__ __forceinline__ void pv_one(f32x16& od, int vb, bf16x8 pa0, bf16x8 pa1, bf16x8 pa2, bf16x8 pa3) {
  const s16x4 l0 = tr_read<v_rd_off(D0, 0, 0)>(vb), h0 = tr_read<v_rd_off(D0, 0, 1)>(vb), l1 = tr_read<v_rd_off(D0, 1, 0)>(vb), h1 = tr_read<v_rd_off(D0, 1, 1)>(vb);
  const s16x4 l2 = tr_read<v_rd_off(D0, 2, 0)>(vb), h2 = tr_read<v_rd_off(D0, 2, 1)>(vb), l3 = tr_read<v_rd_off(D0, 3, 0)>(vb), h3 = tr_read<v_rd_off(D0, 3, 1)>(vb);
  asm volatile("s_waitcnt lgkmcnt(0)" ::: "memory"); SBAR();
#define PK(L, H) (bf16x8){L[0], L[1], L[2], L[3], H[0], H[1], H[2], H[3]}
  od = __builtin_amdgcn_mfma_f32_32x32x16_bf16(pa0, PK(l0, h0), od, 0, 0, 0);
  od = __builtin_amdgcn_mfma_f32_32x32x16_bf16(pa1, PK(l1, h1), od, 0, 0, 0);
  od = __builtin_amdgcn_mfma_f32_32x32x16_bf16(pa2, PK(l2, h2), od, 0, 0, 0);
  od = __builtin_amdgcn_mfma_f32_32x32x16_bf16(pa3, PK(l3, h3), od, 0, 0, 0);
#undef PK
}
__device__ __forceinline__ void pv_d0(f32x16* o, int vb, bf16x8 pa0, bf16x8 pa1, bf16x8 pa2, bf16x8 pa3) {
  pv_one<0>(o[0], vb, pa0, pa1, pa2, pa3); pv_one<1>(o[1], vb, pa0, pa1, pa2, pa3); pv_one<2>(o[2], vb, pa0, pa1, pa2, pa3); pv_one<3>(o[3], vb, pa0, pa1, pa2, pa3);
}
template <int LDQ, int LDK, int LDO, bool MASKED, int SDEPTH>
__device__ __forceinline__ void attn_body(const bf16* __restrict__ Qb, const bf16* __restrict__ Kh, const bf16* __restrict__ Vh,
                                          bf16* __restrict__ Ob, const unsigned* __restrict__ mrow0, int seq, char* lds, const int wv) {
  int tid_ = wv * 64 + (int)__builtin_amdgcn_mbcnt_hi(~0u, __builtin_amdgcn_mbcnt_lo(~0u, 0u)); asm volatile("" : "+v"(tid_));
  const int tid = tid_, wid = tid >> 6, lane = tid & 63, r32 = lane & 31, hi = lane >> 5;
  bf16* V_lds = (bf16*)lds; bf16* K_lds = (bf16*)(lds + 2 * SHM_V);
  float* ws = (float*)(lds + 2 * SHM_V + 2 * SHM_K) + wid * 64; float* li_l = ws; float* al_l = ws + 32;
  float m_reg = -1e30f, l_reg = 0; f32x16 o[4] = {}; bf16x8 qr[8];
  const bf16* Qw = Qb + (long)(wid * QBLK + r32) * LDQ + hi * 8;
#pragma unroll
  for (int d0 = 0; d0 < 8; ++d0) qr[d0] = *reinterpret_cast<const bf16x8*>(Qw + d0 * 16);
  const int msh = 4 * hi;
  u32x2* mlds = (u32x2*)(lds + SHM_ATTN);
  if (MASKED) {
#pragma unroll 4
    for (int i = 0; i < 16; ++i) { const int idx = tid + 512 * i; mlds[(idx >> 5) * 33 + (idx & 31)] = *reinterpret_cast<const u32x2*>(mrow0 + 2 * idx); }
  }
  const int mro = (wid * QBLK + r32) * 33;
#define MLOAD(j) (MASKED ? mlds[mro + (j)] : (u32x2){0u, 0u})
  const int sr = tid >> 4, sc = (tid & 15) * 8, vst0 = v_st(sr, sc), vst1 = v_st(32 + sr, sc);
  const int vb0 = (int)(uintptr_t)V_lds + v_rd_base(lane);
  struct { bf16x8 vs0, vs1, ks0, ks1; } sr_[SDEPTH];
#define SLOAD(i, k0) do { sr_[i].vs0 = *reinterpret_cast<const bf16x8*>(&Vh[(long)((k0) + sr) * LDK + sc]); sr_[i].vs1 = *reinterpret_cast<const bf16x8*>(&Vh[(long)((k0) + 32 + sr) * LDK + sc]); \
    sr_[i].ks0 = *reinterpret_cast<const bf16x8*>(&Kh[(long)((k0) + sr) * LDK + sc]); sr_[i].ks1 = *reinterpret_cast<const bf16x8*>(&Kh[(long)((k0) + 32 + sr) * LDK + sc]); } while (0)
#define SWRITE(b, i) do { *(bf16x8*)((char*)V_lds + (b) * SHM_V + vst0) = sr_[i].vs0;          \
    *(bf16x8*)((char*)V_lds + (b) * SHM_V + vst1) = sr_[i].vs1; int kc = sc * 2;               \
    *(bf16x8*)((char*)K_lds + (b) * SHM_K + KSWZ(sr, kc)) = sr_[i].ks0;                       \
    *(bf16x8*)((char*)K_lds + (b) * SHM_K + KSWZ(32 + sr, kc)) = sr_[i].ks1; } while (0)
#define SWAIT() do { if constexpr (SDEPTH == 2) asm volatile("s_waitcnt vmcnt(4)" ::: "memory"); else asm volatile("s_waitcnt vmcnt(0)" ::: "memory"); } while (0)
#define RESC(a) do { if (__any((a) < 1.f)) { if (hi == 0) al_l[r32] = (a); asm volatile("s_waitcnt lgkmcnt(0)" ::: "memory"); \
    _Pragma("unroll") for (int d = 0; d < 4; ++d) _Pragma("unroll") for (int r = 0; r < 16; ++r) o[d][r] *= al_l[crow(r, hi)]; } } while (0)
  f32x16 pA0, pA1, pB0, pB1; float mnA, mnB, alA, alB; bf16x8 pa0, pa1, pa2, pa3; const int NT = seq / KVBLK;
  u32x2 mwA, mwB;
  constexpr int SE = 0, SO = SDEPTH - 1;
  SLOAD(SE, 0); asm volatile("s_waitcnt vmcnt(0)" ::: "memory"); SWRITE(0, SE); __syncthreads();
  qkt(pA0, pA1, K_lds, qr, r32, hi); partialSM<MASKED>(pA0, pA1, m_reg, mnA, alA);
  SLOAD(SO, KVBLK); if constexpr (SDEPTH == 2) { if (2 < NT) SLOAD(SE, 2 * KVBLK); }
  SWAIT(); SWRITE(1, SO); __syncthreads();
  for (int j = 1; j + 1 < NT; j += 2) {
    mwA = MLOAD(j - 1);
    SBAR(); qkt(pB0, pB1, (bf16*)((char*)K_lds + SHM_K), qr, r32, hi);
    finishSM<MASKED>(pA0, pA1, alA, l_reg, pa0, pa1, pa2, pa3, mwA[0] >> msh, mwA[1] >> msh); SBAR();
    SLOAD(SO, (j + SDEPTH) * KVBLK); SBAR();
    pv_d0(o, vb0, pa0, pa1, pa2, pa3); partialSM<MASKED>(pB0, pB1, m_reg, mnB, alB);
    __syncthreads(); SWAIT(); SWRITE(0, SE);
    RESC(alB); __syncthreads();
    mwB = MLOAD(j);
    SBAR(); qkt(pA0, pA1, K_lds, qr, r32, hi);
    finishSM<MASKED>(pB0, pB1, alB, l_reg, pa0, pa1, pa2, pa3, mwB[0] >> msh, mwB[1] >> msh); SBAR();
    if (SDEPTH == 1 || j + 3 < NT) SLOAD(SE, (j + 1 + SDEPTH) * KVBLK); SBAR();
    pv_d0(o, vb0 + (int)SHM_V, pa0, pa1, pa2, pa3); partialSM<MASKED>(pA0, pA1, m_reg, mnA, alA);
    __syncthreads(); SWAIT(); SWRITE(1, SO);
    RESC(alA); __syncthreads();
  }
  mwA = MLOAD(NT - 2);
  SBAR(); qkt(pB0, pB1, (bf16*)((char*)K_lds + SHM_K), qr, r32, hi);
  finishSM<MASKED>(pA0, pA1, alA, l_reg, pa0, pa1, pa2, pa3, mwA[0] >> msh, mwA[1] >> msh); SBAR();
  pv_d0(o, vb0, pa0, pa1, pa2, pa3); partialSM<MASKED>(pB0, pB1, m_reg, mnB, alB);
  __syncthreads(); RESC(alB);
  mwB = MLOAD(NT - 1);
  finishSM<MASKED>(pB0, pB1, alB, l_reg, pa0, pa1, pa2, pa3, mwB[0] >> msh, mwB[1] >> msh); SBAR();
  pv_d0(o, vb0 + (int)SHM_V, pa0, pa1, pa2, pa3);
  if (hi == 0) li_l[r32] = l_reg; asm volatile("s_waitcnt lgkmcnt(0)" ::: "memory");
  float rli[16];
#pragma unroll
  for (int r = 0; r < 16; ++r) rli[r] = __builtin_amdgcn_rcpf(li_l[crow(r, hi)]);
  bf16* Ow = Ob + (long)(wid * QBLK) * LDO;
#pragma unroll
  for (int r = 0; r < 16; ++r) { int orow = crow(r, hi);
#pragma unroll
    for (int d0 = 0; d0 < 4; ++d0) { const float v = o[d0][r] * rli[r]; unsigned u = __float_as_uint(v); u = (u + 0x7fffu + ((u >> 16) & 1u)) >> 16;
      Ow[(long)orow * LDO + d0 * 32 + r32] = (bf16)u; } }
  __syncthreads();
#undef SLOAD
#undef SWRITE
#undef SWAIT
#undef RESC
#undef MLOAD
}
#undef KSWZ
#undef SBAR
}
namespace cg = cooperative_groups;
constexpr int NWAVES = 8;
#ifndef WGM_P1
#define WGM_P1 4
#endif
#ifndef WGM_P11
#define WGM_P11 4
#endif
#ifndef WGM_P5
#define WGM_P5 2
#endif
#ifndef PROBE_PH
#define PROBE_PH -1
#endif
#ifndef ATT_SD
#define ATT_SD 2
#endif
#ifndef MK_ONE_LAUNCH
#define MK_ONE_LAUNCH 1
#endif
constexpr int NB = 8, SEQ = 2048, DM = 2048, T = NB * SEQ, NMEM = 256, TM = NB * NMEM;
constexpr int NIN = 6000, NP = 6144;
constexpr int C_R = 0, C_K = 1024, C_V = 2048, C_XW = 3072, C_XA = 3136, C_XG = 3200, C_Q = 3360, C_AK = 4384, C_AV = 4640, C_QI = 4896, C_KI = 5920, C_WI = 5984;
constexpr int DFF = 8192, NL = 3072, KL = 384;
constexpr float NORM_EPS = 1e-5f, RWKV_LN_EPS = 64e-5f;
constexpr size_t MiB = 1u << 20;
constexpr size_t WS_CTL = 0, CTL_ZERO_BYTES = 384 * 1024;
constexpr size_t WS_WIN = 2 * MiB, WS_WMIX = 26 * MiB, WS_WQ = 34 * MiB, WS_WKV = 36 * MiB, WS_WO = 40 * MiB, WS_WUP = 42 * MiB, WS_WDN = 74 * MiB, WS_WL = 106 * MiB;
constexpr size_t WS_XN = 110 * MiB, WS_MEMN = 174 * MiB, WS_MEMKV = 182 * MiB, WS_AL = 186 * MiB, WS_MASK = 198 * MiB, WS_QC = 202 * MiB, WS_OC = 218 * MiB;
constexpr size_t WS_Y = 236 * MiB, WS_P = 300 * MiB, WS_ACT = 236 * MiB, WS_END = 492 * MiB;
static_assert(WS_WL + (size_t)NL * KL * 2 <= WS_XN && WS_AL + (size_t)T * KL * 2 <= WS_MASK && WS_P + (size_t)T * NP * 2 <= WS_END && WS_ACT + (size_t)T * DFF * 2 <= WS_END, "ws map");
constexpr int CW_QUEUE = 64;
constexpr int CW_BAR = 4096;
constexpr int CW_SS1 = 32768, CW_SS2 = CW_SS1 + T, CW_SS3 = CW_SS2 + T, CW_PCNT = CW_SS3 + T + 64, CW_TMO = 2048;
static_assert((CW_PCNT + 64 * 64) * 4 <= (int)CTL_ZERO_BYTES, "control words inside the memset");
constexpr int RING_BYTES = 131072, LDS_BYTES = 147456, MISC_OFF = LDS_BYTES - 256;

#define GAS __attribute__((address_space(1)))
#define LAS __attribute__((address_space(3)))
typedef unsigned short bf16;
typedef unsigned v4u __attribute__((ext_vector_type(4)));
typedef unsigned v2u __attribute__((ext_vector_type(2)));
typedef float f32x4 __attribute__((ext_vector_type(4)));
typedef float f32x16 __attribute__((ext_vector_type(16)));
typedef short bf16x8 __attribute__((ext_vector_type(8)));
typedef GAS unsigned gu32;
#define RLX_AGENT __ATOMIC_RELAXED, __HIP_MEMORY_SCOPE_AGENT
#define LDS_WAIT() asm volatile("s_waitcnt lgkmcnt(0)" ::: "memory")
#define VM_WAIT() asm volatile("s_waitcnt vmcnt(0)" ::: "memory")
__device__ __forceinline__ unsigned f2bf(float f) { unsigned u = __builtin_bit_cast(unsigned, f); return (u + 0x7fffu + ((u >> 16) & 1u)) >> 16; }
__device__ __forceinline__ unsigned pk2(float lo, float hi) { return f2bf(lo) | (f2bf(hi) << 16); }
__device__ __forceinline__ float bf2f(unsigned short h) { return __builtin_bit_cast(float, (unsigned)h << 16); }
__device__ __forceinline__ float bflo(unsigned w) { return __builtin_bit_cast(float, w << 16); }
__device__ __forceinline__ float bfhi(unsigned w) { return __builtin_bit_cast(float, w & 0xffff0000u); }
__device__ __forceinline__ float wave_sum(float v) {
#pragma unroll
    for (int o = 1; o < 64; o <<= 1) v += __shfl_xor(v, o);
    return v;
}
__device__ __forceinline__ float quad_sum(float v) {
    v += __builtin_bit_cast(float, __builtin_amdgcn_update_dpp(0, __builtin_bit_cast(int, v), 0xB1, 0xF, 0xF, false));
    v += __builtin_bit_cast(float, __builtin_amdgcn_update_dpp(0, __builtin_bit_cast(int, v), 0x4E, 0xF, 0xF, false));
    return v;
}

struct Args { const void* in[26]; float* out; unsigned char* ws; int ph_lo, ph_hi; };

struct Frame {
    LAS unsigned char* lds; int tid, lane, wave, G, bid, wv;
    const float *x, *mem; const int* pos;
    const float *norm_mix, *w_in, *mu, *w0, *wd_up, *a0, *a_up, *g_up, *k_k, *k_a, *r_k, *lnx_w, *lnx_b, *w_mix, *norm_cross, *norm_mem, *w_q, *w_kv, *w_o, *norm_mlp, *w_up, *w_dn, *norm_final;
    float* out; unsigned* ctl;
    bf16 *WIN, *WMIX, *WQ, *WKV, *WO, *WUP, *WDN, *WL, *XN, *MEMN, *MEMKV, *AL, *QC, *OC, *Y, *P, *ACT, *EWAG; unsigned* MASK;
};

__device__ __forceinline__ void p0_transpose_item(const float* W, int K, int N, int NPAD, bf16* WT, LAS float* scr, int item, int lane, const float* gain = nullptr) {
    const int nblk = NPAD / 64, kb = item / nblk, nb = item % nblk, k0 = 64 * kb, n0 = 64 * nb;
    const int c4 = (lane & 15) * 4, kr = lane >> 4; const bool ok = (n0 + c4) < N;
    f32x4 v[16];
#pragma unroll
    for (int i = 0; i < 16; ++i) v[i] = ok ? __builtin_nontemporal_load((const f32x4*)(W + (size_t)(k0 + kr + 4 * i) * N + n0 + c4)) : (f32x4){0.f, 0.f, 0.f, 0.f};
#pragma unroll
    for (int i = 0; i < 16; ++i) { LAS float* s = scr + (kr + 4 * i) * 65 + c4; const float gk = gain ? gain[k0 + kr + 4 * i] : 1.f; s[0] = v[i].x * gk; s[1] = v[i].y * gk; s[2] = v[i].z * gk; s[3] = v[i].w * gk; }
    LDS_WAIT(); asm volatile("" ::: "memory");
    const int c = lane & 7;
#pragma unroll
    for (int j = 0; j < 8; ++j) { const int n = (lane >> 3) + 8 * j; const LAS float* s = scr + (8 * c) * 65 + n;
        v4u o; o.x = pk2(s[0 * 65], s[1 * 65]); o.y = pk2(s[2 * 65], s[3 * 65]); o.z = pk2(s[4 * 65], s[5 * 65]); o.w = pk2(s[6 * 65], s[7 * 65]);
        *(v4u*)(WT + (size_t)(n0 + n) * K + k0 + 8 * c) = o; }
    LDS_WAIT(); asm volatile("" ::: "memory");
}
__device__ __forceinline__ void rms_row_to_bf16(const float* xrow, const float* g, bf16* orow, int lane) {
    const f32x4* xr = (const f32x4*)xrow + lane; const f32x4* gr = (const f32x4*)g + lane;
    f32x4 v[8]; float s = 0.f;
#pragma unroll
    for (int j = 0; j < 8; ++j) { v[j] = __builtin_nontemporal_load(xr + 64 * j); s += (v[j].x * v[j].x + v[j].y * v[j].y) + (v[j].z * v[j].z + v[j].w * v[j].w); }
    const float rstd = 1.f / sqrtf(wave_sum(s) * (1.f / DM) + NORM_EPS);
    v2u* o8 = (v2u*)orow + lane;
#pragma unroll
    for (int j = 0; j < 8; ++j) { const f32x4 gg = gr[64 * j]; v2u w; w.x = pk2(v[j].x * rstd * gg.x, v[j].y * rstd * gg.y); w.y = pk2(v[j].z * rstd * gg.z, v[j].w * rstd * gg.w); o8[64 * j] = w; }
}
__device__ __forceinline__ void p0_prologue(Frame& F, int part = 3) {
    LAS float* scr = (LAS float*)(F.lds + F.wave * 16640);
    const int gw = F.bid * NWAVES + F.wave, NGW = F.G * NWAVES;
    constexpr int I_IN = (DM / 64) * (NP / 64), I_MIX = (DM / 64) * (DM / 64), I_Q = (DM / 64) * (512 / 64), I_KV = (DM / 64) * (1024 / 64), I_O = (512 / 64) * (DM / 64),
                  I_UP = (DM / 64) * (DFF / 64), I_DN = (DFF / 64) * (DM / 64);
    constexpr int NITEMS = I_IN + I_MIX + I_Q + I_KV + I_O;
    if (part & 1)
    for (int it = gw; it < NITEMS; it += NGW) {
        int r = it;
        if (r < I_IN) { p0_transpose_item(F.w_in, DM, NIN, NP, F.WIN, scr, r, F.lane); continue; } r -= I_IN;
        if (r < I_MIX) { p0_transpose_item(F.w_mix, DM, DM, DM, F.WMIX, scr, r, F.lane); continue; } r -= I_MIX;
        if (r < I_Q) { p0_transpose_item(F.w_q, DM, 512, 512, F.WQ, scr, r, F.lane, F.norm_cross); continue; } r -= I_Q;
        if (r < I_KV) { p0_transpose_item(F.w_kv, DM, 1024, 1024, F.WKV, scr, r, F.lane); continue; } r -= I_KV;
        if (r < I_O) { p0_transpose_item(F.w_o, 512, DM, DM, F.WO, scr, r, F.lane); continue; } r -= I_O;
    }
    if (part & 1)
    for (int idx = F.bid * 512 + F.tid; idx < NL * (KL / 8); idx += F.G * 512) {
        const int n = idx % NL, k0 = (idx / NL) * 8, ty = n >> 10, c = n & 1023; float v[8];
#pragma unroll
        for (int i = 0; i < 8; ++i) { const int k = k0 + i; float x = 0.f;
            if (ty == 0) { if (k < 64) x = F.wd_up[(size_t)k * 1024 + c]; }
            else if (ty == 1) { if (k >= 64 && k < 128) x = F.a_up[(size_t)(k - 64) * 1024 + c]; }
            else { if (k >= 128 && k < 288) x = F.g_up[(size_t)(k - 128) * 1024 + c]; }
            v[i] = x; }
        v4u o; o.x = pk2(v[0], v[1]); o.y = pk2(v[2], v[3]); o.z = pk2(v[4], v[5]); o.w = pk2(v[6], v[7]);
        *(v4u*)(F.WL + (size_t)n * KL + k0) = o;
    }
    if (part & 2)
    for (int m = gw; m < T; m += NGW) rms_row_to_bf16(F.x + (size_t)m * DM, F.norm_mix, F.XN + (size_t)m * DM, F.lane);
    for (int m = gw; m < TM; m += NGW) rms_row_to_bf16(F.mem + (size_t)m * DM, F.norm_mem, F.MEMN + (size_t)m * DM, F.lane);
}
__device__ __forceinline__ void p7_mlp_weights(Frame& F, int blk0, int nblk) {
    const int me = F.bid - blk0; if (me < 0 || me >= nblk) return;
    LAS float* scr = (LAS float*)(F.lds + F.wave * 16640);
    constexpr int I_UP = (DM / 64) * (DFF / 64), I_DN = (DFF / 64) * (DM / 64);
    for (int it = me * NWAVES + F.wave; it < I_UP + I_DN; it += nblk * NWAVES) {
        if (it < I_UP) p0_transpose_item(F.w_up, DM, DFF, DFF, F.WUP, scr, it, F.lane, F.norm_mlp);
        else p0_transpose_item(F.w_dn, DFF, DM, DM, F.WDN, scr, it - I_UP, F.lane);
    }
}
__device__ __forceinline__ void norm_phase(Frame& F, const float* g) {
    const int gw = F.bid * NWAVES + F.wave, NGW = F.G * NWAVES;
    for (int m = gw; m < T; m += NGW) rms_row_to_bf16(F.out + (size_t)m * DM, g, F.XN + (size_t)m * DM, F.lane);
}
__device__ __forceinline__ void final_norm_phase(Frame& F) {
    const int gw = F.bid * NWAVES + F.wave, NGW = F.G * NWAVES;
    for (int m = gw; m < T; m += NGW) {
        const v4u* xr = (const v4u*)(F.XN + (size_t)m * DM) + F.lane; f32x4* orow = (f32x4*)(F.out + (size_t)m * DM); const f32x4* gr = (const f32x4*)F.norm_final;
        v4u w[4]; float s = 0.f;
#pragma unroll
        for (int j = 0; j < 4; ++j) { w[j] = __builtin_nontemporal_load(xr + 64 * j);
            const float a0 = bflo(w[j].x), a1 = bfhi(w[j].x), a2 = bflo(w[j].y), a3 = bfhi(w[j].y), a4 = bflo(w[j].z), a5 = bfhi(w[j].z), a6 = bflo(w[j].w), a7 = bfhi(w[j].w);
            s += (a0 * a0 + a1 * a1) + (a2 * a2 + a3 * a3) + (a4 * a4 + a5 * a5) + (a6 * a6 + a7 * a7); }
        const float rstd = 1.f / sqrtf(wave_sum(s) * (1.f / DM) + NORM_EPS);
#pragma unroll
        for (int j = 0; j < 4; ++j) { const int c4 = (64 * j + F.lane) * 2; const f32x4 g0 = gr[c4], g1 = gr[c4 + 1];
            __builtin_nontemporal_store((f32x4){bflo(w[j].x) * rstd * g0.x, bfhi(w[j].x) * rstd * g0.y, bflo(w[j].y) * rstd * g0.z, bfhi(w[j].y) * rstd * g0.w}, orow + c4);
            __builtin_nontemporal_store((f32x4){bflo(w[j].z) * rstd * g1.x, bfhi(w[j].z) * rstd * g1.y, bflo(w[j].w) * rstd * g1.z, bfhi(w[j].w) * rstd * g1.w}, orow + c4 + 1); }
    }
}

__device__ __forceinline__ void prep_phase(Frame& F) {
    const int gw = F.bid * NWAVES + F.wave, NGW = F.G * NWAVES, lane = F.lane;
    LAS float* cs0 = (LAS float*)(F.lds + F.wave * 512);
    int c1 = 0, c2 = 0, fi0 = 0;
    if (lane < 16) { c1 = C_Q + (lane >> 1) * 128 + (lane & 1) * 8; c2 = c1 + 16; fi0 = (lane & 1) * 8; }
    else if (lane < 20) { const int j = lane - 16; c1 = C_AK + (j >> 1) * 128 + (j & 1) * 8; c2 = c1 + 16; fi0 = (j & 1) * 8; }
    else if (lane < 36) { c1 = C_QI + (lane - 20) * 64; c2 = c1 + 8; fi0 = 16; }
    else { c1 = C_KI; c2 = c1 + 8; fi0 = 16; }
    const bool rope_l = lane < 37, lora_l = lane < 36, pad_l = lane < 48;
    const int j0 = lane * 8;
    f32x4 mu0 = {0.f, 0.f, 0.f, 0.f}, mu1 = mu0;
    if (lora_l) { mu0 = *(const f32x4*)(F.mu + C_XW + j0); mu1 = *(const f32x4*)(F.mu + C_XW + j0 + 4); }
    const float fe = (lane < 16) ? (float)lane * (1.f / 16.f) : (float)(lane - 16) * (1.f / 8.f);
    const float invf = exp2f(-fe * 18.931568569324174f);
    for (int mb = gw; mb < T; mb += 2 * NGW) {
        v4u x1[2], x2[2], cu[2], pv[2]; float posf[2]; bool val[2];
#pragma unroll
        for (int u = 0; u < 2; ++u) { const int mm = mb + u * NGW; val[u] = mm < T; const int ms = val[u] ? mm : mb; bf16* prow = F.P + (size_t)ms * NP;
            x1[u] = (v4u){0u, 0u, 0u, 0u}; x2[u] = x1[u]; cu[u] = x1[u]; pv[u] = x1[u];
            if (rope_l) { x1[u] = *(const v4u*)(prow + c1); x2[u] = *(const v4u*)(prow + c2); }
            if (lora_l) { cu[u] = *(const v4u*)(prow + C_XW + j0); if ((ms & (SEQ - 1)) > 0) pv[u] = *(const v4u*)(prow - NP + C_XW + j0); }
            posf[u] = (float)F.pos[ms]; }
#pragma unroll
        for (int u = 0; u < 2; ++u) if (lane < 24) {
            const float ang = posf[u] * invf; const float k = rintf(ang * 0.15915494309189535f);
            float r = fmaf(-k, 6.2831854820251465f, ang); r = fmaf(-k, -1.7484555e-7f, r);
            cs0[u * 64 + lane] = __cosf(r); cs0[u * 64 + 32 + lane] = __sinf(r); }
        LDS_WAIT(); asm volatile("" ::: "memory");
#pragma unroll
        for (int u = 0; u < 2; ++u) { const int mm = mb + u * NGW; if (!val[u]) continue; bf16* prow = F.P + (size_t)mm * NP;
            if (rope_l) { const LAS float* cs = cs0 + u * 64 + fi0;
                const f32x4 ca = *(const LAS f32x4*)(cs), cb = *(const LAS f32x4*)(cs + 4), sa = *(const LAS f32x4*)(cs + 32), sb = *(const LAS f32x4*)(cs + 36);
                const float co[8] = {ca.x, ca.y, ca.z, ca.w, cb.x, cb.y, cb.z, cb.w}, si[8] = {sa.x, sa.y, sa.z, sa.w, sb.x, sb.y, sb.z, sb.w};
                const unsigned a[4] = {x1[u].x, x1[u].y, x1[u].z, x1[u].w}, bq[4] = {x2[u].x, x2[u].y, x2[u].z, x2[u].w}; unsigned o1[4], o2[4];
#pragma unroll
                for (int e = 0; e < 4; ++e) { const float p0 = bflo(a[e]), p1 = bfhi(a[e]), q0 = bflo(bq[e]), q1 = bfhi(bq[e]);
                    o1[e] = pk2(p0 * co[2 * e] - q0 * si[2 * e], p1 * co[2 * e + 1] - q1 * si[2 * e + 1]);
                    o2[e] = pk2(q0 * co[2 * e] + p0 * si[2 * e], q1 * co[2 * e + 1] + p1 * si[2 * e + 1]); }
                *(v4u*)(prow + c1) = (v4u){o1[0], o1[1], o1[2], o1[3]}; *(v4u*)(prow + c2) = (v4u){o2[0], o2[1], o2[2], o2[3]}; }
            if (pad_l) { unsigned o[4] = {0u, 0u, 0u, 0u};
                if (lora_l) { const unsigned cw[4] = {cu[u].x, cu[u].y, cu[u].z, cu[u].w}, pw_[4] = {pv[u].x, pv[u].y, pv[u].z, pv[u].w};
                    const float mu8[8] = {mu0.x, mu0.y, mu0.z, mu0.w, mu1.x, mu1.y, mu1.z, mu1.w};
#pragma unroll
                    for (int e = 0; e < 4; ++e) { float v2[2];
#pragma unroll
                        for (int q = 0; q < 2; ++q) { const float xc = q ? bfhi(cw[e]) : bflo(cw[e]), xp = q ? bfhi(pw_[e]) : bflo(pw_[e]); const float xm = xc + (xp - xc) * mu8[2 * e + q];
                            float v = xm;
                            if (j0 < 64) v = 1.f - 2.f * __builtin_amdgcn_rcpf(1.f + __expf(2.f * xm));
                            else if (j0 >= 128) v = __builtin_amdgcn_rcpf(1.f + __expf(-xm));
                            v2[q] = v; }
                        o[e] = pk2(v2[0], v2[1]); } }
                *(v4u*)(F.AL + (size_t)mm * KL + j0) = (v4u){o[0], o[1], o[2], o[3]}; }
        }
        LDS_WAIT(); asm volatile("" ::: "memory");
    }
}

__device__ __forceinline__ void indexer_unit(Frame& F, int b, int qblk) {
    int t_ = F.wv * 64 + (int)__builtin_amdgcn_mbcnt_hi(~0u, __builtin_amdgcn_mbcnt_lo(~0u, 0u)); asm volatile("" : "+v"(t_));
    const int tid = t_, lane = tid & 63, wave = F.wv, col = lane & 31, hf = lane >> 5;
    const int q0 = qblk * 16, t0 = q0 + 2 * wave, my_t = t0 + hf;
    const bf16* Pb = F.P + (size_t)b * SEQ * NP;
    LAS unsigned char* L = F.lds;
    bf16x8 af[4];
    { const int rho = col, sel = (rho >> 2) & 1, head = (rho & 3) + 4 * (rho >> 3);
      const bf16* qrow = Pb + (size_t)(t0 + sel) * NP + C_QI + head * 64 + hf * 8;
#pragma unroll
      for (int s = 0; s < 4; ++s) af[s] = *(const bf16x8*)(qrow + 16 * s); }
    float wq[16];
    { const v4u* wr = (const v4u*)(Pb + (size_t)my_t * NP + C_WI); const v4u a = wr[0], c = wr[1];
      wq[0] = bflo(a.x); wq[1] = bfhi(a.x); wq[2] = bflo(a.y); wq[3] = bfhi(a.y); wq[4] = bflo(a.z); wq[5] = bfhi(a.z); wq[6] = bflo(a.w); wq[7] = bfhi(a.w);
      wq[8] = bflo(c.x); wq[9] = bfhi(c.x); wq[10] = bflo(c.y); wq[11] = bfhi(c.y); wq[12] = bflo(c.z); wq[13] = bfhi(c.z); wq[14] = bflo(c.w); wq[15] = bfhi(c.w); }
    const int nch = (q0 + 15) / 128 + 1;
    const int srow = tid >> 3, sc16 = tid & 7;
    const bf16* ksrc = Pb + (size_t)srow * NP + C_KI + sc16 * 8;
    v4u st0 = *(const v4u*)(ksrc), st1 = *(const v4u*)(ksrc + (size_t)64 * NP);
    *(LAS v4u*)(L + srow * 144 + sc16 * 16) = st0; *(LAS v4u*)(L + (srow + 64) * 144 + sc16 * 16) = st1;
    __syncthreads();
    unsigned key[64];
#pragma unroll
    for (int ch = 0; ch < 16; ++ch) {
        if (ch < nch) {
            const bool more = (ch + 1 < nch);
            if (more) { st0 = *(const v4u*)(ksrc + (size_t)(128 * (ch + 1)) * NP); st1 = *(const v4u*)(ksrc + (size_t)(128 * (ch + 1) + 64) * NP); }
            const LAS unsigned char* kb0 = L + (ch & 1) * 18432 + col * 144 + hf * 16;
#pragma unroll
            for (int sub = 0; sub < 4; ++sub) { const int kb = 4 * ch + sub;
                f32x16 c = {};
#pragma unroll
                for (int s = 0; s < 4; ++s) { const bf16x8 bfr = *(const LAS bf16x8*)(kb0 + sub * 32 * 144 + s * 32); c = __builtin_amdgcn_mfma_f32_32x32x16_bf16(af[s], bfr, c, 0, 0, 0); }
                float sc = 0.f;
#pragma unroll
                for (int r = 0; r < 16; ++r) sc = fmaf(fmaxf(c[r], 0.f), wq[r], sc);
                unsigned u = __float_as_uint(sc); u = (u & 0x80000000u) ? ~u : (u | 0x80000000u);
                key[kb] = (kb * 32 + col <= my_t) ? u : 0u; }
            if (more) { LAS unsigned char* dst = L + ((ch + 1) & 1) * 18432; *(LAS v4u*)(dst + srow * 144 + sc16 * 16) = st0; *(LAS v4u*)(dst + (srow + 64) * 144 + sc16 * 16) = st1; }
            __syncthreads();
        } else {
#pragma unroll
            for (int sub = 0; sub < 4; ++sub) key[4 * ch + sub] = 0u;
        }
    }
    bool done = (my_t + 1 <= 256);
    unsigned tau = done ? 1u : 0u;
    const int nch8 = (q0 + 15) / 256 + 1;
    for (int bit = 31; bit >= 0; --bit) {
        if (__all(done)) break;
        const unsigned cand = tau | (1u << bit);
        int cnt = 0;
#pragma unroll
        for (int g8 = 0; g8 < 8; ++g8) if (g8 < nch8) {
#pragma unroll
            for (int j = 0; j < 8; ++j) cnt += (key[8 * g8 + j] >= cand) ? 1 : 0; }
        cnt += __builtin_amdgcn_update_dpp(0, cnt, 0xB1, 0xF, 0xF, false); cnt += __builtin_amdgcn_update_dpp(0, cnt, 0x4E, 0xF, 0xF, false);
        cnt += __builtin_amdgcn_update_dpp(0, cnt, 0x141, 0xF, 0xF, false); cnt += __builtin_amdgcn_update_dpp(0, cnt, 0x140, 0xF, 0xF, false);
        { auto rr = __builtin_amdgcn_permlane16_swap((unsigned)cnt, (unsigned)cnt, false, false); cnt = (int)(rr[0] + rr[1]); }
        if (!done && cnt >= 256) { tau = cand; if (cnt == 256) done = true; }
    }
    unsigned* ma = F.MASK + (size_t)(b * SEQ + t0) * 64;
    unsigned wa = 0u, wb = 0u;
#pragma unroll
    for (int kb = 0; kb < 64; ++kb) {
        const unsigned long long bal = __ballot(key[kb] >= tau);
        asm volatile("s_nop 4\n\tv_writelane_b32 %0, %2, %4\n\tv_writelane_b32 %1, %3, %4" : "+v"(wa), "+v"(wb) : "s"((unsigned)bal), "s"((unsigned)(bal >> 32)), "i"(kb));
    }
    ma[lane] = wa; ma[64 + lane] = wb;
    __syncthreads();
}
__device__ __forceinline__ void indexer_phase(Frame& F) {
    for (int i = 0; i < (NB * (SEQ / 16) + F.G - 1) / F.G; ++i) {
        const int j = i * F.G + ((i & 1) ? (F.G - 1 - F.bid) : F.bid);
        if (j < NB * (SEQ / 16)) indexer_unit(F, j & 7, j >> 3);
    }
}

template <int CTRL> __device__ __forceinline__ float dppx(float v) { return __builtin_bit_cast(float, __builtin_amdgcn_update_dpp(0, __builtin_bit_cast(int, v), CTRL, 0xF, 0xF, false)); }
__device__ __forceinline__ float row16_sum(float v) {
    v += dppx<0xB1>(v); v += dppx<0x4E>(v); v += dppx<0x141>(v); v += dppx<0x140>(v); return v;
}
__device__ __forceinline__ void row16_sum2(float& a, float& b) {
    asm volatile("s_nop 1\n\t"
        "v_add_f32_dpp %0, %0, %0 quad_perm:[1,0,3,2] row_mask:0xf bank_mask:0xf\n\t"
        "v_add_f32_dpp %1, %1, %1 quad_perm:[1,0,3,2] row_mask:0xf bank_mask:0xf\n\t"
        "s_nop 0\n\t"
        "v_add_f32_dpp %0, %0, %0 quad_perm:[2,3,0,1] row_mask:0xf bank_mask:0xf\n\t"
        "v_add_f32_dpp %1, %1, %1 quad_perm:[2,3,0,1] row_mask:0xf bank_mask:0xf\n\t"
        "s_nop 0\n\t"
        "v_add_f32_dpp %0, %0, %0 row_half_mirror row_mask:0xf bank_mask:0xf\n\t"
        "v_add_f32_dpp %1, %1, %1 row_half_mirror row_mask:0xf bank_mask:0xf\n\t"
        "s_nop 0\n\t"
        "v_add_f32_dpp %0, %0, %0 row_mirror row_mask:0xf bank_mask:0xf\n\t"
        "v_add_f32_dpp %1, %1, %1 row_mirror row_mask:0xf bank_mask:0xf\n\t"
        "s_nop 1"
        : "+v"(a), "+v"(b));
}
__device__ __forceinline__ float wave_sum_d(float v) { v = row16_sum(v); v += __shfl_xor(v, 16); v += __shfl_xor(v, 32); return v; }
namespace rw {
typedef short bf16x8 __attribute__((ext_vector_type(8)));
typedef short s16x4 __attribute__((ext_vector_type(4)));
typedef float f32x16 __attribute__((ext_vector_type(16)));
constexpr int KAP = 0, RH = 13824, KBT = 27648, BBT = 43008, VT = 58368, KH = 78848, BH = 88064, MATS = 97280, YB = 122880, GC = 139264, WTOT = 140032, BON = 144128;
constexpr int I64 = 4608, I32 = 5120, M32 = 2560, MSET = 12800;
constexpr int AKK = 0, AKR = 2560, ABR = 5120, TT = 7680, SCR = 10240;
constexpr int S64 = 144, S32 = 80;
typedef float f32x2_t __attribute__((ext_vector_type(2))); typedef __bf16 bf16x2_t __attribute__((ext_vector_type(2)));
__device__ __forceinline__ unsigned cvtpk(float lo, float hi) { f32x2_t v = {lo, hi}; bf16x2_t b = __builtin_convertvector(v, bf16x2_t); return __builtin_bit_cast(unsigned, b); }
__device__ __forceinline__ unsigned short cvt1(float x) { return (unsigned short)cvtpk(x, 0.f); }
__device__ __forceinline__ bf16x8 frag_nat(const LAS unsigned char* base, int stride, int row, int kb, int h) { return *(const LAS bf16x8*)(base + row * stride + (kb + 8 * h) * 2); }
__device__ __forceinline__ bf16x8 frag_perm(const LAS unsigned char* base, int stride, int row, int kb, int h) {
    const s16x4 lo = *(const LAS s16x4*)(base + row * stride + (kb + 4 * h) * 2), hi = *(const LAS s16x4*)(base + row * stride + (kb + 8 + 4 * h) * 2);
    return (bf16x8){lo[0], lo[1], lo[2], lo[3], hi[0], hi[1], hi[2], hi[3]};
}
__device__ __forceinline__ bf16x8 acc_frag(const f32x16& x, int s) {
    typedef unsigned u32x4 __attribute__((ext_vector_type(4)));
    u32x4 w; w.x = cvtpk(x[8 * s + 0], x[8 * s + 1]); w.y = cvtpk(x[8 * s + 2], x[8 * s + 3]); w.z = cvtpk(x[8 * s + 4], x[8 * s + 5]); w.w = cvtpk(x[8 * s + 6], x[8 * s + 7]);
    return __builtin_bit_cast(bf16x8, w);
}
__device__ __forceinline__ int crow(int r, int hi) { return (r & 3) + 8 * (r >> 2) + 4 * hi; }
}

#ifndef PROBE_VAR
#define PROBE_VAR 0
#endif
__device__ __forceinline__ void wave_sum2(float& a, float& b) {
    row16_sum2(a, b);
    const float a1 = __shfl_xor(a, 16), b1 = __shfl_xor(b, 16); a += a1; b += b1;
    const float a2 = __shfl_xor(a, 32), b2 = __shfl_xor(b, 32); a += a2; b += b2;
}
template <int N> __device__ __forceinline__ void wave_sum_n(float (&v)[N]) {
#pragma unroll
    for (int i = 0; i < N; ++i) v[i] += dppx<0xB1>(v[i]);
#pragma unroll
    for (int i = 0; i < N; ++i) v[i] += dppx<0x4E>(v[i]);
#pragma unroll
    for (int i = 0; i < N; ++i) v[i] += dppx<0x141>(v[i]);
#pragma unroll
    for (int i = 0; i < N; ++i) v[i] += dppx<0x140>(v[i]);
#pragma unroll
    for (int i = 0; i < N; ++i) { auto rr = __builtin_amdgcn_permlane16_swap(__float_as_uint(v[i]), __float_as_uint(v[i]), false, false);
        v[i] = __uint_as_float(rr[0]) + __uint_as_float(rr[1]); }
#pragma unroll
    for (int i = 0; i < N; ++i) { auto rr = __builtin_amdgcn_permlane32_swap(__float_as_uint(v[i]), __float_as_uint(v[i]), false, false);
        v[i] = __uint_as_float(rr[0]) + __uint_as_float(rr[1]); }
}
__device__ __forceinline__ void rwkv_unit(Frame& F, int b, int h, const int pv = 0) {
    using namespace rw;
    int t_ = F.wv * 64 + (int)__builtin_amdgcn_mbcnt_hi(~0u, __builtin_amdgcn_mbcnt_lo(~0u, 0u)); asm volatile("" : "+v"(t_));
    const int lane = t_ & 63, wave = __builtin_amdgcn_readfirstlane(t_ >> 6), l31 = lane & 31, hi = lane >> 5;
    LAS unsigned char* L = F.lds;
    const int c = lane, col = h * 64 + c;
    const float mu_r = F.mu[C_R + col], mu_k = F.mu[C_K + col], mu_v = F.mu[C_V + col];
    const float kkc = F.k_k[col], kac = F.k_a[col], rkc = F.r_k[col], lw = F.lnx_w[col], lb = F.lnx_b[col];
    const size_t m0 = (size_t)b * SEQ;
    const int vh = wave & 1;
    constexpr int NCH = SEQ / 32;
    float st[40];
#pragma unroll
    for (int i = 0; i < 40; ++i) st[i] = 0.f;
#define rm(j) st[(j)]
#define kt(j) st[8 + (j)]
#define kk(j) st[16 + (j)]
#define bb(j) st[24 + (j)]
#define cs(j) st[32 + (j)]
    unsigned raw[8][5]; unsigned rawp[3]; unsigned gq[8];
#define RW_LOAD(ch) do { { const int tk0 = (ch) * 32 + 8 * wave; const bf16* pp = F.P + (m0 + tk0 - (tk0 > 0 ? 1 : 0)) * NP; rawp[0] = pp[C_R + col]; rawp[1] = pp[C_K + col]; rawp[2] = pp[C_V + col]; } \
        _Pragma("unroll") for (int j = 0; j < 8; ++j) { const size_t m = m0 + (ch) * 32 + 8 * wave + j; const bf16* pr = F.P + m * NP; const bf16* er = F.EWAG + m * NL; \
        raw[j][0] = __builtin_nontemporal_load(pr + C_R + col); raw[j][1] = __builtin_nontemporal_load(pr + C_K + col); raw[j][2] = __builtin_nontemporal_load(pr + C_V + col); \
        raw[j][3] = __builtin_nontemporal_load(er + col); raw[j][4] = __builtin_nontemporal_load(er + 1024 + col); } } while (0)
    if (pv & 128) return;
    if (wave < 4) RW_LOAD(0);
    for (int it = 0; it < NCH + 4; ++it) {
        if (wave < 4) {
            bf16x8 vv = {}; float bon8[8];
#pragma unroll
            for (int j = 0; j < 8; ++j) bon8[j] = 0.f;
            if (it >= 4) { const int ch = it - 4; vv = *(const LAS bf16x8*)(L + VT + (ch & 3) * I32 + c * S32 + 16 * wave);
#pragma unroll
                for (int j = 0; j < 8; ++j) bon8[j] = ((const LAS float*)(L + BON + (ch & 3) * 128))[8 * wave + j]; }
            if (it >= 1 && it <= NCH && !(pv & 32)) { const int ch = it - 1; const LAS float* wt = (const LAS float*)(L + WTOT + (ch & 1) * 2048);
                float off = 0.f, tot = 0.f;
#pragma unroll
                for (int w2 = 0; w2 < 4; ++w2) { const float x = wt[w2 * 64 + c]; tot += x; off += (w2 < wave) ? x : 0.f; }
                const float lgC = -tot;
                LAS unsigned char* pK = L + KAP + (ch % 3) * I64; LAS unsigned char* pR = L + RH + (ch % 3) * I64; LAS unsigned char* pKH = L + KH + (ch & 1) * I64; LAS unsigned char* pBH = L + BH + (ch & 1) * I64;
                LAS unsigned char* pKB = L + KBT + (ch % 3) * I32; LAS unsigned char* pBB = L + BBT + (ch % 3) * I32;
                const float eC = __expf(lgC); float egp = __expf(-off);
                unsigned kb4[4], bb4[4];
#pragma unroll
                for (int j = 0; j < 8; ++j) { const int i = 8 * wave + j;
                    const float e_g = __expf(-(off + cs(j))), e_m = __builtin_amdgcn_rcpf(e_g), e_c = eC * e_m;
                    *(LAS bf16*)(pK + i * S64 + 2 * c) = cvt1(kk(j) * egp); *(LAS bf16*)(pR + i * S64 + 2 * c) = cvt1(rm(j) * e_g);
                    *(LAS bf16*)(pKH + i * S64 + 2 * c) = cvt1(kt(j) * e_m); *(LAS bf16*)(pBH + i * S64 + 2 * c) = cvt1(bb(j) * e_m);
                    const float kbv = kt(j) * e_c, bbv = -bb(j) * e_c;
                    if (j & 1) { kb4[j >> 1] = cvtpk(__uint_as_float(kb4[j >> 1]), kbv); bb4[j >> 1] = cvtpk(__uint_as_float(bb4[j >> 1]), bbv); }
                    else { kb4[j >> 1] = __float_as_uint(kbv); bb4[j >> 1] = __float_as_uint(bbv); }
                    egp = e_g; }
                *(LAS v4u*)(pKB + c * S32 + 16 * wave) = (v4u){kb4[0], kb4[1], kb4[2], kb4[3]};
                *(LAS v4u*)(pBB + c * S32 + 16 * wave) = (v4u){bb4[0], bb4[1], bb4[2], bb4[3]};
                if (wave == 0) ((LAS float*)(L + GC + (ch % 3) * 256))[c] = eC;
            }
            if (it < NCH && !(pv & 64)) { const int ch = it;
                float kkr8[8], a8[8], red[16]; unsigned vt4[4];
#pragma unroll
                for (int j = 0; j < 8; ++j) { const int tk = ch * 32 + 8 * wave + j; const bool hp = tk > 0;
                    const float r0 = bf2f((unsigned short)raw[j][0]), k0 = bf2f((unsigned short)raw[j][1]), v0 = bf2f((unsigned short)raw[j][2]);
                    const float r1 = !hp ? 0.f : bf2f((unsigned short)(j ? raw[j ? j - 1 : 0][0] : rawp[0])), k1 = !hp ? 0.f : bf2f((unsigned short)(j ? raw[j ? j - 1 : 0][1] : rawp[1])),
                                v1 = !hp ? 0.f : bf2f((unsigned short)(j ? raw[j ? j - 1 : 0][2] : rawp[2]));
                    rm(j) = r0 + (r1 - r0) * mu_r; const float km = k0 + (k1 - k0) * mu_k; const float vmj = v0 + (v1 - v0) * mu_v;
                    if (j & 1) vt4[j >> 1] = cvtpk(__uint_as_float(vt4[j >> 1]), vmj); else vt4[j >> 1] = __float_as_uint(vmj);
                    const float ew = bf2f((unsigned short)raw[j][3]); a8[j] = bf2f((unsigned short)raw[j][4]);
                    kkr8[j] = km * kkc; kt(j) = km * (1.f + (a8[j] - 1.f) * kac);
                    red[j] = kkr8[j] * kkr8[j]; red[8 + j] = rm(j) * kt(j) * rkc;
                    cs(j) = (j ? cs(j ? j - 1 : 0) : 0.f) + ew; }
                *(LAS v4u*)(L + VT + (ch & 3) * I32 + c * S32 + 16 * wave) = (v4u){vt4[0], vt4[1], vt4[2], vt4[3]};
                wave_sum_n<16>(red);
#pragma unroll
                for (int j = 0; j < 8; ++j) { kk(j) = kkr8[j] * __builtin_amdgcn_rsqf(fmaxf(red[j], 1e-24f)); bb(j) = kk(j) * a8[j]; }
                if (lane < 8) { float bo = red[8];
#pragma unroll
                    for (int j = 1; j < 8; ++j) bo = (lane == j) ? red[8 + j] : bo;
                    ((LAS float*)(L + BON + (ch & 3) * 128))[8 * wave + lane] = bo; }
                ((LAS float*)(L + WTOT + (ch & 1) * 2048))[wave * 64 + c] = cs(7);
            }
            if (!(pv & 2) && it + 1 < NCH) RW_LOAD(it + 1);
            if (it >= 4 && !(pv & 4)) { const int ch = it - 4;
                const LAS float* yb = (const LAS float*)(L + YB + (ch & 1) * 8192);
                float y8[8], sm[16];
#pragma unroll
                for (int j = 0; j < 8; ++j) { y8[j] = yb[(8 * wave + j) * 64 + c]; sm[j] = y8[j]; sm[8 + j] = y8[j] * y8[j]; }
                wave_sum_n<16>(sm);
#pragma unroll
                for (int j = 0; j < 8; ++j) { const int i = 8 * wave + j;
                    const float mean = sm[j] * (1.f / 64.f), var = fmaxf(sm[8 + j] * (1.f / 64.f) - mean * mean, 0.f);
                    const float yn = (y8[j] - mean) * __builtin_amdgcn_rsqf(var + RWKV_LN_EPS) * lw + lb;
                    const float o = (yn + bon8[j] * bf2f((unsigned short)vv[j])) * bf2f((unsigned short)gq[j]);
                    F.Y[(m0 + ch * 32 + i) * DM + col] = cvt1(o); }
            }
            if (!(pv & 2) && it + 1 >= 4 && it + 1 < NCH + 4) {
#pragma unroll
                for (int j = 0; j < 8; ++j) gq[j] = __builtin_nontemporal_load(F.EWAG + (m0 + (it - 3) * 32 + 8 * wave + j) * NL + 2048 + col); }
        } else if (wave < 6) {
            if (it >= 3 && it < NCH + 3 && !(pv & 8)) { const int ch = it - 3;
                const LAS unsigned char* pK = L + KAP + (ch % 3) * I64; const LAS unsigned char* pR = L + RH + (ch % 3) * I64; const LAS unsigned char* pKB = L + KBT + (ch % 3) * I32;
                const LAS unsigned char* pBB = L + BBT + (ch % 3) * I32; const LAS unsigned char* pV = L + VT + (ch & 3) * I32; const LAS unsigned char* pM = L + MATS + (ch & 1) * MSET;
                f32x16 X0, X1;
#pragma unroll
                for (int r = 0; r < 16; ++r) { X0[r] = st[r]; X1[r] = st[16 + r]; }
                f32x16 RHS = {}, YT = {}; bf16x8 xb[4];
                xb[0] = acc_frag(X0, 0); xb[1] = acc_frag(X0, 1); xb[2] = acc_frag(X1, 0); xb[3] = acc_frag(X1, 1);
#pragma unroll
                for (int q = 0; q < 4; ++q) { RHS = __builtin_amdgcn_mfma_f32_32x32x16_bf16(frag_perm(pK, S64, l31, 16 * q, hi), xb[q], RHS, 0, 0, 0);
                                              YT = __builtin_amdgcn_mfma_f32_32x32x16_bf16(frag_perm(pR, S64, l31, 16 * q, hi), xb[q], YT, 0, 0, 0); }
                const bf16x8 vf0 = frag_nat(pV, S32, 32 * vh + l31, 0, hi), vf1 = frag_nat(pV, S32, 32 * vh + l31, 16, hi);
                RHS = __builtin_amdgcn_mfma_f32_32x32x16_bf16(frag_nat(pM + AKK, S32, l31, 0, hi), vf0, RHS, 0, 0, 0);
                RHS = __builtin_amdgcn_mfma_f32_32x32x16_bf16(frag_nat(pM + AKK, S32, l31, 16, hi), vf1, RHS, 0, 0, 0);
                YT = __builtin_amdgcn_mfma_f32_32x32x16_bf16(frag_nat(pM + AKR, S32, l31, 0, hi), vf0, YT, 0, 0, 0);
                YT = __builtin_amdgcn_mfma_f32_32x32x16_bf16(frag_nat(pM + AKR, S32, l31, 16, hi), vf1, YT, 0, 0, 0);
                f32x16 U = {};
                { const bf16x8 r0 = acc_frag(RHS, 0), r1 = acc_frag(RHS, 1);
                  U = __builtin_amdgcn_mfma_f32_32x32x16_bf16(frag_perm(pM + TT, S32, l31, 0, hi), r0, U, 0, 0, 0);
                  U = __builtin_amdgcn_mfma_f32_32x32x16_bf16(frag_perm(pM + TT, S32, l31, 16, hi), r1, U, 0, 0, 0); }
                const bf16x8 u0 = acc_frag(U, 0), u1 = acc_frag(U, 1);
                YT = __builtin_amdgcn_mfma_f32_32x32x16_bf16(frag_perm(pM + ABR, S32, l31, 0, hi), u0, YT, 0, 0, 0);
                YT = __builtin_amdgcn_mfma_f32_32x32x16_bf16(frag_perm(pM + ABR, S32, l31, 16, hi), u1, YT, 0, 0, 0);
                LAS float* yb = (LAS float*)(L + YB + (ch & 1) * 8192);
#pragma unroll
                for (int r = 0; r < 16; ++r) yb[crow(r, hi) * 64 + 32 * vh + l31] = YT[r];
                const LAS float* gc = (const LAS float*)(L + GC + (ch % 3) * 256);
#pragma unroll
                for (int r = 0; r < 16; ++r) { X0[r] *= gc[crow(r, hi)]; X1[r] *= gc[32 + crow(r, hi)]; }
                X0 = __builtin_amdgcn_mfma_f32_32x32x16_bf16(frag_nat(pKB, S32, l31, 0, hi), vf0, X0, 0, 0, 0);
                X1 = __builtin_amdgcn_mfma_f32_32x32x16_bf16(frag_nat(pKB, S32, 32 + l31, 0, hi), vf0, X1, 0, 0, 0);
                X0 = __builtin_amdgcn_mfma_f32_32x32x16_bf16(frag_nat(pKB, S32, l31, 16, hi), vf1, X0, 0, 0, 0);
                X1 = __builtin_amdgcn_mfma_f32_32x32x16_bf16(frag_nat(pKB, S32, 32 + l31, 16, hi), vf1, X1, 0, 0, 0);
                X0 = __builtin_amdgcn_mfma_f32_32x32x16_bf16(frag_perm(pBB, S32, l31, 0, hi), u0, X0, 0, 0, 0);
                X1 = __builtin_amdgcn_mfma_f32_32x32x16_bf16(frag_perm(pBB, S32, 32 + l31, 0, hi), u0, X1, 0, 0, 0);
                X0 = __builtin_amdgcn_mfma_f32_32x32x16_bf16(frag_perm(pBB, S32, l31, 16, hi), u1, X0, 0, 0, 0);
                X1 = __builtin_amdgcn_mfma_f32_32x32x16_bf16(frag_perm(pBB, S32, 32 + l31, 16, hi), u1, X1, 0, 0, 0);
#pragma unroll
                for (int r = 0; r < 16; ++r) { st[r] = X0[r]; st[16 + r] = X1[r]; }
            }
        } else {
            if (it >= 2 && it < NCH + 2 && !(pv & 16)) { const int ch = it - 2;
                const LAS unsigned char* pK = L + KAP + (ch % 3) * I64; const LAS unsigned char* pR = L + RH + (ch % 3) * I64; const LAS unsigned char* pKH = L + KH + (ch & 1) * I64; const LAS unsigned char* pBH = L + BH + (ch & 1) * I64;
                LAS unsigned char* pM = L + MATS + (ch & 1) * MSET;
                if (wave == 6) {
#pragma unroll
                    for (int w3 = 0; w3 < 3; ++w3) { const LAS unsigned char* Aimg = (w3 == 0) ? pK : pR; const LAS unsigned char* Bimg = (w3 == 2) ? pBH : pKH;
                        f32x16 d = {};
#pragma unroll
                        for (int q = 0; q < 4; ++q) d = __builtin_amdgcn_mfma_f32_32x32x16_bf16(frag_nat(Aimg, S64, l31, 16 * q, hi), frag_nat(Bimg, S64, l31, 16 * q, hi), d, 0, 0, 0);
                        const int dst = (w3 == 0) ? AKK : (w3 == 1) ? AKR : ABR; const float sg = (w3 == 2) ? -1.f : 1.f;
#pragma unroll
                        for (int r = 0; r < 16; ++r) { const int t = crow(r, hi); const bool keep = (w3 == 0) ? (l31 < t) : (l31 <= t);
                            *(LAS bf16*)(pM + dst + t * S32 + 2 * l31) = cvt1(keep ? sg * d[r] : 0.f); } }
                } else {
                    f32x16 pw = {}, pT = {};
#pragma unroll
                    for (int q = 0; q < 4; ++q) { const bf16x8 fk = frag_nat(pK, S64, l31, 16 * q, hi), fb = frag_nat(pBH, S64, l31, 16 * q, hi);
                        pw = __builtin_amdgcn_mfma_f32_32x32x16_bf16(fk, fb, pw, 0, 0, 0);
                        pT = __builtin_amdgcn_mfma_f32_32x32x16_bf16(fb, fk, pT, 0, 0, 0); }
#pragma unroll
                    for (int r = 0; r < 16; ++r) { pw[r] = (l31 < crow(r, hi)) ? pw[r] : 0.f; pT[r] = (crow(r, hi) < l31) ? pT[r] : 0.f; }
                    f32x16 P;
#pragma unroll
                    for (int r = 0; r < 16; ++r) P[r] = ((crow(r, hi) == l31) ? 1.f : 0.f) - pw[r];
                    if (!(pv & 1))
#pragma unroll
                    for (int k2 = 0; k2 < 5; ++k2) {
                        const bf16x8 t0 = acc_frag(pT, 0), t1 = acc_frag(pT, 1);
                        if (k2 > 0) { const bf16x8 p0 = acc_frag(P, 0), p1 = acc_frag(P, 1);
                            P = __builtin_amdgcn_mfma_f32_32x32x16_bf16(t0, p0, P, 0, 0, 0); P = __builtin_amdgcn_mfma_f32_32x32x16_bf16(t1, p1, P, 0, 0, 0); }
                        if (k2 < 4) { const bf16x8 w0 = acc_frag(pw, 0), w1 = acc_frag(pw, 1); f32x16 nw = {}, nT = {};
                            nw = __builtin_amdgcn_mfma_f32_32x32x16_bf16(t0, w0, nw, 0, 0, 0); nw = __builtin_amdgcn_mfma_f32_32x32x16_bf16(t1, w1, nw, 0, 0, 0);
                            nT = __builtin_amdgcn_mfma_f32_32x32x16_bf16(w0, t0, nT, 0, 0, 0); nT = __builtin_amdgcn_mfma_f32_32x32x16_bf16(w1, t1, nT, 0, 0, 0);
                            pw = nw; pT = nT; }
                    }
#pragma unroll
                    for (int r = 0; r < 16; ++r) *(LAS bf16*)(pM + TT + crow(r, hi) * S32 + 2 * l31) = cvt1(P[r]);
                }
            }
        }
        __syncthreads();
    }
#undef RW_LOAD
#undef rm
#undef kt
#undef kk
#undef bb
#undef cs
}
__device__ __forceinline__ void mix_phase(Frame& F, int qword = CW_QUEUE, int only = 0) {
    LAS int* slot = (LAS int*)(F.lds + LDS_BYTES - 64);
    for (;;) {
        __syncthreads();
        if (F.tid == 0) slot[0] = (int)__hip_atomic_fetch_add(F.ctl + qword, 1u, RLX_AGENT);
        __syncthreads();
        const int it = slot[0];
        if (it >= 128 + 512) break;
        if (it < 128 && only == 2) continue;
        if (it >= 128 && only == 1) break;
        if (it < 128) {
#ifndef SKIP_RWKV
            rwkv_unit(F, it >> 4, it & 15, only ? (PROBE_VAR) : 0);
#endif
        }
        else {
            const int u = it - 128;
            const int qb = 7 - (u >> 6), bh = u & 63, b = bh >> 3, h = bh & 7, g = h >> 2;
            const size_t m0 = (size_t)b * SEQ, q0 = (size_t)qb * 256;
#ifndef SKIP_ATT
            att::attn_body<NP, NP, DM, true, ATT_SD>(F.P + (m0 + q0) * NP + C_Q + h * 128, F.P + m0 * NP + C_AK + g * 128, F.P + m0 * NP + C_AV + g * 128,
                                             F.Y + (m0 + q0) * DM + 1024 + h * 128, F.MASK + (m0 + q0) * 64, (int)q0 + 256, (char*)F.lds, F.wv);
#endif
        }
    }
}
__device__ __forceinline__ void cross_phase(Frame& F) {
    for (int u = F.bid; u < NB * 4 * 8; u += F.G) {
        const int b = u >> 5, h = (u >> 3) & 3, qb = u & 7;
        const size_t m0 = (size_t)b * SEQ + (size_t)qb * 256, k0 = (size_t)b * NMEM;
        att::attn_body<512, 1024, 512, false, 2>(F.QC + m0 * 512 + h * 128, F.MEMKV + k0 * 1024 + h * 128, F.MEMKV + k0 * 1024 + 512 + h * 128,
                                              F.OC + m0 * 512 + h * 128, nullptr, NMEM, (char*)F.lds, F.wv);
    }
}

#define XB_TMO      128
#define XB_XCNT(j)  (256  + 64 * (j))
#define XB_XSUB(j)  (1280 + 64 * (j))
#define XB_XGEN(j)  (2304 + 64 * (j))
#define XB_TOP      3328
#define XB_TOPGEN   3392
#define XCD_BAR_WORDS 3456
#define XB_SPIN_CAP (1u << 18)

__device__ __forceinline__ unsigned xb_ld(unsigned* p)              { return __hip_atomic_load(p, __ATOMIC_RELAXED, __HIP_MEMORY_SCOPE_AGENT); }
__device__ __forceinline__ unsigned xb_add(unsigned* p, unsigned v) { return __hip_atomic_fetch_add(p, v, __ATOMIC_RELAXED, __HIP_MEMORY_SCOPE_AGENT); }
__device__ __forceinline__ unsigned xb_xcc_id() { return (unsigned)__builtin_amdgcn_s_getreg((3 << 11) | 20) & 0xFu; }
#define XB_SPIN(cond, bar) do { unsigned _sp = 0; while (cond) { __builtin_amdgcn_s_sleep(1); \
    if ((++_sp & 255u) == 0u) { if (xb_ld(&(bar)[XB_TMO])) break; if (_sp > XB_SPIN_CAP) { atomicAdd(&(bar)[XB_TMO], 1u); break; } } } } while (0)

struct XcdBarrier {
    unsigned* bar; unsigned x;
    volatile LAS unsigned* st;
};

__device__ __forceinline__ XcdBarrier xcd_barrier_post(unsigned* bar, volatile LAS unsigned* st, const bool leader) {
    XcdBarrier b; b.bar = bar; b.x = xb_xcc_id(); b.st = st;
    if (leader) (void)xb_add(&bar[XB_XCNT(b.x)], 1u);
    return b;
}
__device__ __forceinline__ void xcd_barrier_complete(unsigned* bar, unsigned x, unsigned& nloc, unsigned& nx) {
    const unsigned G = gridDim.x * gridDim.y * gridDim.z;
    unsigned sum, cnt, mine, sp = 0u;
    for (;;) {
        sum = 0u; cnt = 0u; mine = 0u;
#pragma unroll
        for (unsigned j = 0; j < 16; ++j) { const unsigned c = xb_ld(&bar[XB_XCNT(j)]); sum += c; cnt += (c > 0u) ? 1u : 0u; mine = (j == x) ? c : mine; }
        if (sum == G) break;
        __builtin_amdgcn_s_sleep(1);
        if ((++sp & 255u) == 0u) { if (xb_ld(&bar[XB_TMO])) break; if (sp > XB_SPIN_CAP) { atomicAdd(&bar[XB_TMO], 1u); break; } }
    }
    nloc = mine > 0u ? mine : 1u; nx = cnt > 0u ? cnt : 1u;
}

__device__ __forceinline__ void xcd_barrier(const XcdBarrier& b, const bool leader) {
    asm volatile("s_waitcnt vmcnt(0)" ::: "memory");
    __syncthreads();
    if (leader) {
        unsigned* bar = b.bar;
        __builtin_amdgcn_s_waitcnt(0);
        unsigned nloc = b.st[0], nx = b.st[1];
        if (nloc == 0u) { xcd_barrier_complete(bar, b.x, nloc, nx); b.st[0] = nloc; b.st[1] = nx; }
        const unsigned old = xb_add(&bar[XB_XSUB(b.x)], 1u);
        const unsigned gen = old / nloc;
        if (old + 1u == (gen + 1u) * nloc) {
            __builtin_amdgcn_fence(__ATOMIC_RELEASE, "agent");
            asm volatile("s_waitcnt vmcnt(0)" ::: "memory");
            const unsigned og = xb_add(&bar[XB_TOP], 1u);
            const unsigned tg = og / nx;
            if (og + 1u == (tg + 1u) * nx) xb_add(&bar[XB_TOPGEN], 1u);
            else XB_SPIN(xb_ld(&bar[XB_TOPGEN]) == tg, bar);
            __builtin_amdgcn_fence(__ATOMIC_ACQUIRE, "agent");
            xb_add(&bar[XB_XGEN(b.x)], 1u);
            asm volatile("s_waitcnt vmcnt(0)" ::: "memory");
        } else {
            XB_SPIN(xb_ld(&bar[XB_XGEN(b.x)]) == gen, bar);
            __builtin_amdgcn_fence(__ATOMIC_ACQUIRE, "agent");
            asm volatile("s_waitcnt vmcnt(0)" ::: "memory");
        }
    }
    __syncthreads();
}

template <typename Tp> __device__ __forceinline__ Tp* inp_ptr(int i) {
    asm volatile("" : "+s"(i));
    typedef __attribute__((address_space(1))) Tp* gptr_t;
    Tp* p = (Tp*)(gptr_t)(((const __attribute__((address_space(4))) unsigned long long*)__builtin_amdgcn_kernarg_segment_ptr())[i]);
    return p;
}
constexpr int N_PHASES = 14;
__global__ void __launch_bounds__(NWAVES * 64, 2) mk_fwd(Args args) {
    extern __shared__ __attribute__((aligned(16))) unsigned char lds[];
    Frame F;
    F.lds = (LAS unsigned char*)lds;
    F.wv = __builtin_amdgcn_readfirstlane((int)threadIdx.x >> 6);
    F.lane = (int)__builtin_amdgcn_mbcnt_hi(~0u, __builtin_amdgcn_mbcnt_lo(~0u, 0u)); F.tid = F.wv * 64 + F.lane; F.wave = F.wv;
    F.G = gridDim.x; F.bid = blockIdx.x;
#define INP(i) inp_ptr<const float>(i)
#define WSP(off) ((bf16*)(inp_ptr<unsigned char>(27) + (off)))
    F.out = inp_ptr<float>(26); F.ctl = (unsigned*)inp_ptr<unsigned char>(27);
    for (int u = F.tid; u < 32; u += NWAVES * 64) ((LAS unsigned*)(F.lds + MISC_OFF))[u] = 0u;
    __syncthreads();
    XcdBarrier bar = xcd_barrier_post(F.ctl + CW_BAR, (volatile LAS unsigned*)(F.lds + MISC_OFF) + 8, F.tid == 0);
    const int lo = args.ph_lo, hi = args.ph_hi;
#ifndef PHMASK
#define PHMASK 0xFFFF
#endif
#define IN(k) ((((PHMASK) >> (k)) & 1) && lo <= (k) && (k) < hi)
#define SEAM(k) do { if (IN(k) && IN((k) + 1)) xcd_barrier(bar, F.wv == 0 && (int)__builtin_amdgcn_mbcnt_hi(~0u, __builtin_amdgcn_mbcnt_lo(~0u, 0u)) == 0); { int t_ = F.wv * 64 + (int)__builtin_amdgcn_mbcnt_hi(~0u, __builtin_amdgcn_mbcnt_lo(~0u, 0u)); asm volatile("" : "+v"(t_)); F.tid = t_; F.lane = t_ & 63; F.wave = F.wv; } } while (0)
#define PRB(k) ((PROBE_PH) == (k) || ((k) == 11 && (PROBE_PH) == 110) || ((k) == 4 && ((PROBE_PH) == 40 || (PROBE_PH) == 41)) || ((k) == 0 && ((PROBE_PH) == 100 || (PROBE_PH) == 101)))
#define REP(k) for (int rep_ = 0; rep_ < (PRB(k) ? 2 : 1); ++rep_, (PRB(k) && rep_ < 2) ? xcd_barrier(bar, F.wv == 0 && (int)__builtin_amdgcn_mbcnt_hi(~0u, __builtin_amdgcn_mbcnt_lo(~0u, 0u)) == 0) : (void)0)
    using pg8::Gemm; using pg8::StaticOrder;
    REP(0) if (IN(0)) {
        F.x = INP(0); F.mem = INP(1); F.norm_mix = INP(3); F.w_in = INP(4); F.wd_up = INP(7); F.a_up = INP(9); F.g_up = INP(10); F.w_mix = INP(16); F.norm_mem = INP(18);
        F.norm_cross = INP(17); F.norm_mlp = INP(22); F.w_q = INP(19); F.w_kv = INP(20); F.w_o = INP(21); F.w_up = INP(23); F.w_dn = INP(24);
        F.WIN = WSP(WS_WIN); F.WMIX = WSP(WS_WMIX); F.WQ = WSP(WS_WQ); F.WKV = WSP(WS_WKV); F.WO = WSP(WS_WO); F.WUP = WSP(WS_WUP); F.WDN = WSP(WS_WDN); F.WL = WSP(WS_WL);
        F.XN = WSP(WS_XN); F.MEMN = WSP(WS_MEMN);
        p0_prologue(F, rep_ ? (PROBE_PH) - 99 : 3); } SEAM(0);
    REP(1) if (IN(1)) {
        F.XN = WSP(WS_XN); F.WIN = WSP(WS_WIN); F.P = WSP(WS_P); F.MEMN = WSP(WS_MEMN); F.WKV = WSP(WS_WKV); F.MEMKV = WSP(WS_MEMKV);
        { Gemm g{F.XN, F.WIN, T, NP, DM}; StaticOrder S; S.init(T, NP, F.G, F.bid, WGM_P1); pg8::EpiB16<0> E{F.P, NP, nullptr, 0.f, 0.f};
          pg8::gemm_phase<pg8::EpiB16<0>, StaticOrder, true, true>(F.lds, g, S, E, F.wv); }
    } SEAM(1);
    if (IN(2)) { F.P = WSP(WS_P); F.AL = WSP(WS_AL); F.pos = (const int*)INP(2); F.mu = INP(5); prep_phase(F); } SEAM(2);
    REP(3) if (IN(3)) {
        F.AL = WSP(WS_AL); F.WL = WSP(WS_WL); F.EWAG = (bf16*)F.out; F.w0 = INP(6); F.a0 = INP(8); F.P = WSP(WS_P); F.MASK = (unsigned*)WSP(WS_MASK);
#ifndef SKIP_LORA
        { int kl = 256; asm volatile("" : "+s"(kl)); Gemm g{F.AL, F.WL, T, NL, kl, KL, 8, 256}; StaticOrder S; S.init(T, NL, F.G, F.bid); pg8::EpiLora E{F.EWAG, NL, F.w0, F.a0};
          pg8::gemm_phase<pg8::EpiLora, StaticOrder, true, true>(F.lds, g, S, E, F.wv); }
#endif
#ifndef SKIP_IDX
#if PROBE_PH == 30
        { int nrep = 2; asm volatile("" : "+s"(nrep)); for (int rp = 0; rp < nrep; ++rp) indexer_phase(F); }
#else
        indexer_phase(F);
#endif
#endif
    } SEAM(3);
    REP(4) if (IN(4)) { F.P = WSP(WS_P); F.EWAG = (bf16*)F.out; F.MASK = (unsigned*)WSP(WS_MASK); F.Y = WSP(WS_Y); F.mu = INP(5); F.k_k = INP(11); F.k_a = INP(12); F.r_k = INP(13);
        F.lnx_w = INP(14); F.lnx_b = INP(15); if (rep_) F.Y = WSP(WS_XN);
        mix_phase(F, CW_QUEUE + 64 * rep_, rep_ ? (PROBE_PH) - 39 : 0); } SEAM(4);
    if (IN(5)) { F.Y = WSP(WS_Y); F.WMIX = WSP(WS_WMIX); F.x = INP(0); F.XN = WSP(WS_XN); Gemm g{F.Y, F.WMIX, T, DM, DM}; StaticOrder S; S.init(T, DM, F.G, F.bid, WGM_P5); pg8::EpiResB<false, false> E{F.x, F.XN, DM, nullptr, (float*)(F.ctl + CW_SS1), 0.f, 0.f};
        pg8::gemm_phase<pg8::EpiResB<false, false>, StaticOrder, true, true>(F.lds, g, S, E, F.wv); } SEAM(5);
    if (IN(7)) { F.XN = WSP(WS_XN); F.WQ = WSP(WS_WQ); F.QC = WSP(WS_QC); Gemm g{F.XN, F.WQ, T, 512, DM}; StaticOrder S; S.init(T, 512, F.G, F.bid); pg8::EpiB16<0, true> E{F.QC, 512, (const float*)(F.ctl + CW_SS1), 1.f / DM, NORM_EPS};
        pg8::gemm_phase<pg8::EpiB16<0, true>, StaticOrder, true, true>(F.lds, g, S, E, F.wv);
        F.MEMN = WSP(WS_MEMN); F.WKV = WSP(WS_WKV); F.MEMKV = WSP(WS_MEMKV);
        { Gemm g{F.MEMN, F.WKV, TM, 1024, DM}; StaticOrder S; S.init(TM, 1024, F.G, (F.bid + F.G / 2) % F.G); pg8::EpiB16<0> E{F.MEMKV, 1024, nullptr, 0.f, 0.f};
          pg8::gemm_phase<pg8::EpiB16<0>, StaticOrder, true, true>(F.lds, g, S, E, F.wv); }
        F.w_up = INP(23); F.w_dn = INP(24); F.norm_mlp = INP(22); F.WUP = WSP(WS_WUP); F.WDN = WSP(WS_WDN);
        p7_mlp_weights(F, 160, F.G - 160);
    } SEAM(7);
    if (IN(8)) { F.QC = WSP(WS_QC); F.MEMKV = WSP(WS_MEMKV); F.OC = WSP(WS_OC); cross_phase(F); } SEAM(8);
    if (IN(9)) { F.OC = WSP(WS_OC); F.WO = WSP(WS_WO); int kl = 512; asm volatile("" : "+s"(kl)); F.XN = WSP(WS_XN); Gemm g{F.OC, F.WO, T, DM, kl}; StaticOrder S; S.init(T, DM, F.G, F.bid); pg8::EpiResB<true, false> E{nullptr, F.XN, DM, nullptr, (float*)(F.ctl + CW_SS2), 0.f, 0.f};
        pg8::gemm_phase<pg8::EpiResB<true, false>, StaticOrder, true, true>(F.lds, g, S, E, F.wv); } SEAM(9);
    REP(11) if (IN(11)) { F.XN = WSP(WS_XN); F.WUP = WSP(WS_WUP); F.ACT = WSP(WS_ACT); Gemm g{F.XN, F.WUP, T, DFF, DM}; StaticOrder S; S.init(T, DFF, F.G, F.bid, WGM_P11); pg8::EpiB16<2, false, true> E{F.ACT, DFF, nullptr, 0.f, 0.f};
        #if PROBE_PH == 110
        if (rep_) { pg8::EpiNull EN{}; pg8::gemm_phase<pg8::EpiNull, StaticOrder, true, true>(F.lds, g, S, EN, F.wv); } else
#endif
        pg8::gemm_phase<pg8::EpiB16<2, false, true>, StaticOrder, true, true>(F.lds, g, S, E, F.wv); } SEAM(11);
    if (IN(12)) { F.ACT = WSP(WS_ACT); F.WDN = WSP(WS_WDN); F.XN = WSP(WS_XN); F.norm_final = INP(25);
        Gemm g{F.ACT, F.WDN, T, DM, DFF}; pg8::PanelOrder S{F.bid};
        pg8::EpiFinal E{F.XN, DM, (const float*)(F.ctl + CW_SS2), (float*)(F.ctl + CW_SS3), F.ctl + CW_PCNT, F.norm_final, F.out, 1.f / DM, NORM_EPS, F.ctl + CW_TMO};
        pg8::gemm_phase<pg8::EpiFinal, pg8::PanelOrder, true, true>(F.lds, g, S, E, F.wv); }
#undef IN
#undef SEAM
}

extern "C" void kernel_launch(void* const* d_in, const int* in_sizes, int n_in, void* d_out, int out_size, void* d_ws, size_t ws_size, hipStream_t stream) {
    static int grid = 0;
    if (grid == 0) {
        if (n_in != 26 || in_sizes[0] != T * DM || out_size != T * DM || ws_size < WS_END) {
            fprintf(stderr, "kernel_launch: unexpected shapes: n_in %d in0 %d out %d ws %zu (need %zu)\n", n_in, n_in > 0 ? in_sizes[0] : -1, out_size, ws_size, (size_t)WS_END); grid = -1; return; }
        int dev = 0, cus = 0, per_cu = 0;
        if (hipGetDevice(&dev) != hipSuccess || hipDeviceGetAttribute(&cus, hipDeviceAttributeMultiprocessorCount, dev) != hipSuccess) { grid = -1; return; }
        if (hipFuncSetAttribute((const void*)mk_fwd, hipFuncAttributeMaxDynamicSharedMemorySize, LDS_BYTES) != hipSuccess) { fprintf(stderr, "kernel_launch: hipFuncSetAttribute failed\n"); grid = -1; return; }
        if (hipOccupancyMaxActiveBlocksPerMultiprocessor(&per_cu, (const void*)mk_fwd, NWAVES * 64, LDS_BYTES) != hipSuccess || per_cu < 1) { fprintf(stderr, "kernel_launch: occupancy query says %d\n", per_cu); per_cu = 1; }
        (void)hipGetLastError();
        grid = cus;
    }
    if (grid < 0) return;
    (void)hipMemsetAsync((char*)d_ws + WS_CTL, 0, CTL_ZERO_BYTES, stream);
    Args a{};
    for (int i = 0; i < 26; ++i) a.in[i] = d_in[i];
    a.out = (float*)d_out; a.ws = (unsigned char*)d_ws;
#if MK_ONE_LAUNCH
    a.ph_lo = 0; a.ph_hi = N_PHASES;
    void* kargs[] = {&a};
    hipError_t e = hipLaunchCooperativeKernel((const void*)mk_fwd, dim3(grid), dim3(NWAVES * 64), kargs, LDS_BYTES, stream);
    if (e != hipSuccess) fprintf(stderr, "kernel_launch: cooperative launch failed: %s (grid %d)\n", hipGetErrorString(e), grid);
#else
    for (int p = 0; p < N_PHASES; ++p) { a.ph_lo = p; a.ph_hi = p + 1; hipLaunchKernelGGL(mk_fwd, dim3(grid), dim3(NWAVES * 64), LDS_BYTES, stream, a); }
#endif
}
```

```cpp
#include <hip/hip_runtime.h>
#include <hip/hip_cooperative_groups.h>
#include <cstdio>
#include <cstdint>
namespace pg8 {
#define PG8_LAS __attribute__((address_space(3)))
typedef unsigned short bf16_t;
typedef short bf16x8 __attribute__((ext_vector_type(8)));
typedef float f32x4 __attribute__((ext_vector_type(4)));
typedef unsigned u32x4 __attribute__((ext_vector_type(4)));
constexpr int BM = 256, BK = 64, HALF = 128, HTB = HALF * BK * 2  , STAGE_BYTES = 8 * HTB, NXCD = 8, WGM = 4;

__host__ __device__ __forceinline__ int lds_byte(int r, int c) { const int st = (r >> 4) * 2 + (c >> 5), rr = r & 15, cc = c & 31, ob = rr * 64 + cc * 2; return st * 1024 + (ob ^ (((ob >> 9) & 1) << 5)); }
__host__ __device__ __forceinline__ void stage_rc(int b, int& R, int& C) { const int st = b / 1024, sb = b % 1024, swz = sb ^ (((sb >> 9) & 1) << 5); R = (st >> 1) * 16 + swz / 64; C = (st & 1) * 32 + (swz % 64) / 2; }
__host__ __device__ __forceinline__ int perm32(int rho) { const int n = rho >> 4, i = rho & 15; return 8 * (i >> 2) + 4 * n + (i & 3); }

struct Unit { int pm, pn; };
struct Gemm { const bf16_t* A; const bf16_t* Bt; int M, N, K; int ld, kpn, kofs; };

struct StaticOrder {
    int nM, nN, nwg, G, c, wgm;
    __host__ __device__ void init(int M, int N, int G_, int c_, int wgm_ = WGM) { nM = M / BM; nN = N / BM; nwg = nM * nN; G = G_; c = c_; wgm = wgm_; }
    __host__ __device__ bool next(int i, Unit& u) const {
        const long L = (long)i * G + c; if (L >= nwg) return false;
        int wgid = (int)L; { const int q = nwg / NXCD, r = nwg % NXCD, xcd = wgid % NXCD, off = wgid / NXCD; wgid = (xcd < r ? xcd * (q + 1) : r * (q + 1) + (xcd - r) * q) + off; }
        const int nig = wgm * nN, gid = wgid / nig, fm = gid * wgm, gsz = (nM - fm) < wgm ? (nM - fm) : wgm;
        u.pm = fm + ((wgid % nig) % gsz); u.pn = (wgid % nig) / gsz; return true;
    }
    __device__ __forceinline__ void a_ready(const Unit&) const {}
    __device__ __forceinline__ void done(const Unit&) const {}
};

__device__ __forceinline__ unsigned cvt_pk_bf16(float lo, float hi) { unsigned r; asm volatile("v_cvt_pk_bf16_f32 %0, %1, %2" : "=v"(r) : "v"(lo), "v"(hi)); return r; }
typedef float f32x2 __attribute__((ext_vector_type(2)));
__device__ __forceinline__ float fq_sum(float v) {
    { auto rr = __builtin_amdgcn_permlane16_swap(__float_as_uint(v), __float_as_uint(v), false, false); v = __uint_as_float(rr[0]) + __uint_as_float(rr[1]); }
    { auto rr = __builtin_amdgcn_permlane32_swap(__float_as_uint(v), __float_as_uint(v), false, false); v = __uint_as_float(rr[0]) + __uint_as_float(rr[1]); }
    return v;
}
__device__ __forceinline__ void xch8(const u32x4 a, const u32x4 b, const bool lo  , u32x4& d0, u32x4& d1) {
#pragma unroll
    for (int i = 0; i < 4; ++i) {
        const unsigned give = lo ? b[i] : a[i];
        const unsigned r = (unsigned)__builtin_amdgcn_update_dpp(0, (int)give, 0x128  , 0xF, 0xF, false);
        d0[i] = lo ? a[i] : r; d1[i] = lo ? r : b[i]; }
}
__device__ __forceinline__ u32x4 pack8(const f32x4 v0, const f32x4 v1) { u32x4 w; w.x = cvt_pk_bf16(v0[0], v0[1]); w.y = cvt_pk_bf16(v0[2], v0[3]); w.z = cvt_pk_bf16(v1[0], v1[1]); w.w = cvt_pk_bf16(v1[2], v1[3]); return w; }
template <int ACT, bool ROWSCALE = false, bool NTS = false> struct EpiB16 {
    static constexpr bool PERM = true, AFTER_DRAIN = false;
    bf16_t* O; int ldc; const float* ss; float inv_n, eps;
    __device__ __forceinline__ void operator()(const f32x4 (&acc)[2][2][4][2], const Unit& u, int wr, int wc, int fr, int fq) const {
        const int rowg = u.pm * BM + wr * 64; const bool lo = fr < 8;
        bf16_t* sp = O + (size_t)(rowg + (fr & 7)) * ldc + u.pn * BM + wc * 64 + (fr >> 3) * 32 + 8 * fq;
#pragma unroll
        for (int ai = 0; ai < 2; ++ai)
#pragma unroll
            for (int m = 0; m < 4; ++m) {
                float rs = 1.f; if (ROWSCALE) rs = __builtin_amdgcn_rsqf(ss[rowg + ai * HALF + m * 16 + fr] * inv_n + eps);
                u32x4 w[2];
#pragma unroll
                for (int bj = 0; bj < 2; ++bj) { f32x4 v0 = acc[ai][bj][m][0], v1 = acc[ai][bj][m][1];
                    if (ROWSCALE) { v0 = v0 * rs; v1 = v1 * rs; }
                    if (ACT == 2) {
#pragma unroll
                        for (int i = 0; i < 4; ++i) { float a = fmaxf(v0[i], 0.f), b = fmaxf(v1[i], 0.f); v0[i] = a * a; v1[i] = b * b; } }
                    w[bj] = pack8(v0, v1); }
                u32x4 d0, d1; xch8(w[0], w[1], lo, d0, d1);
                bf16_t* p = sp + (size_t)(ai * HALF + m * 16) * ldc;
                if (NTS) { __builtin_nontemporal_store(d0, (u32x4*)p); __builtin_nontemporal_store(d1, (u32x4*)(p + (size_t)8 * ldc)); }
                else { *(u32x4*)p = d0; *(u32x4*)(p + (size_t)8 * ldc) = d1; } }
    }
};
struct EpiLora {
    static constexpr bool PERM = true, AFTER_DRAIN = false;
    bf16_t* O; int ldc; const float* w0; const float* a0;
    __device__ __forceinline__ void operator()(const f32x4 (&acc)[2][2][4][2], const Unit& u, int wr, int wc, int fr, int fq) const {
        const int rowg = u.pm * BM + wr * 64; const bool lo = fr < 8;
        const int type = u.pn >> 2, cb0 = (u.pn & 3) * BM + wc * 64 + 8 * fq;
        const float* bias = (type == 0) ? w0 : a0;
        const float sc = (type == 0) ? 0.6065306597126334f : 1.0f;
        f32x4 bz[2][2] = {{{0.f, 0.f, 0.f, 0.f}, {0.f, 0.f, 0.f, 0.f}}, {{0.f, 0.f, 0.f, 0.f}, {0.f, 0.f, 0.f, 0.f}}};
        if (type < 2) {
#pragma unroll
            for (int bj = 0; bj < 2; ++bj) { bz[bj][0] = *(const f32x4*)(bias + cb0 + bj * 32); bz[bj][1] = *(const f32x4*)(bias + cb0 + bj * 32 + 4); } }
        bf16_t* sp = O + (size_t)(rowg + (fr & 7)) * ldc + u.pn * BM + wc * 64 + (fr >> 3) * 32 + 8 * fq;
#pragma unroll
        for (int ai = 0; ai < 2; ++ai)
#pragma unroll
            for (int m = 0; m < 4; ++m) { u32x4 w[2];
#pragma unroll
                for (int bj = 0; bj < 2; ++bj) {
                    f32x4 v0 = acc[ai][bj][m][0] + bz[bj][0], v1 = acc[ai][bj][m][1] + bz[bj][1];
                    if (type < 2) {
#pragma unroll
                        for (int i = 0; i < 4; ++i) { v0[i] = sc * __builtin_amdgcn_rcpf(1.f + __expf(-v0[i])); v1[i] = sc * __builtin_amdgcn_rcpf(1.f + __expf(-v1[i])); } }
                    w[bj] = pack8(v0, v1); }
                u32x4 d0, d1; xch8(w[0], w[1], lo, d0, d1);
                bf16_t* p = sp + (size_t)(ai * HALF + m * 16) * ldc;
                __builtin_nontemporal_store(d0, (u32x4*)p); __builtin_nontemporal_store(d1, (u32x4*)(p + (size_t)8 * ldc)); }
    }
};
struct EpiNull {
    static constexpr bool PERM = true, AFTER_DRAIN = false;
    __device__ __forceinline__ void operator()(const f32x4 (&acc)[2][2][4][2], const Unit&, int, int, int, int) const {
#pragma unroll
        for (int ai = 0; ai < 2; ++ai)
#pragma unroll
            for (int bj = 0; bj < 2; ++bj)
#pragma unroll
                for (int m = 0; m < 4; ++m)
#pragma unroll
                    for (int n = 0; n < 2; ++n) asm volatile("" :: "v"(acc[ai][bj][m][n]));
    }
};
template <bool RES_BF16, bool SCALE> struct EpiResB {
    static constexpr bool PERM = true, AFTER_DRAIN = false;
    const float* resf; bf16_t* xn; int ldc; const float* ssin; float* ssout; float inv_n, eps;
    __device__ __forceinline__ void operator()(const f32x4 (&acc)[2][2][4][2], const Unit& u, int wr, int wc, int fr, int fq) const {
        const int rowg = u.pm * BM + wr * 64, colw = u.pn * BM + wc * 64; const bool lo = fr < 8;
        bf16_t* sp = xn + (size_t)(rowg + (fr & 7)) * ldc + colw + (fr >> 3) * 32 + 8 * fq;
        const float* lp = resf + (size_t)(rowg + (fr & 7)) * ldc + colw + 8 * fq + (fr >> 3) * 4;
#pragma unroll
        for (int ai = 0; ai < 2; ++ai)
#pragma unroll
            for (int m = 0; m < 4; ++m) { const int row = rowg + ai * HALF + m * 16 + fr; const size_t go = (size_t)(ai * HALF + m * 16) * ldc; float sq = 0.f;
                float s = 1.f; if (SCALE) s = __builtin_amdgcn_rcpf(ssin[row] * inv_n + eps);
                f32x4 r[2][2];
                if (RES_BF16) { const u32x4 L0 = *(const u32x4*)(sp + go), L1 = *(const u32x4*)(sp + go + (size_t)8 * ldc); u32x4 w[2]; xch8(L0, L1, lo, w[0], w[1]);
#pragma unroll
                    for (int bj = 0; bj < 2; ++bj) {
                        r[bj][0] = (f32x4){__builtin_bit_cast(float, w[bj].x << 16), __builtin_bit_cast(float, w[bj].x & 0xffff0000u), __builtin_bit_cast(float, w[bj].y << 16), __builtin_bit_cast(float, w[bj].y & 0xffff0000u)};
                        r[bj][1] = (f32x4){__builtin_bit_cast(float, w[bj].z << 16), __builtin_bit_cast(float, w[bj].z & 0xffff0000u), __builtin_bit_cast(float, w[bj].w << 16), __builtin_bit_cast(float, w[bj].w & 0xffff0000u)}; } }
                else {
#pragma unroll
                    for (int bj = 0; bj < 2; ++bj) { const u32x4 L0 = __builtin_nontemporal_load((const u32x4*)(lp + go + bj * 32)), L1 = __builtin_nontemporal_load((const u32x4*)(lp + go + bj * 32 + (size_t)8 * ldc));
                        u32x4 w0, w1; xch8(L0, L1, lo, w0, w1); r[bj][0] = __builtin_bit_cast(f32x4, w0); r[bj][1] = __builtin_bit_cast(f32x4, w1); } }
                u32x4 wo[2];
#pragma unroll
                for (int bj = 0; bj < 2; ++bj) {
                    const f32x4 o0 = r[bj][0] + acc[ai][bj][m][0] * s, o1 = r[bj][1] + acc[ai][bj][m][1] * s;
                    sq += (o0[0] * o0[0] + o0[1] * o0[1]) + (o0[2] * o0[2] + o0[3] * o0[3]) + (o1[0] * o1[0] + o1[1] * o1[1]) + (o1[2] * o1[2] + o1[3] * o1[3]);
                    wo[bj] = pack8(o0, o1); }
                u32x4 d0, d1; xch8(wo[0], wo[1], lo, d0, d1);
                *(u32x4*)(sp + go) = d0; *(u32x4*)(sp + go + (size_t)8 * ldc) = d1;
                sq = fq_sum(sq);
                if (fq == 0) atomicAdd(ssout + row, sq);
                asm volatile("" ::: "memory"); }
    }
};
struct PanelOrder {
    int c;
    __device__ __forceinline__ bool next(int i, Unit& u) const { if (i >= 2 || c >= 256) return false; u.pm = 32 * i + (c & 31); u.pn = c >> 5; return true; }
    __device__ __forceinline__ void a_ready(const Unit&) const {}
    __device__ __forceinline__ void done(const Unit&) const {}
};
struct EpiFinal {
    static constexpr bool PERM = true, AFTER_DRAIN = false;
    const bf16_t* xn; int ldc; const float* ssin; float* ss3; unsigned* pcnt; const float* gain; float* out; float inv_n, eps; unsigned* tmo;
    __device__ __forceinline__ void operator()(const f32x4 (&acc_)[2][2][4][2], const Unit& u, int wr, int wc, int fr, int fq) const {
        f32x4 (&acc)[2][2][4][2] = const_cast<f32x4 (&)[2][2][4][2]>(acc_);
        const int row0 = u.pm * BM + wr * 64 + fr, col0 = u.pn * BM + wc * 64 + 8 * fq; const bool lo = fr < 8;
#pragma unroll
        for (int ai = 0; ai < 2; ++ai)
#pragma unroll
            for (int m = 0; m < 4; ++m) { const int row = row0 + ai * HALF + m * 16; float sq = 0.f;
                const float s = __builtin_amdgcn_rcpf(ssin[row] * inv_n + eps);
                const bf16_t* lp = xn + (size_t)(row - fr + (fr & 7)) * ldc + u.pn * BM + wc * 64 + (fr >> 3) * 32 + 8 * fq;
                u32x4 wx[2]; { const u32x4 L0 = *(const u32x4*)lp, L1 = *(const u32x4*)(lp + (size_t)8 * ldc); xch8(L0, L1, lo, wx[0], wx[1]); }
#pragma unroll
                for (int bj = 0; bj < 2; ++bj) { const u32x4 w = wx[bj];
                    const f32x4 r0 = {__builtin_bit_cast(float, w.x << 16), __builtin_bit_cast(float, w.x & 0xffff0000u), __builtin_bit_cast(float, w.y << 16), __builtin_bit_cast(float, w.y & 0xffff0000u)};
                    const f32x4 r1 = {__builtin_bit_cast(float, w.z << 16), __builtin_bit_cast(float, w.z & 0xffff0000u), __builtin_bit_cast(float, w.w << 16), __builtin_bit_cast(float, w.w & 0xffff0000u)};
                    const f32x4 o0 = r0 + acc[ai][bj][m][0] * s, o1 = r1 + acc[ai][bj][m][1] * s; acc[ai][bj][m][0] = o0; acc[ai][bj][m][1] = o1;
                    sq += (o0[0] * o0[0] + o0[1] * o0[1]) + (o0[2] * o0[2] + o0[3] * o0[3]) + (o1[0] * o1[0] + o1[1] * o1[1]) + (o1[2] * o1[2] + o1[3] * o1[3]); }
                sq = fq_sum(sq);
                if (fq == 0) atomicAdd(ss3 + row, sq);
                asm volatile("" ::: "memory"); }
        asm volatile("s_waitcnt vmcnt(0)" ::: "memory"); __syncthreads();
        unsigned* cw = pcnt + 64 * u.pm;
        if (wr == 0 && wc == 0) {
            if (fr == 0 && fq == 0) { __builtin_amdgcn_fence(__ATOMIC_RELEASE, "agent"); asm volatile("s_waitcnt vmcnt(0)" ::: "memory"); __hip_atomic_fetch_add(cw, 1u, __ATOMIC_RELAXED, __HIP_MEMORY_SCOPE_AGENT); }
            unsigned spins = 0;
            while ((unsigned)__builtin_amdgcn_readfirstlane(__hip_atomic_load(cw, __ATOMIC_RELAXED, __HIP_MEMORY_SCOPE_AGENT)) < 8u) {
                __builtin_amdgcn_s_sleep(2);
                if (++spins > (1u << 22)) { if (fr == 0 && fq == 0) __hip_atomic_store(tmo, 1u, __ATOMIC_RELAXED, __HIP_MEMORY_SCOPE_AGENT); break; } }
            __builtin_amdgcn_fence(__ATOMIC_ACQUIRE, "agent"); asm volatile("s_waitcnt vmcnt(0)" ::: "memory");
        }
        __syncthreads();
#pragma unroll
        for (int ai = 0; ai < 2; ++ai)
#pragma unroll
            for (int m = 0; m < 4; ++m) { const int row = row0 + ai * HALF + m * 16;
                const float rs = __builtin_amdgcn_rsqf(__hip_atomic_load(ss3 + row, __ATOMIC_RELAXED, __HIP_MEMORY_SCOPE_AGENT) * inv_n + eps);
                float* p = out + (size_t)(row - fr + (fr & 7)) * ldc + col0 + (fr >> 3) * 4;
#pragma unroll
                for (int bj = 0; bj < 2; ++bj) { const f32x4 g0 = *(const f32x4*)(gain + col0 + bj * 32), g1 = *(const f32x4*)(gain + col0 + bj * 32 + 4);
                    const f32x4 y0 = acc[ai][bj][m][0] * rs * g0, y1 = acc[ai][bj][m][1] * rs * g1;
                    u32x4 d0, d1; xch8(__builtin_bit_cast(u32x4, y0), __builtin_bit_cast(u32x4, y1), lo, d0, d1);
                    __builtin_nontemporal_store(d0, (u32x4*)(p + bj * 32));
                    __builtin_nontemporal_store(d1, (u32x4*)(p + bj * 32 + (size_t)8 * ldc)); } }
    }
};
template <class Epi, class Sched, bool ALIGN_EPI = false, bool SP2 = false>
__device__ __forceinline__ void gemm_phase(PG8_LAS unsigned char* lds, const Gemm g, const Sched& S, const Epi& E, const int wv  ) {
    int tid_ = wv * 64 + (int)__builtin_amdgcn_mbcnt_hi(~0u, __builtin_amdgcn_mbcnt_lo(~0u, 0u)); asm volatile("" : "+v"(tid_));
    const int tid = tid_, wid = __builtin_amdgcn_readfirstlane(tid >> 6), lane = tid & 63, wr = wid >> 2, wc = wid & 3, fr = lane & 15, fq = lane >> 4;
    const int K = g.K, nt = K / BK, LD = g.ld ? g.ld : g.K;
    unsigned voffA[2], voffB[2];
#pragma unroll
    for (int i = 0; i < 2; ++i) { int R, C; stage_rc(tid * 16 + i * 8192, R, C); const int Rb = (R >> 5) * 64 + (Epi::PERM ? perm32(R & 31) : (R & 31));
        voffA[i] = (unsigned)(R * LD + C) * 2u; voffB[i] = (unsigned)(Rb * LD + C) * 2u; }
    const size_t kstep = (size_t)(BK * 2);
    const size_t hstep = (size_t)HALF * LD * 2;
    const size_t tstep = 2 * hstep;
    const size_t hstepB = (size_t)32 * LD * 2;
    const unsigned ldsw = (unsigned)wid * 1024u;
    const int aoff = lds_byte(wr * 64 + fr, fq * 8), boff = lds_byte(wc * 32 + fr, fq * 8);
#define PG8_SA(b, h) (((b) * 2 + (h)) * HTB)
#define PG8_SB(b, h) ((4 + (b) * 2 + (h)) * HTB)
#define PG8_STAGE(bufoff, gbase, voff) do { _Pragma("unroll") for (int _i = 0; _i < 2; ++_i) \
        __builtin_amdgcn_global_load_lds((const unsigned*)((const char*)(gbase) + (voff)[_i]), (PG8_LAS unsigned*)(lds + (bufoff) + ldsw + _i * 8192), 16, 0, 0); } while (0)
#define PG8_LDA(dst, b, h) do { _Pragma("unroll") for (int m = 0; m < 4; ++m) _Pragma("unroll") for (int k = 0; k < 2; ++k) dst[m][k] = *(const PG8_LAS bf16x8*)(lds + PG8_SA(b, h) + aoff + m * 2048 + k * 1024); } while (0)
#define PG8_LDB(dst, b, h) do { _Pragma("unroll") for (int n = 0; n < 2; ++n) _Pragma("unroll") for (int k = 0; k < 2; ++k) dst[n][k] = *(const PG8_LAS bf16x8*)(lds + PG8_SB(b, h) + boff + n * 2048 + k * 1024); } while (0)
#define PG8_MMA(ai, bj, At, Bt) do { __builtin_amdgcn_s_setprio(1); _Pragma("unroll") for (int m = 0; m < 4; ++m) _Pragma("unroll") for (int n = 0; n < 2; ++n) _Pragma("unroll") for (int k = 0; k < 2; ++k) \
        acc[ai][bj][m][n] = __builtin_amdgcn_mfma_f32_16x16x32_bf16(Bt[n][k], At[m][k], acc[ai][bj][m][n], 0, 0, 0); __builtin_amdgcn_s_setprio(0); } while (0)
#define PG8_WAIT_V(n) asm volatile("s_waitcnt vmcnt(" #n ")" ::: "memory")
#define PG8_WAIT_L(n) asm volatile("s_waitcnt lgkmcnt(" #n ")" ::: "memory")
#define PG8_BAR __builtin_amdgcn_s_barrier()
#define PG8_SCHED __builtin_amdgcn_sched_barrier(0)
    Unit cur, nxt; int ui = 0;
    if (!S.next(0, cur)) return;
    f32x4 acc[2][2][4][2];
#pragma unroll
    for (int a = 0; a < 2; ++a)
#pragma unroll
        for (int b = 0; b < 2; ++b)
#pragma unroll
            for (int m = 0; m < 4; ++m)
#pragma unroll
                for (int n = 0; n < 2; ++n) acc[a][b][m][n] = (f32x4){0.f, 0.f, 0.f, 0.f};
    bf16x8 At[4][2], B0[2][2], B1[2][2];
#define PG8_KOF(u) ((size_t)((g.kofs && (u).pn >= g.kpn) ? g.kofs : 0))
    const char* cA = (const char*)g.A + (size_t)cur.pm * tstep + PG8_KOF(cur); const char* cB = (const char*)g.Bt + (size_t)cur.pn * tstep + PG8_KOF(cur);
    S.a_ready(cur);
    if constexpr (SP2) {
        PG8_STAGE(PG8_SB(0, 0), cB, voffB); PG8_STAGE(PG8_SB(0, 1), cB + hstepB, voffB); PG8_STAGE(PG8_SA(0, 0), cA, voffA); PG8_STAGE(PG8_SA(0, 1), cA + hstep, voffA);
        if (wr == 1) PG8_BAR;
        PG8_WAIT_V(2); PG8_BAR;
        PG8_STAGE(PG8_SB(1, 0), cB + kstep, voffB); PG8_STAGE(PG8_SA(1, 0), cA + kstep, voffA); PG8_STAGE(PG8_SB(1, 1), cB + hstepB + kstep, voffB);
        PG8_WAIT_V(6); PG8_BAR;
    } else {
        PG8_STAGE(PG8_SB(0, 0), cB, voffB); PG8_STAGE(PG8_SA(0, 0), cA, voffA); PG8_STAGE(PG8_SB(0, 1), cB + hstepB, voffB); PG8_STAGE(PG8_SA(0, 1), cA + hstep, voffA);
        if (wr == 1) PG8_BAR;
        PG8_WAIT_V(4); PG8_BAR;
        PG8_STAGE(PG8_SB(1, 0), cB + kstep, voffB); PG8_STAGE(PG8_SA(1, 0), cA + kstep, voffA); PG8_STAGE(PG8_SB(1, 1), cB + hstepB + kstep, voffB);
        PG8_WAIT_V(6); PG8_BAR;
    }
    for (;;) {
        const bool has_next = S.next(ui + 1, nxt);
        const char* nA = has_next ? (const char*)g.A + (size_t)nxt.pm * tstep + PG8_KOF(nxt) : cA; const char* nB = has_next ? (const char*)g.Bt + (size_t)nxt.pn * tstep + PG8_KOF(nxt) : cB;
        for (int t = 0; t < nt; t += 2) {
            const bool last = (t == nt - 2);
            const char* a1 = cA + (size_t)(t + 1) * kstep;
            const char* a2 = last ? nA : cA + (size_t)(t + 2) * kstep; const char* b2 = last ? nB : cB + (size_t)(t + 2) * kstep;
            const char* a3 = a2 + kstep; const char* b3 = b2 + kstep;
            if (last && has_next) S.a_ready(nxt);
            if constexpr (SP2) {
            PG8_LDB(B0, 0, 0); PG8_LDB(B1, 0, 1); PG8_SCHED; PG8_LDA(At, 0, 0); PG8_STAGE(PG8_SA(1, 1), a1 + hstep, voffA);
            PG8_WAIT_V(8); PG8_WAIT_L(0); PG8_BAR; PG8_MMA(0, 0, At, B0); PG8_MMA(0, 1, At, B1); PG8_BAR; PG8_SCHED;
            PG8_LDA(At, 0, 1); PG8_STAGE(PG8_SB(0, 0), b2, voffB); PG8_STAGE(PG8_SB(0, 1), b2 + hstepB, voffB); PG8_STAGE(PG8_SA(0, 0), a2, voffA);
            PG8_WAIT_V(8); PG8_WAIT_L(0); PG8_BAR; PG8_MMA(1, 0, At, B0); PG8_MMA(1, 1, At, B1); PG8_BAR; PG8_SCHED;
            PG8_LDB(B0, 1, 0); PG8_LDB(B1, 1, 1); PG8_SCHED; PG8_LDA(At, 1, 0); PG8_STAGE(PG8_SA(0, 1), a2 + hstep, voffA);
            PG8_WAIT_V(8); PG8_WAIT_L(0); PG8_BAR; PG8_MMA(0, 0, At, B0); PG8_MMA(0, 1, At, B1); PG8_BAR; PG8_SCHED;
            PG8_LDA(At, 1, 1); PG8_STAGE(PG8_SB(1, 0), b3, voffB); PG8_STAGE(PG8_SB(1, 1), b3 + hstepB, voffB); PG8_STAGE(PG8_SA(1, 0), a3, voffA);
            PG8_WAIT_V(8); PG8_WAIT_L(0); PG8_BAR; PG8_MMA(1, 0, At, B0); PG8_MMA(1, 1, At, B1); PG8_BAR; PG8_SCHED;
            } else {
            PG8_LDB(B0, 0, 0); PG8_SCHED; PG8_LDA(At, 0, 0); PG8_STAGE(PG8_SA(1, 1), a1 + hstep, voffA);
            PG8_WAIT_L(8); PG8_BAR; PG8_WAIT_L(0); PG8_MMA(0, 0, At, B0); PG8_BAR; PG8_SCHED;
            PG8_LDB(B1, 0, 1); PG8_STAGE(PG8_SB(0, 0), b2, voffB);
            PG8_BAR; PG8_WAIT_L(0); PG8_MMA(0, 1, At, B1); PG8_BAR;
            PG8_LDA(At, 0, 1); PG8_STAGE(PG8_SA(0, 0), a2, voffA);
            PG8_BAR; PG8_WAIT_L(0); PG8_MMA(1, 0, At, B0); PG8_BAR; PG8_SCHED;
            PG8_STAGE(PG8_SB(0, 1), b2 + hstepB, voffB);
            PG8_WAIT_V(6); PG8_BAR; PG8_MMA(1, 1, At, B1); PG8_BAR;
            PG8_LDB(B0, 1, 0); PG8_SCHED; PG8_LDA(At, 1, 0); PG8_STAGE(PG8_SA(0, 1), a2 + hstep, voffA);
            PG8_WAIT_L(8); PG8_BAR; PG8_WAIT_L(0); PG8_MMA(0, 0, At, B0); PG8_BAR; PG8_SCHED;
            PG8_LDB(B1, 1, 1); PG8_STAGE(PG8_SB(1, 0), b3, voffB);
            PG8_BAR; PG8_WAIT_L(0); PG8_MMA(0, 1, At, B1); PG8_BAR;
            PG8_LDA(At, 1, 1); PG8_STAGE(PG8_SA(1, 0), a3, voffA);
            PG8_BAR; PG8_WAIT_L(0); PG8_MMA(1, 0, At, B0); PG8_BAR; PG8_SCHED;
            PG8_STAGE(PG8_SB(1, 1), b3 + hstepB, voffB);
            PG8_WAIT_V(6); PG8_BAR; PG8_MMA(1, 1, At, B1); PG8_BAR;
            }
        }
        if constexpr (ALIGN_EPI) { if (wr == 0) PG8_BAR; }
        if constexpr (!Epi::AFTER_DRAIN) { E(acc, cur, wr, wc, fr, fq); S.done(cur); }
        if (!has_next) break;
#pragma unroll
        for (int a = 0; a < 2; ++a)
#pragma unroll
            for (int b = 0; b < 2; ++b)
#pragma unroll
                for (int m = 0; m < 4; ++m)
#pragma unroll
                    for (int n = 0; n < 2; ++n) acc[a][b][m][n] = (f32x4){0.f, 0.f, 0.f, 0.f};
        cur = nxt; cA = nA; cB = nB; ++ui;
        if constexpr (ALIGN_EPI) { if (wr == 1) PG8_BAR; }
    }
    PG8_WAIT_V(0);
    if constexpr (!ALIGN_EPI) { if (wr == 0) PG8_BAR; }
    PG8_BAR;
    if constexpr (Epi::AFTER_DRAIN) { E.fused(acc, cur, wr, wc, fr, fq, lds, wid, lane); S.done(cur); }
#undef PG8_KOF
#undef PG8_SA
#undef PG8_SB
#undef PG8_STAGE
#undef PG8_LDA
#undef PG8_LDB
#undef PG8_MMA
#undef PG8_WAIT_V
#undef PG8_WAIT_L
#undef PG8_BAR
#undef PG8_SCHED
}
}
namespace att {
typedef unsigned short bf16;
constexpr int   D = 128, NW = 8, QBLK = 32, KVBLK = 64;
constexpr float SCALE = 0.088388347648318440f;
constexpr float THR = 8.f;
constexpr size_t SHM_V = KVBLK * D * 2, SHM_K = KVBLK * D * 2, SHM_ATTN = 2 * SHM_V + 2 * SHM_K + NW * 64 * 4;
using bf16x8 = __attribute__((ext_vector_type(8))) short;
using s16x4  = __attribute__((ext_vector_type(4))) short;
using f32x16 = __attribute__((ext_vector_type(16))) float;
using u32x4  = __attribute__((ext_vector_type(4))) unsigned;
using u32x2  = __attribute__((ext_vector_type(2))) unsigned;
#define KSWZ(row, colB) ((row) * 256 + ((colB) ^ (((row) & 7) << 4)))
#define SBAR() __builtin_amdgcn_sched_barrier(0)
__device__ __forceinline__ int crow(int r, int hi) { return (r & 3) + 8 * (r >> 2) + 4 * hi; }
__device__ __forceinline__ unsigned cvtpk(float lo, float hi) { unsigned r; asm volatile("v_cvt_pk_bf16_f32 %0, %1, %2" : "=v"(r) : "v"(lo), "v"(hi)); return r; }
__device__ __forceinline__ void mask16(f32x16& p, unsigned mw) {
#pragma unroll
  for (int r = 0; r < 16; ++r) { const int cr = (r & 3) + 8 * (r >> 2); const int m = __builtin_amdgcn_sbfe((int)mw, cr, 1); p[r] = __uint_as_float(__float_as_uint(p[r]) & (unsigned)m); }
}
template <bool MASKED>
__device__ __forceinline__ void partialSM(f32x16& p0, f32x16& p1, float& m_reg, float& mn, float& alpha) {
  constexpr float C = SCALE * 1.4426950408889634f;
  float pmax = p0[0];
#pragma unroll
  for (int r = 1; r < 16; ++r) pmax = fmaxf(pmax, p0[r]);
#pragma unroll
  for (int r = 0; r < 16; ++r) pmax = fmaxf(pmax, p1[r]);
  { auto rr = __builtin_amdgcn_permlane32_swap(__float_as_uint(pmax), __float_as_uint(pmax), false, false);
    pmax = fmaxf(__uint_as_float(rr[0]), __uint_as_float(rr[1])); }
  if (__builtin_expect(__all(pmax - m_reg <= THR / SCALE), 1)) { mn = m_reg; alpha = 1.f; }
  else { mn = fmaxf(m_reg, pmax); alpha = __builtin_amdgcn_exp2f((m_reg - mn) * C); m_reg = mn; }
  float mnC = -mn * C;
#pragma unroll
  for (int r = 0; r < 16; ++r) p0[r] = fmaf(p0[r], C, mnC);
#pragma unroll
  for (int r = 0; r < 16; ++r) p1[r] = fmaf(p1[r], C, mnC);
#pragma unroll
  for (int r = 0; r < 16; ++r) p0[r] = __builtin_amdgcn_exp2f(p0[r]);
}
template <bool MASKED>
__device__ __forceinline__ void finishSM(f32x16& p0, f32x16& p1, float alpha, float& l_reg, bf16x8& pa0, bf16x8& pa1, bf16x8& pa2, bf16x8& pa3, unsigned mw0, unsigned mw1) {
#pragma unroll
  for (int r = 0; r < 16; ++r) p1[r] = __builtin_amdgcn_exp2f(p1[r]);
  if (MASKED) { mask16(p0, mw0); mask16(p1, mw1); }
  float ps = 0;
#pragma unroll
  for (int r = 0; r < 16; ++r) ps += p0[r];
#pragma unroll
  for (int r = 0; r < 16; ++r) ps += p1[r];
  { auto rr = __builtin_amdgcn_permlane32_swap(__float_as_uint(ps), __float_as_uint(ps), false, false);
    ps = __uint_as_float(rr[0]) + __uint_as_float(rr[1]); }
  l_reg = l_reg * alpha + ps;
#define PK4(P, BASE, OUT) do { unsigned a0 = cvtpk(P[BASE + 0], P[BASE + 1]), a1 = cvtpk(P[BASE + 2], P[BASE + 3]);   \
    unsigned b0 = cvtpk(P[BASE + 4], P[BASE + 5]), b1 = cvtpk(P[BASE + 6], P[BASE + 7]);                              \
    auto r0 = __builtin_amdgcn_permlane32_swap(a0, b0, false, false); auto r1 = __builtin_amdgcn_permlane32_swap(a1, b1, false, false); \
    u32x4 w = {r0[0], r1[0], r0[1], r1[1]}; OUT = *reinterpret_cast<bf16x8*>(&w); } while (0)
  PK4(p0, 0, pa0); PK4(p0, 8, pa1); PK4(p1, 0, pa2); PK4(p1, 8, pa3);
#undef PK4
}
__device__ __forceinline__ void qkt(f32x16& p0, f32x16& p1, const bf16* Ks, const bf16x8* qr, int r32, int hi) {
  p0 = f32x16{}; p1 = f32x16{};
#pragma unroll
  for (int d0 = 0; d0 < 8; ++d0) { int cb = (d0 * 16 + hi * 8) * 2;
    bf16x8 b0 = *reinterpret_cast<const bf16x8*>((const char*)Ks + KSWZ(r32, cb));
    bf16x8 b1 = *reinterpret_cast<const bf16x8*>((const char*)Ks + KSWZ(32 + r32, cb));
    p0 = __builtin_amdgcn_mfma_f32_32x32x16_bf16(b0, qr[d0], p0, 0, 0, 0);
    p1 = __builtin_amdgcn_mfma_f32_32x32x16_bf16(b1, qr[d0], p1, 0, 0, 0); }
}
__device__ __forceinline__ int v_st(int k, int c) { const int kk = (k & ~0xC) | ((k & 4) << 1) | ((k & 8) >> 1); return ((kk >> 3) * 4 + (c >> 5)) * 512 + ((kk & 7) * 32 + (c & 31)) * 2; }
__device__ __forceinline__ int v_rd_base(int lane) { return ((lane & 3) << 3) | (((lane >> 2) & 3) << 6) | (((lane >> 4) & 1) << 5) | (((lane >> 5) & 1) << 8); }
constexpr int v_rd_off(int d0, int ks, int half) { return d0 * 512 + ks * 4096 + half * 2048; }
template <int OFF> __device__ __forceinline__ s16x4 tr_read(int vb) {
  s16x4 r; asm volatile("ds_read_b64_tr_b16 %0, %1 offset:%2" : "=&v"(r) : "v"(vb), "i"(OFF) : "memory"); return r;
}
template <int D0> __device__ __forceinline__ void pv_one(f32x16& od, int vb, bf16x8 pa0, bf16x8 pa1, bf16x8 pa2, bf16x8 pa3) {
  const s16x4 l0 = tr_read<v_rd_off(D0, 0, 0)>(vb), h0 = tr_read<v_rd_off(D0, 0, 1)>(vb), l1 = tr_read<v_rd_off(D0, 1, 0)>(vb), h1 = tr_read<v_rd_off(D0, 1, 1)>(vb);
  const s16x4 l2 = tr_read<v_rd_off(D0, 2, 0)>(vb), h2 = tr_read<v_rd_off(D0, 2, 1)>(vb), l3 = tr_read<v_rd_off(D0, 3, 0)>(vb), h3 = tr_read<v_rd_off(D0, 3, 1)>(vb);
  asm volatile("s_waitcnt lgkmcnt(0)" ::: "memory"); SBAR();
#define PK(L, H) (bf16x8){L[0], L[1], L[2], L[3], H[0], H[1], H[2], H[3]}
  od = __builtin_amdgcn_mfma_f32_32x32x16_bf16(pa0, PK(l0, h0), od, 0, 0, 0);
  od = __builtin_amdgcn_mfma_f32_32x32x16_bf16(pa1, PK(l1, h1), od, 0, 0, 0);
  od = __builtin_amdgcn_mfma_f32_32x32x16_bf16(pa2, PK(l2, h2), od, 0, 0, 0);
  od = __builtin_amdgcn_mfma_f32_32x32x16_bf16(pa3, PK(l3, h3), od, 0, 0, 0);
#undef PK
}
__device__ __forceinline__ void pv_d0(f32x16* o, int vb, bf16x8 pa0, bf16x8 pa1, bf16x8 pa2, bf16x8 pa3) {
  pv_one<0>(o[0], vb, pa0, pa1, pa2, pa3); pv_one<1>(o[1], vb, pa0, pa1, pa2, pa3); pv_one<2>(o[2], vb, pa0, pa1, pa2, pa3); pv_one<3>(o[3], vb, pa0, pa1, pa2, pa3);
}
template <int LDQ, int LDK, int LDO, bool MASKED, int SDEPTH>
__device__ __forceinline__ void attn_body(const bf16* __restrict__ Qb, const bf16* __restrict__ Kh, const bf16* __restrict__ Vh,
                                          bf16* __restrict__ Ob, const unsigned* __restrict__ mrow0, int seq, char* lds, const int wv) {
  int tid_ = wv * 64 + (int)__builtin_amdgcn_mbcnt_hi(~0u, __builtin_amdgcn_mbcnt_lo(~0u, 0u)); asm volatile("" : "+v"(tid_));
  const int tid = tid_, wid = tid >> 6, lane = tid & 63, r32 = lane & 31, hi = lane >> 5;
  bf16* V_lds = (bf16*)lds; bf16* K_lds = (bf16*)(lds + 2 * SHM_V);
  float* ws = (float*)(lds + 2 * SHM_V + 2 * SHM_K) + wid * 64; float* li_l = ws; float* al_l = ws + 32;
  float m_reg = -1e30f, l_reg = 0; f32x16 o[4] = {}; bf16x8 qr[8];
  const bf16* Qw = Qb + (long)(wid * QBLK + r32) * LDQ + hi * 8;
#pragma unroll
  for (int d0 = 0; d0 < 8; ++d0) qr[d0] = *reinterpret_cast<const bf16x8*>(Qw + d0 * 16);
  const int msh = 4 * hi;
  u32x2* mlds = (u32x2*)(lds + SHM_ATTN);
  if (MASKED) {
#pragma unroll 4
    for (int i = 0; i < 16; ++i) { const int idx = tid + 512 * i; mlds[(idx >> 5) * 33 + (idx & 31)] = *reinterpret_cast<const u32x2*>(mrow0 + 2 * idx); }
  }
  const int mro = (wid * QBLK + r32) * 33;
#define MLOAD(j) (MASKED ? mlds[mro + (j)] : (u32x2){0u, 0u})
  const int sr = tid >> 4, sc = (tid & 15) * 8, vst0 = v_st(sr, sc), vst1 = v_st(32 + sr, sc);
  const int vb0 = (int)(uintptr_t)V_lds + v_rd_base(lane);
  struct { bf16x8 vs0, vs1, ks0, ks1; } sr_[SDEPTH];
#define SLOAD(i, k0) do { sr_[i].vs0 = *reinterpret_cast<const bf16x8*>(&Vh[(long)((k0) + sr) * LDK + sc]); sr_[i].vs1 = *reinterpret_cast<const bf16x8*>(&Vh[(long)((k0) + 32 + sr) * LDK + sc]); \
    sr_[i].ks0 = *reinterpret_cast<const bf16x8*>(&Kh[(long)((k0) + sr) * LDK + sc]); sr_[i].ks1 = *reinterpret_cast<const bf16x8*>(&Kh[(long)((k0) + 32 + sr) * LDK + sc]); } while (0)
#define SWRITE(b, i) do { *(bf16x8*)((char*)V_lds + (b) * SHM_V + vst0) = sr_[i].vs0;          \
    *(bf16x8*)((char*)V_lds + (b) * SHM_V + vst1) = sr_[i].vs1; int kc = sc * 2;               \
    *(bf16x8*)((char*)K_lds + (b) * SHM_K + KSWZ(sr, kc)) = sr_[i].ks0;                       \
    *(bf16x8*)((char*)K_lds + (b) * SHM_K + KSWZ(32 + sr, kc)) = sr_[i].ks1; } while (0)
#define SWAIT() do { if constexpr (SDEPTH == 2) asm volatile("s_waitcnt vmcnt(4)" ::: "memory"); else asm volatile("s_waitcnt vmcnt(0)" ::: "memory"); } while (0)
#define RESC(a) do { if (__any((a) < 1.f)) { if (hi == 0) al_l[r32] = (a); asm volatile("s_waitcnt lgkmcnt(0)" ::: "memory"); \
    _Pragma("unroll") for (int d = 0; d < 4; ++d) _Pragma("unroll") for (int r = 0; r < 16; ++r) o[d][r] *= al_l[crow(r, hi)]; } } while (0)
  f32x16 pA0, pA1, pB0, pB1; float mnA, mnB, alA, alB; bf16x8 pa0, pa1, pa2, pa3; const int NT = seq / KVBLK;
  u32x2 mwA, mwB;
  constexpr int SE = 0, SO = SDEPTH - 1;
  SLOAD(SE, 0); asm volatile("s_waitcnt vmcnt(0)" ::: "memory"); SWRITE(0, SE); __syncthreads();
  qkt(pA0, pA1, K_lds, qr, r32, hi); partialSM<MASKED>(pA0, pA1, m_reg, mnA, alA);
  SLOAD(SO, KVBLK); if constexpr (SDEPTH == 2) { if (2 < NT) SLOAD(SE, 2 * KVBLK); }
  SWAIT(); SWRITE(1, SO); __syncthreads();
  for (int j = 1; j + 1 < NT; j += 2) {
    mwA = MLOAD(j - 1);
    SBAR(); qkt(pB0, pB1, (bf16*)((char*)K_lds + SHM_K), qr, r32, hi);
    finishSM<MASKED>(pA0, pA1, alA, l_reg, pa0, pa1, pa2, pa3, mwA[0] >> msh, mwA[1] >> msh); SBAR();
    SLOAD(SO, (j + SDEPTH) * KVBLK); SBAR();
    pv_d0(o, vb0, pa0, pa1, pa2, pa3); partialSM<MASKED>(pB0, pB1, m_reg, mnB, alB);
    __syncthreads(); SWAIT(); SWRITE(0, SE);
    RESC(alB); __syncthreads();
    mwB = MLOAD(j);
    SBAR(); qkt(pA0, pA1, K_lds, qr, r32, hi);
    finishSM<MASKED>(pB0, pB1, alB, l_reg, pa0, pa1, pa2, pa3, mwB[0] >> msh, mwB[1] >> msh); SBAR();
    if (SDEPTH == 1 || j + 3 < NT) SLOAD(SE, (j + 1 + SDEPTH) * KVBLK); SBAR();
    pv_d0(o, vb0 + (int)SHM_V, pa0, pa1, pa2, pa3); partialSM<MASKED>(pA0, pA1, m_reg, mnA, alA);
    __syncthreads(); SWAIT(); SWRITE(1, SO);
    RESC(alA); __syncthreads();
  }
  mwA = MLOAD(NT - 2);
  SBAR(); qkt(pB0, pB1, (bf16*)((char*)K_lds + SHM_K), qr, r32, hi);
  finishSM<MASKED>(pA0, pA1, alA, l_reg, pa0, pa1, pa2, pa3, mwA[0] >> msh, mwA[1] >> msh); SBAR();
  pv_d0(o, vb0, pa0, pa1, pa2, pa3); partialSM<MASKED>(pB0, pB1, m_reg, mnB, alB);
  __syncthreads(); RESC(alB);
  mwB = MLOAD(NT - 1);
  finishSM<MASKED>(pB0, pB1, alB, l_reg, pa0, pa1, pa2, pa3, mwB[0] >> msh, mwB[1] >> msh); SBAR();
  pv_d0(o, vb0 + (int)SHM_V, pa0, pa1, pa2, pa3);
  if (hi == 0) li_l[r32] = l_reg; asm volatile("s_waitcnt lgkmcnt(0)" ::: "memory");
  float rli[16];
#pragma unroll
  for (int r = 0; r < 16; ++r) rli[r] = __builtin_amdgcn_rcpf(li_l[crow(r, hi)]);
  bf16* Ow = Ob + (long)(wid * QBLK) * LDO;
#pragma unroll
  for (int r = 0; r < 16; ++r) { int orow = crow(r, hi);
#pragma unroll
    for (int d0 = 0; d0 < 4; ++d0) { const float v = o[d0][r] * rli[r]; unsigned u = __float_as_uint(v); u = (u + 0x7fffu + ((u >> 16) & 1u)) >> 16;
      Ow[(long)orow * LDO + d0 * 32 + r32] = (bf16)u; } }
  __syncthreads();
#undef SLOAD
#undef SWRITE
#undef SWAIT
#undef RESC
#undef MLOAD
}
#undef KSWZ
#undef SBAR
}
namespace cg = cooperative_groups;
constexpr int NWAVES = 8;
#ifndef WGM_P1
#define WGM_P1 4
#endif
#ifndef WGM_P11
#define WGM_P11 4
#endif
#ifndef WGM_P5
#define WGM_P5 2
#endif
#ifndef PROBE_PH
#define PROBE_PH -1
#endif
#ifndef ATT_SD
#define ATT_SD 2
#endif
#ifndef MK_ONE_LAUNCH
#define MK_ONE_LAUNCH 1
#endif
constexpr int NB = 8, SEQ = 2048, DM = 2048, T = NB * SEQ, NMEM = 256, TM = NB * NMEM;
constexpr int NIN = 6000, NP = 6144;
constexpr int C_R = 0, C_K = 1024, C_V = 2048, C_XW = 3072, C_XA = 3136, C_XG = 3200, C_Q = 3360, C_AK = 4384, C_AV = 4640, C_QI = 4896, C_KI = 5920, C_WI = 5984;
constexpr int DFF = 8192, NL = 3072, KL = 384;
constexpr float NORM_EPS = 1e-5f, RWKV_LN_EPS = 64e-5f;
constexpr size_t MiB = 1u << 20;
constexpr size_t WS_CTL = 0, CTL_ZERO_BYTES = 384 * 1024;
constexpr size_t WS_WIN = 2 * MiB, WS_WMIX = 26 * MiB, WS_WQ = 34 * MiB, WS_WKV = 36 * MiB, WS_WO = 40 * MiB, WS_WUP = 42 * MiB, WS_WDN = 74 * MiB, WS_WL = 106 * MiB;
constexpr size_t WS_XN = 110 * MiB, WS_MEMN = 174 * MiB, WS_MEMKV = 182 * MiB, WS_AL = 186 * MiB, WS_MASK = 198 * MiB, WS_QC = 202 * MiB, WS_OC = 218 * MiB;
constexpr size_t WS_Y = 236 * MiB, WS_P = 300 * MiB, WS_ACT = 236 * MiB, WS_END = 492 * MiB;
static_assert(WS_WL + (size_t)NL * KL * 2 <= WS_XN && WS_AL + (size_t)T * KL * 2 <= WS_MASK && WS_P + (size_t)T * NP * 2 <= WS_END && WS_ACT + (size_t)T * DFF * 2 <= WS_END, "ws map");
constexpr int CW_QUEUE = 64;
constexpr int CW_BAR = 4096;
constexpr int CW_SS1 = 32768, CW_SS2 = CW_SS1 + T, CW_SS3 = CW_SS2 + T, CW_PCNT = CW_SS3 + T + 64, CW_TMO = 2048;
static_assert((CW_PCNT + 64 * 64) * 4 <= (int)CTL_ZERO_BYTES, "control words inside the memset");
constexpr int RING_BYTES = 131072, LDS_BYTES = 147456, MISC_OFF = LDS_BYTES - 256;

#define GAS __attribute__((address_space(1)))
#define LAS __attribute__((address_space(3)))
typedef unsigned short bf16;
typedef unsigned v4u __attribute__((ext_vector_type(4)));
typedef unsigned v2u __attribute__((ext_vector_type(2)));
typedef float f32x4 __attribute__((ext_vector_type(4)));
typedef float f32x16 __attribute__((ext_vector_type(16)));
typedef short bf16x8 __attribute__((ext_vector_type(8)));
typedef GAS unsigned gu32;
#define RLX_AGENT __ATOMIC_RELAXED, __HIP_MEMORY_SCOPE_AGENT
#define LDS_WAIT() asm volatile("s_waitcnt lgkmcnt(0)" ::: "memory")
#define VM_WAIT() asm volatile("s_waitcnt vmcnt(0)" ::: "memory")
__device__ __forceinline__ unsigned f2bf(float f) { unsigned u = __builtin_bit_cast(unsigned, f); return (u + 0x7fffu + ((u >> 16) & 1u)) >> 16; }
__device__ __forceinline__ unsigned pk2(float lo, float hi) { return f2bf(lo) | (f2bf(hi) << 16); }
__device__ __forceinline__ float bf2f(unsigned short h) { return __builtin_bit_cast(float, (unsigned)h << 16); }
__device__ __forceinline__ float bflo(unsigned w) { return __builtin_bit_cast(float, w << 16); }
__device__ __forceinline__ float bfhi(unsigned w) { return __builtin_bit_cast(float, w & 0xffff0000u); }
__device__ __forceinline__ float wave_sum(float v) {
#pragma unroll
    for (int o = 1; o < 64; o <<= 1) v += __shfl_xor(v, o);
    return v;
}
__device__ __forceinline__ float quad_sum(float v) {
    v += __builtin_bit_cast(float, __builtin_amdgcn_update_dpp(0, __builtin_bit_cast(int, v), 0xB1, 0xF, 0xF, false));
    v += __builtin_bit_cast(float, __builtin_amdgcn_update_dpp(0, __builtin_bit_cast(int, v), 0x4E, 0xF, 0xF, false));
    return v;
}

struct Args { const void* in[26]; float* out; unsigned char* ws; int ph_lo, ph_hi; };

struct Frame {
    LAS unsigned char* lds; int tid, lane, wave, G, bid, wv;
    const float *x, *mem; const int* pos;
    const float *norm_mix, *w_in, *mu, *w0, *wd_up, *a0, *a_up, *g_up, *k_k, *k_a, *r_k, *lnx_w, *lnx_b, *w_mix, *norm_cross, *norm_mem, *w_q, *w_kv, *w_o, *norm_mlp, *w_up, *w_dn, *norm_final;
    float* out; unsigned* ctl;
    bf16 *WIN, *WMIX, *WQ, *WKV, *WO, *WUP, *WDN, *WL, *XN, *MEMN, *MEMKV, *AL, *QC, *OC, *Y, *P, *ACT, *EWAG; unsigned* MASK;
};

__device__ __forceinline__ void p0_transpose_item(const float* W, int K, int N, int NPAD, bf16* WT, LAS float* scr, int item, int lane, const float* gain = nullptr) {
    const int nblk = NPAD / 64, kb = item / nblk, nb = item % nblk, k0 = 64 * kb, n0 = 64 * nb;
    const int c4 = (lane & 15) * 4, kr = lane >> 4; const bool ok = (n0 + c4) < N;
    f32x4 v[16];
#pragma unroll
    for (int i = 0; i < 16; ++i) v[i] = ok ? __builtin_nontemporal_load((const f32x4*)(W + (size_t)(k0 + kr + 4 * i) * N + n0 + c4)) : (f32x4){0.f, 0.f, 0.f, 0.f};
#pragma unroll
    for (int i = 0; i < 16; ++i) { LAS float* s = scr + (kr + 4 * i) * 65 + c4; const float gk = gain ? gain[k0 + kr + 4 * i] : 1.f; s[0] = v[i].x * gk; s[1] = v[i].y * gk; s[2] = v[i].z * gk; s[3] = v[i].w * gk; }
    LDS_WAIT(); asm volatile("" ::: "memory");
    const int c = lane & 7;
#pragma unroll
    for (int j = 0; j < 8; ++j) { const int n = (lane >> 3) + 8 * j; const LAS float* s = scr + (8 * c) * 65 + n;
        v4u o; o.x = pk2(s[0 * 65], s[1 * 65]); o.y = pk2(s[2 * 65], s[3 * 65]); o.z = pk2(s[4 * 65], s[5 * 65]); o.w = pk2(s[6 * 65], s[7 * 65]);
        *(v4u*)(WT + (size_t)(n0 + n) * K + k0 + 8 * c) = o; }
    LDS_WAIT(); asm volatile("" ::: "memory");
}
__device__ __forceinline__ void rms_row_to_bf16(const float* xrow, const float* g, bf16* orow, int lane) {
    const f32x4* xr = (const f32x4*)xrow + lane; const f32x4* gr = (const f32x4*)g + lane;
    f32x4 v[8]; float s = 0.f;
#pragma unroll
    for (int j = 0; j < 8; ++j) { v[j] = __builtin_nontemporal_load(xr + 64 * j); s += (v[j].x * v[j].x + v[j].y * v[j].y) + (v[j].z * v[j].z + v[j].w * v[j].w); }
    const float rstd = 1.f / sqrtf(wave_sum(s) * (1.f / DM) + NORM_EPS);
    v2u* o8 = (v2u*)orow + lane;
#pragma unroll
    for (int j = 0; j < 8; ++j) { const f32x4 gg = gr[64 * j]; v2u w; w.x = pk2(v[j].x * rstd * gg.x, v[j].y * rstd * gg.y); w.y = pk2(v[j].z * rstd * gg.z, v[j].w * rstd * gg.w); o8[64 * j] = w; }
}
__device__ __forceinline__ void p0_prologue(Frame& F, int part = 3) {
    LAS float* scr = (LAS float*)(F.lds + F.wave * 16640);
    const int gw = F.bid * NWAVES + F.wave, NGW = F.G * NWAVES;
    constexpr int I_IN = (DM / 64) * (NP / 64), I_MIX = (DM / 64) * (DM / 64), I_Q = (DM / 64) * (512 / 64), I_KV = (DM / 64) * (1024 / 64), I_O = (512 / 64) * (DM / 64),
                  I_UP = (DM / 64) * (DFF / 64), I_DN = (DFF / 64) * (DM / 64);
    constexpr int NITEMS = I_IN + I_MIX + I_Q + I_KV + I_O;
    if (part & 1)
    for (int it = gw; it < NITEMS; it += NGW) {
        int r = it;
        if (r < I_IN) { p0_transpose_item(F.w_in, DM, NIN, NP, F.WIN, scr, r, F.lane); continue; } r -= I_IN;
        if (r < I_MIX) { p0_transpose_item(F.w_mix, DM, DM, DM, F.WMIX, scr, r, F.lane); continue; } r -= I_MIX;
        if (r < I_Q) { p0_transpose_item(F.w_q, DM, 512, 512, F.WQ, scr, r, F.lane, F.norm_cross); continue; } r -= I_Q;
        if (r < I_KV) { p0_transpose_item(F.w_kv, DM, 1024, 1024, F.WKV, scr, r, F.lane); continue; } r -= I_KV;
        if (r < I_O) { p0_transpose_item(F.w_o, 512, DM, DM, F.WO, scr, r, F.lane); continue; } r -= I_O;
    }
    if (part & 1)
    for (int idx = F.bid * 512 + F.tid; idx < NL * (KL / 8); idx += F.G * 512) {
        const int n = idx % NL, k0 = (idx / NL) * 8, ty = n >> 10, c = n & 1023; float v[8];
#pragma unroll
        for (int i = 0; i < 8; ++i) { const int k = k0 + i; float x = 0.f;
            if (ty == 0) { if (k < 64) x = F.wd_up[(size_t)k * 1024 + c]; }
            else if (ty == 1) { if (k >= 64 && k < 128) x = F.a_up[(size_t)(k - 64) * 1024 + c]; }
            else { if (k >= 128 && k < 288) x = F.g_up[(size_t)(k - 128) * 1024 + c]; }
            v[i] = x; }
        v4u o; o.x = pk2(v[0], v[1]); o.y = pk2(v[2], v[3]); o.z = pk2(v[4], v[5]); o.w = pk2(v[6], v[7]);
        *(v4u*)(F.WL + (size_t)n * KL + k0) = o;
    }
    if (part & 2)
    for (int m = gw; m < T; m += NGW) rms_row_to_bf16(F.x + (size_t)m * DM, F.norm_mix, F.XN + (size_t)m * DM, F.lane);
    for (int m = gw; m < TM; m += NGW) rms_row_to_bf16(F.mem + (size_t)m * DM, F.norm_mem, F.MEMN + (size_t)m * DM, F.lane);
}
__device__ __forceinline__ void p7_mlp_weights(Frame& F, int blk0, int nblk) {
    const int me = F.bid - blk0; if (me < 0 || me >= nblk) return;
    LAS float* scr = (LAS float*)(F.lds + F.wave * 16640);
    constexpr int I_UP = (DM / 64) * (DFF / 64), I_DN = (DFF / 64) * (DM / 64);
    for (int it = me * NWAVES + F.wave; it < I_UP + I_DN; it += nblk * NWAVES) {
        if (it < I_UP) p0_transpose_item(F.w_up, DM, DFF, DFF, F.WUP, scr, it, F.lane, F.norm_mlp);
        else p0_transpose_item(F.w_dn, DFF, DM, DM, F.WDN, scr, it - I_UP, F.lane);
    }
}
__device__ __forceinline__ void norm_phase(Frame& F, const float* g) {
    const int gw = F.bid * NWAVES + F.wave, NGW = F.G * NWAVES;
    for (int m = gw; m < T; m += NGW) rms_row_to_bf16(F.out + (size_t)m * DM, g, F.XN + (size_t)m * DM, F.lane);
}
__device__ __forceinline__ void final_norm_phase(Frame& F) {
    const int gw = F.bid * NWAVES + F.wave, NGW = F.G * NWAVES;
    for (int m = gw; m < T; m += NGW) {
        const v4u* xr = (const v4u*)(F.XN + (size_t)m * DM) + F.lane; f32x4* orow = (f32x4*)(F.out + (size_t)m * DM); const f32x4* gr = (const f32x4*)F.norm_final;
        v4u w[4]; float s = 0.f;
#pragma unroll
        for (int j = 0; j < 4; ++j) { w[j] = __builtin_nontemporal_load(xr + 64 * j);
            const float a0 = bflo(w[j].x), a1 = bfhi(w[j].x), a2 = bflo(w[j].y), a3 = bfhi(w[j].y), a4 = bflo(w[j].z), a5 = bfhi(w[j].z), a6 = bflo(w[j].w), a7 = bfhi(w[j].w);
            s += (a0 * a0 + a1 * a1) + (a2 * a2 + a3 * a3) + (a4 * a4 + a5 * a5) + (a6 * a6 + a7 * a7); }
        const float rstd = 1.f / sqrtf(wave_sum(s) * (1.f / DM) + NORM_EPS);
#pragma unroll
        for (int j = 0; j < 4; ++j) { const int c4 = (64 * j + F.lane) * 2; const f32x4 g0 = gr[c4], g1 = gr[c4 + 1];
            __builtin_nontemporal_store((f32x4){bflo(w[j].x) * rstd * g0.x, bfhi(w[j].x) * rstd * g0.y, bflo(w[j].y) * rstd * g0.z, bfhi(w[j].y) * rstd * g0.w}, orow + c4);
            __builtin_nontemporal_store((f32x4){bflo(w[j].z) * rstd * g1.x, bfhi(w[j].z) * rstd * g1.y, bflo(w[j].w) * rstd * g1.z, bfhi(w[j].w) * rstd * g1.w}, orow + c4 + 1); }
    }
}

__device__ __forceinline__ void prep_phase(Frame& F) {
    const int gw = F.bid * NWAVES + F.wave, NGW = F.G * NWAVES, lane = F.lane;
    LAS float* cs0 = (LAS float*)(F.lds + F.wave * 512);
    int c1 = 0, c2 = 0, fi0 = 0;
    if (lane < 16) { c1 = C_Q + (lane >> 1) * 128 + (lane & 1) * 8; c2 = c1 + 16; fi0 = (lane & 1) * 8; }
    else if (lane < 20) { const int j = lane - 16; c1 = C_AK + (j >> 1) * 128 + (j & 1) * 8; c2 = c1 + 16; fi0 = (j & 1) * 8; }
    else if (lane < 36) { c1 = C_QI + (lane - 20) * 64; c2 = c1 + 8; fi0 = 16; }
    else { c1 = C_KI; c2 = c1 + 8; fi0 = 16; }
    const bool rope_l = lane < 37, lora_l = lane < 36, pad_l = lane < 48;
    const int j0 = lane * 8;
    f32x4 mu0 = {0.f, 0.f, 0.f, 0.f}, mu1 = mu0;
    if (lora_l) { mu0 = *(const f32x4*)(F.mu + C_XW + j0); mu1 = *(const f32x4*)(F.mu + C_XW + j0 + 4); }
    const float fe = (lane < 16) ? (float)lane * (1.f / 16.f) : (float)(lane - 16) * (1.f / 8.f);
    const float invf = exp2f(-fe * 18.931568569324174f);
    for (int mb = gw; mb < T; mb += 2 * NGW) {
        v4u x1[2], x2[2], cu[2], pv[2]; float posf[2]; bool val[2];
#pragma unroll
        for (int u = 0; u < 2; ++u) { const int mm = mb + u * NGW; val[u] = mm < T; const int ms = val[u] ? mm : mb; bf16* prow = F.P + (size_t)ms * NP;
            x1[u] = (v4u){0u, 0u, 0u, 0u}; x2[u] = x1[u]; cu[u] = x1[u]; pv[u] = x1[u];
            if (rope_l) { x1[u] = *(const v4u*)(prow + c1); x2[u] = *(const v4u*)(prow + c2); }
            if (lora_l) { cu[u] = *(const v4u*)(prow + C_XW + j0); if ((ms & (SEQ - 1)) > 0) pv[u] = *(const v4u*)(prow - NP + C_XW + j0); }
            posf[u] = (float)F.pos[ms]; }
#pragma unroll
        for (int u = 0; u < 2; ++u) if (lane < 24) {
            const float ang = posf[u] * invf; const float k = rintf(ang * 0.15915494309189535f);
            float r = fmaf(-k, 6.2831854820251465f, ang); r = fmaf(-k, -1.7484555e-7f, r);
            cs0[u * 64 + lane] = __cosf(r); cs0[u * 64 + 32 + lane] = __sinf(r); }
        LDS_WAIT(); asm volatile("" ::: "memory");
#pragma unroll
        for (int u = 0; u < 2; ++u) { const int mm = mb + u * NGW; if (!val[u]) continue; bf16* prow = F.P + (size_t)mm * NP;
            if (rope_l) { const LAS float* cs = cs0 + u * 64 + fi0;
                const f32x4 ca = *(const LAS f32x4*)(cs), cb = *(const LAS f32x4*)(cs + 4), sa = *(const LAS f32x4*)(cs + 32), sb = *(const LAS f32x4*)(cs + 36);
                const float co[8] = {ca.x, ca.y, ca.z, ca.w, cb.x, cb.y, cb.z, cb.w}, si[8] = {sa.x, sa.y, sa.z, sa.w, sb.x, sb.y, sb.z, sb.w};
                const unsigned a[4] = {x1[u].x, x1[u].y, x1[u].z, x1[u].w}, bq[4] = {x2[u].x, x2[u].y, x2[u].z, x2[u].w}; unsigned o1[4], o2[4];
#pragma unroll
                for (int e = 0; e < 4; ++e) { const float p0 = bflo(a[e]), p1 = bfhi(a[e]), q0 = bflo(bq[e]), q1 = bfhi(bq[e]);
                    o1[e] = pk2(p0 * co[2 * e] - q0 * si[2 * e], p1 * co[2 * e + 1] - q1 * si[2 * e + 1]);
                    o2[e] = pk2(q0 * co[2 * e] + p0 * si[2 * e], q1 * co[2 * e + 1] + p1 * si[2 * e + 1]); }
                *(v4u*)(prow + c1) = (v4u){o1[0], o1[1], o1[2], o1[3]}; *(v4u*)(prow + c2) = (v4u){o2[0], o2[1], o2[2], o2[3]}; }
            if (pad_l) { unsigned o[4] = {0u, 0u, 0u, 0u};
                if (lora_l) { const unsigned cw[4] = {cu[u].x, cu[u].y, cu[u].z, cu[u].w}, pw_[4] = {pv[u].x, pv[u].y, pv[u].z, pv[u].w};
                    const float mu8[8] = {mu0.x, mu0.y, mu0.z, mu0.w, mu1.x, mu1.y, mu1.z, mu1.w};
#pragma unroll
                    for (int e = 0; e < 4; ++e) { float v2[2];
#pragma unroll
                        for (int q = 0; q < 2; ++q) { const float xc = q ? bfhi(cw[e]) : bflo(cw[e]), xp = q ? bfhi(pw_[e]) : bflo(pw_[e]); const float xm = xc + (xp - xc) * mu8[2 * e + q];
                            float v = xm;
                            if (j0 < 64) v = 1.f - 2.f * __builtin_amdgcn_rcpf(1.f + __expf(2.f * xm));
                            else if (j0 >= 128) v = __builtin_amdgcn_rcpf(1.f + __expf(-xm));
                            v2[q] = v; }
                        o[e] = pk2(v2[0], v2[1]); } }
                *(v4u*)(F.AL + (size_t)mm * KL + j0) = (v4u){o[0], o[1], o[2], o[3]}; }
        }
        LDS_WAIT(); asm volatile("" ::: "memory");
    }
}

__device__ __forceinline__ void indexer_unit(Frame& F, int b, int qblk) {
    int t_ = F.wv * 64 + (int)__builtin_amdgcn_mbcnt_hi(~0u, __builtin_amdgcn_mbcnt_lo(~0u, 0u)); asm volatile("" : "+v"(t_));
    const int tid = t_, lane = tid & 63, wave = F.wv, col = lane & 31, hf = lane >> 5;
    const int q0 = qblk * 16, t0 = q0 + 2 * wave, my_t = t0 + hf;
    const bf16* Pb = F.P + (size_t)b * SEQ * NP;
    LAS unsigned char* L = F.lds;
    bf16x8 af[4];
    { const int rho = col, sel = (rho >> 2) & 1, head = (rho & 3) + 4 * (rho >> 3);
      const bf16* qrow = Pb + (size_t)(t0 + sel) * NP + C_QI + head * 64 + hf * 8;
#pragma unroll
      for (int s = 0; s < 4; ++s) af[s] = *(const bf16x8*)(qrow + 16 * s); }
    float wq[16];
    { const v4u* wr = (const v4u*)(Pb + (size_t)my_t * NP + C_WI); const v4u a = wr[0], c = wr[1];
      wq[0] = bflo(a.x); wq[1] = bfhi(a.x); wq[2] = bflo(a.y); wq[3] = bfhi(a.y); wq[4] = bflo(a.z); wq[5] = bfhi(a.z); wq[6] = bflo(a.w); wq[7] = bfhi(a.w);
      wq[8] = bflo(c.x); wq[9] = bfhi(c.x); wq[10] = bflo(c.y); wq[11] = bfhi(c.y); wq[12] = bflo(c.z); wq[13] = bfhi(c.z); wq[14] = bflo(c.w); wq[15] = bfhi(c.w); }
    const int nch = (q0 + 15) / 128 + 1;
    const int srow = tid >> 3, sc16 = tid & 7;
    const bf16* ksrc = Pb + (size_t)srow * NP + C_KI + sc16 * 8;
    v4u st0 = *(const v4u*)(ksrc), st1 = *(const v4u*)(ksrc + (size_t)64 * NP);
    *(LAS v4u*)(L + srow * 144 + sc16 * 16) = st0; *(LAS v4u*)(L + (srow + 64) * 144 + sc16 * 16) = st1;
    __syncthreads();
    unsigned key[64];
#pragma unroll
    for (int ch = 0; ch < 16; ++ch) {
        if (ch < nch) {
            const bool more = (ch + 1 < nch);
            if (more) { st0 = *(const v4u*)(ksrc + (size_t)(128 * (ch + 1)) * NP); st1 = *(const v4u*)(ksrc + (size_t)(128 * (ch + 1) + 64) * NP); }
            const LAS unsigned char* kb0 = L + (ch & 1) * 18432 + col * 144 + hf * 16;
#pragma unroll
            for (int sub = 0; sub < 4; ++sub) { const int kb = 4 * ch + sub;
                f32x16 c = {};
#pragma unroll
                for (int s = 0; s < 4; ++s) { const bf16x8 bfr = *(const LAS bf16x8*)(kb0 + sub * 32 * 144 + s * 32); c = __builtin_amdgcn_mfma_f32_32x32x16_bf16(af[s], bfr, c, 0, 0, 0); }
                float sc = 0.f;
#pragma unroll
                for (int r = 0; r < 16; ++r) sc = fmaf(fmaxf(c[r], 0.f), wq[r], sc);
                unsigned u = __float_as_uint(sc); u = (u & 0x80000000u) ? ~u : (u | 0x80000000u);
                key[kb] = (kb * 32 + col <= my_t) ? u : 0u; }
            if (more) { LAS unsigned char* dst = L + ((ch + 1) & 1) * 18432; *(LAS v4u*)(dst + srow * 144 + sc16 * 16) = st0; *(LAS v4u*)(dst + (srow + 64) * 144 + sc16 * 16) = st1; }
            __syncthreads();
        } else {
#pragma unroll
            for (int sub = 0; sub < 4; ++sub) key[4 * ch + sub] = 0u;
        }
    }
    bool done = (my_t + 1 <= 256);
    unsigned tau = done ? 1u : 0u;
    const int nch8 = (q0 + 15) / 256 + 1;
    for (int bit = 31; bit >= 0; --bit) {
        if (__all(done)) break;
        const unsigned cand = tau | (1u << bit);
        int cnt = 0;
#pragma unroll
        for (int g8 = 0; g8 < 8; ++g8) if (g8 < nch8) {
#pragma unroll
            for (int j = 0; j < 8; ++j) cnt += (key[8 * g8 + j] >= cand) ? 1 : 0; }
        cnt += __builtin_amdgcn_update_dpp(0, cnt, 0xB1, 0xF, 0xF, false); cnt += __builtin_amdgcn_update_dpp(0, cnt, 0x4E, 0xF, 0xF, false);
        cnt += __builtin_amdgcn_update_dpp(0, cnt, 0x141, 0xF, 0xF, false); cnt += __builtin_amdgcn_update_dpp(0, cnt, 0x140, 0xF, 0xF, false);
        { auto rr = __builtin_amdgcn_permlane16_swap((unsigned)cnt, (unsigned)cnt, false, false); cnt = (int)(rr[0] + rr[1]); }
        if (!done && cnt >= 256) { tau = cand; if (cnt == 256) done = true; }
    }
    unsigned* ma = F.MASK + (size_t)(b * SEQ + t0) * 64;
    unsigned wa = 0u, wb = 0u;
#pragma unroll
    for (int kb = 0; kb < 64; ++kb) {
        const unsigned long long bal = __ballot(key[kb] >= tau);
        asm volatile("s_nop 4\n\tv_writelane_b32 %0, %2, %4\n\tv_writelane_b32 %1, %3, %4" : "+v"(wa), "+v"(wb) : "s"((unsigned)bal), "s"((unsigned)(bal >> 32)), "i"(kb));
    }
    ma[lane] = wa; ma[64 + lane] = wb;
    __syncthreads();
}
__device__ __forceinline__ void indexer_phase(Frame& F) {
    for (int i = 0; i < (NB * (SEQ / 16) + F.G - 1) / F.G; ++i) {
        const int j = i * F.G + ((i & 1) ? (F.G - 1 - F.bid) : F.bid);
        if (j < NB * (SEQ / 16)) indexer_unit(F, j & 7, j >> 3);
    }
}

template <int CTRL> __device__ __forceinline__ float dppx(float v) { return __builtin_bit_cast(float, __builtin_amdgcn_update_dpp(0, __builtin_bit_cast(int, v), CTRL, 0xF, 0xF, false)); }
__device__ __forceinline__ float row16_sum(float v) {
    v += dppx<0xB1>(v); v += dppx<0x4E>(v); v += dppx<0x141>(v); v += dppx<0x140>(v); return v;
}
__device__ __forceinline__ void row16_sum2(float& a, float& b) {
    asm volatile("s_nop 1\n\t"
        "v_add_f32_dpp %0, %0, %0 quad_perm:[1,0,3,2] row_mask:0xf bank_mask:0xf\n\t"
        "v_add_f32_dpp %1, %1, %1 quad_perm:[1,0,3,2] row_mask:0xf bank_mask:0xf\n\t"
        "s_nop 0\n\t"
        "v_add_f32_dpp %0, %0, %0 quad_perm:[2,3,0,1] row_mask:0xf bank_mask:0xf\n\t"
        "v_add_f32_dpp %1, %1, %1 quad_perm:[2,3,0,1] row_mask:0xf bank_mask:0xf\n\t"
        "s_nop 0\n\t"
        "v_add_f32_dpp %0, %0, %0 row_half_mirror row_mask:0xf bank_mask:0xf\n\t"
        "v_add_f32_dpp %1, %1, %1 row_half_mirror row_mask:0xf bank_mask:0xf\n\t"
        "s_nop 0\n\t"
        "v_add_f32_dpp %0, %0, %0 row_mirror row_mask:0xf bank_mask:0xf\n\t"
        "v_add_f32_dpp %1, %1, %1 row_mirror row_mask:0xf bank_mask:0xf\n\t"
        "s_nop 1"
        : "+v"(a), "+v"(b));
}
__device__ __forceinline__ float wave_sum_d(float v) { v = row16_sum(v); v += __shfl_xor(v, 16); v += __shfl_xor(v, 32); return v; }
namespace rw {
typedef short bf16x8 __attribute__((ext_vector_type(8)));
typedef short s16x4 __attribute__((ext_vector_type(4)));
typedef float f32x16 __attribute__((ext_vector_type(16)));
constexpr int KAP = 0, RH = 13824, KBT = 27648, BBT = 43008, VT = 58368, KH = 78848, BH = 88064, MATS = 97280, YB = 122880, GC = 139264, WTOT = 140032, BON = 144128;
constexpr int I64 = 4608, I32 = 5120, M32 = 2560, MSET = 12800;
constexpr int AKK = 0, AKR = 2560, ABR = 5120, TT = 7680, SCR = 10240;
constexpr int S64 = 144, S32 = 80;
typedef float f32x2_t __attribute__((ext_vector_type(2))); typedef __bf16 bf16x2_t __attribute__((ext_vector_type(2)));
__device__ __forceinline__ unsigned cvtpk(float lo, float hi) { f32x2_t v = {lo, hi}; bf16x2_t b = __builtin_convertvector(v, bf16x2_t); return __builtin_bit_cast(unsigned, b); }
__device__ __forceinline__ unsigned short cvt1(float x) { return (unsigned short)cvtpk(x, 0.f); }
__device__ __forceinline__ bf16x8 frag_nat(const LAS unsigned char* base, int stride, int row, int kb, int h) { return *(const LAS bf16x8*)(base + row * stride + (kb + 8 * h) * 2); }
__device__ __forceinline__ bf16x8 frag_perm(const LAS unsigned char* base, int stride, int row, int kb, int h) {
    const s16x4 lo = *(const LAS s16x4*)(base + row * stride + (kb + 4 * h) * 2), hi = *(const LAS s16x4*)(base + row * stride + (kb + 8 + 4 * h) * 2);
    return (bf16x8){lo[0], lo[1], lo[2], lo[3], hi[0], hi[1], hi[2], hi[3]};
}
__device__ __forceinline__ bf16x8 acc_frag(const f32x16& x, int s) {
    typedef unsigned u32x4 __attribute__((ext_vector_type(4)));
    u32x4 w; w.x = cvtpk(x[8 * s + 0], x[8 * s + 1]); w.y = cvtpk(x[8 * s + 2], x[8 * s + 3]); w.z = cvtpk(x[8 * s + 4], x[8 * s + 5]); w.w = cvtpk(x[8 * s + 6], x[8 * s + 7]);
    return __builtin_bit_cast(bf16x8, w);
}
__device__ __forceinline__ int crow(int r, int hi) { return (r & 3) + 8 * (r >> 2) + 4 * hi; }
}

#ifndef PROBE_VAR
#define PROBE_VAR 0
#endif
__device__ __forceinline__ void wave_sum2(float& a, float& b) {
    row16_sum2(a, b);
    const float a1 = __shfl_xor(a, 16), b1 = __shfl_xor(b, 16); a += a1; b += b1;
    const float a2 = __shfl_xor(a, 32), b2 = __shfl_xor(b, 32); a += a2; b += b2;
}
template <int N> __device__ __forceinline__ void wave_sum_n(float (&v)[N]) {
#pragma unroll
    for (int i = 0; i < N; ++i) v[i] += dppx<0xB1>(v[i]);
#pragma unroll
    for (int i = 0; i < N; ++i) v[i] += dppx<0x4E>(v[i]);
#pragma unroll
    for (int i = 0; i < N; ++i) v[i] += dppx<0x141>(v[i]);
#pragma unroll
    for (int i = 0; i < N; ++i) v[i] += dppx<0x140>(v[i]);
#pragma unroll
    for (int i = 0; i < N; ++i) { auto rr = __builtin_amdgcn_permlane16_swap(__float_as_uint(v[i]), __float_as_uint(v[i]), false, false);
        v[i] = __uint_as_float(rr[0]) + __uint_as_float(rr[1]); }
#pragma unroll
    for (int i = 0; i < N; ++i) { auto rr = __builtin_amdgcn_permlane32_swap(__float_as_uint(v[i]), __float_as_uint(v[i]), false, false);
        v[i] = __uint_as_float(rr[0]) + __uint_as_float(rr[1]); }
}
__device__ __forceinline__ void rwkv_unit(Frame& F, int b, int h, const int pv = 0) {
    using namespace rw;
    int t_ = F.wv * 64 + (int)__builtin_amdgcn_mbcnt_hi(~0u, __builtin_amdgcn_mbcnt_lo(~0u, 0u)); asm volatile("" : "+v"(t_));
    const int lane = t_ & 63, wave = __builtin_amdgcn_readfirstlane(t_ >> 6), l31 = lane & 31, hi = lane >> 5;
    LAS unsigned char* L = F.lds;
    const int c = lane, col = h * 64 + c;
    const float mu_r = F.mu[C_R + col], mu_k = F.mu[C_K + col], mu_v = F.mu[C_V + col];
    const float kkc = F.k_k[col], kac = F.k_a[col], rkc = F.r_k[col], lw = F.lnx_w[col], lb = F.lnx_b[col];
    const size_t m0 = (size_t)b * SEQ;
    const int vh = wave & 1;
    constexpr int NCH = SEQ / 32;
    float st[40];
#pragma unroll
    for (int i = 0; i < 40; ++i) st[i] = 0.f;
#define rm(j) st[(j)]
#define kt(j) st[8 + (j)]
#define kk(j) st[16 + (j)]
#define bb(j) st[24 + (j)]
#define cs(j) st[32 + (j)]
    unsigned raw[8][5]; unsigned rawp[3]; unsigned gq[8];
#define RW_LOAD(ch) do { { const int tk0 = (ch) * 32 + 8 * wave; const bf16* pp = F.P + (m0 + tk0 - (tk0 > 0 ? 1 : 0)) * NP; rawp[0] = pp[C_R + col]; rawp[1] = pp[C_K + col]; rawp[2] = pp[C_V + col]; } \
        _Pragma("unroll") for (int j = 0; j < 8; ++j) { const size_t m = m0 + (ch) * 32 + 8 * wave + j; const bf16* pr = F.P + m * NP; const bf16* er = F.EWAG + m * NL; \
        raw[j][0] = __builtin_nontemporal_load(pr + C_R + col); raw[j][1] = __builtin_nontemporal_load(pr + C_K + col); raw[j][2] = __builtin_nontemporal_load(pr + C_V + col); \
        raw[j][3] = __builtin_nontemporal_load(er + col); raw[j][4] = __builtin_nontemporal_load(er + 1024 + col); } } while (0)
    if (pv & 128) return;
    if (wave < 4) RW_LOAD(0);
    for (int it = 0; it < NCH + 4; ++it) {
        if (wave < 4) {
            bf16x8 vv = {}; float bon8[8];
#pragma unroll
            for (int j = 0; j < 8; ++j) bon8[j] = 0.f;
            if (it >= 4) { const int ch = it - 4; vv = *(const LAS bf16x8*)(L + VT + (ch & 3) * I32 + c * S32 + 16 * wave);
#pragma unroll
                for (int j = 0; j < 8; ++j) bon8[j] = ((const LAS float*)(L + BON + (ch & 3) * 128))[8 * wave + j]; }
            if (it >= 1 && it <= NCH && !(pv & 32)) { const int ch = it - 1; const LAS float* wt = (const LAS float*)(L + WTOT + (ch & 1) * 2048);
                float off = 0.f, tot = 0.f;
#pragma unroll
                for (int w2 = 0; w2 < 4; ++w2) { const float x = wt[w2 * 64 + c]; tot += x; off += (w2 < wave) ? x : 0.f; }
                const float lgC = -tot;
                LAS unsigned char* pK = L + KAP + (ch % 3) * I64; LAS unsigned char* pR = L + RH + (ch % 3) * I64; LAS unsigned char* pKH = L + KH + (ch & 1) * I64; LAS unsigned char* pBH = L + BH + (ch & 1) * I64;
                LAS unsigned char* pKB = L + KBT + (ch % 3) * I32; LAS unsigned char* pBB = L + BBT + (ch % 3) * I32;
                const float eC = __expf(lgC); float egp = __expf(-off);
                unsigned kb4[4], bb4[4];
#pragma unroll
                for (int j = 0; j < 8; ++j) { const int i = 8 * wave + j;
                    const float e_g = __expf(-(off + cs(j))), e_m = __builtin_amdgcn_rcpf(e_g), e_c = eC * e_m;
                    *(LAS bf16*)(pK + i * S64 + 2 * c) = cvt1(kk(j) * egp); *(LAS bf16*)(pR + i * S64 + 2 * c) = cvt1(rm(j) * e_g);
                    *(LAS bf16*)(pKH + i * S64 + 2 * c) = cvt1(kt(j) * e_m); *(LAS bf16*)(pBH + i * S64 + 2 * c) = cvt1(bb(j) * e_m);
                    const float kbv = kt(j) * e_c, bbv = -bb(j) * e_c;
                    if (j & 1) { kb4[j >> 1] = cvtpk(__uint_as_float(kb4[j >> 1]), kbv); bb4[j >> 1] = cvtpk(__uint_as_float(bb4[j >> 1]), bbv); }
                    else { kb4[j >> 1] = __float_as_uint(kbv); bb4[j >> 1] = __float_as_uint(bbv); }
                    egp = e_g; }
                *(LAS v4u*)(pKB + c * S32 + 16 * wave) = (v4u){kb4[0], kb4[1], kb4[2], kb4[3]};
                *(LAS v4u*)(pBB + c * S32 + 16 * wave) = (v4u){bb4[0], bb4[1], bb4[2], bb4[3]};
                if (wave == 0) ((LAS float*)(L + GC + (ch % 3) * 256))[c] = eC;
            }
            if (it < NCH && !(pv & 64)) { const int ch = it;
                float kkr8[8], a8[8], red[16]; unsigned vt4[4];
#pragma unroll
                for (int j = 0; j < 8; ++j) { const int tk = ch * 32 + 8 * wave + j; const bool hp = tk > 0;
                    const float r0 = bf2f((unsigned short)raw[j][0]), k0 = bf2f((unsigned short)raw[j][1]), v0 = bf2f((unsigned short)raw[j][2]);
                    const float r1 = !hp ? 0.f : bf2f((unsigned short)(j ? raw[j ? j - 1 : 0][0] : rawp[0])), k1 = !hp ? 0.f : bf2f((unsigned short)(j ? raw[j ? j - 1 : 0][1] : rawp[1])),
                                v1 = !hp ? 0.f : bf2f((unsigned short)(j ? raw[j ? j - 1 : 0][2] : rawp[2]));
                    rm(j) = r0 + (r1 - r0) * mu_r; const float km = k0 + (k1 - k0) * mu_k; const float vmj = v0 + (v1 - v0) * mu_v;
                    if (j & 1) vt4[j >> 1] = cvtpk(__uint_as_float(vt4[j >> 1]), vmj); else vt4[j >> 1] = __float_as_uint(vmj);
                    const float ew = bf2f((unsigned short)raw[j][3]); a8[j] = bf2f((unsigned short)raw[j][4]);
                    kkr8[j] = km * kkc; kt(j) = km * (1.f + (a8[j] - 1.f) * kac);
                    red[j] = kkr8[j] * kkr8[j]; red[8 + j] = rm(j) * kt(j) * rkc;
                    cs(j) = (j ? cs(j ? j - 1 : 0) : 0.f) + ew; }
                *(LAS v4u*)(L + VT + (ch & 3) * I32 + c * S32 + 16 * wave) = (v4u){vt4[0], vt4[1], vt4[2], vt4[3]};
                wave_sum_n<16>(red);
#pragma unroll
                for (int j = 0; j < 8; ++j) { kk(j) = kkr8[j] * __builtin_amdgcn_rsqf(fmaxf(red[j], 1e-24f)); bb(j) = kk(j) * a8[j]; }
                if (lane < 8) { float bo = red[8];
#pragma unroll
                    for (int j = 1; j < 8; ++j) bo = (lane == j) ? red[8 + j] : bo;
                    ((LAS float*)(L + BON + (ch & 3) * 128))[8 * wave + lane] = bo; }
                ((LAS float*)(L + WTOT + (ch & 1) * 2048))[wave * 64 + c] = cs(7);
            }
            if (!(pv & 2) && it + 1 < NCH) RW_LOAD(it + 1);
            if (it >= 4 && !(pv & 4)) { const int ch = it - 4;
                const LAS float* yb = (const LAS float*)(L + YB + (ch & 1) * 8192);
                float y8[8], sm[16];
#pragma unroll
                for (int j = 0; j < 8; ++j) { y8[j] = yb[(8 * wave + j) * 64 + c]; sm[j] = y8[j]; sm[8 + j] = y8[j] * y8[j]; }
                wave_sum_n<16>(sm);
#pragma unroll
                for (int j = 0; j < 8; ++j) { const int i = 8 * wave + j;
                    const float mean = sm[j] * (1.f / 64.f), var = fmaxf(sm[8 + j] * (1.f / 64.f) - mean * mean, 0.f);
                    const float yn = (y8[j] - mean) * __builtin_amdgcn_rsqf(var + RWKV_LN_EPS) * lw + lb;
                    const float o = (yn + bon8[j] * bf2f((unsigned short)vv[j])) * bf2f((unsigned short)gq[j]);
                    F.Y[(m0 + ch * 32 + i) * DM + col] = cvt1(o); }
            }
            if (!(pv & 2) && it + 1 >= 4 && it + 1 < NCH + 4) {
#pragma unroll
                for (int j = 0; j < 8; ++j) gq[j] = __builtin_nontemporal_load(F.EWAG + (m0 + (it - 3) * 32 + 8 * wave + j) * NL + 2048 + col); }
        } else if (wave < 6) {
            if (it >= 3 && it < NCH + 3 && !(pv & 8)) { const int ch = it - 3;
                const LAS unsigned char* pK = L + KAP + (ch % 3) * I64; const LAS unsigned char* pR = L + RH + (ch % 3) * I64; const LAS unsigned char* pKB = L + KBT + (ch % 3) * I32;
                const LAS unsigned char* pBB = L + BBT + (ch % 3) * I32; const LAS unsigned char* pV = L + VT + (ch & 3) * I32; const LAS unsigned char* pM = L + MATS + (ch & 1) * MSET;
                f32x16 X0, X1;
#pragma unroll
                for (int r = 0; r < 16; ++r) { X0[r] = st[r]; X1[r] = st[16 + r]; }
                f32x16 RHS = {}, YT = {}; bf16x8 xb[4];
                xb[0] = acc_frag(X0, 0); xb[1] = acc_frag(X0, 1); xb[2] = acc_frag(X1, 0); xb[3] = acc_frag(X1, 1);
#pragma unroll
                for (int q = 0; q < 4; ++q) { RHS = __builtin_amdgcn_mfma_f32_32x32x16_bf16(frag_perm(pK, S64, l31, 16 * q, hi), xb[q], RHS, 0, 0, 0);
                                              YT = __builtin_amdgcn_mfma_f32_32x32x16_bf16(frag_perm(pR, S64, l31, 16 * q, hi), xb[q], YT, 0, 0, 0); }
                const bf16x8 vf0 = frag_nat(pV, S32, 32 * vh + l31, 0, hi), vf1 = frag_nat(pV, S32, 32 * vh + l31, 16, hi);
                RHS = __builtin_amdgcn_mfma_f32_32x32x16_bf16(frag_nat(pM + AKK, S32, l31, 0, hi), vf0, RHS, 0, 0, 0);
                RHS = __builtin_amdgcn_mfma_f32_32x32x16_bf16(frag_nat(pM + AKK, S32, l31, 16, hi), vf1, RHS, 0, 0, 0);
                YT = __builtin_amdgcn_mfma_f32_32x32x16_bf16(frag_nat(pM + AKR, S32, l31, 0, hi), vf0, YT, 0, 0, 0);
                YT = __builtin_amdgcn_mfma_f32_32x32x16_bf16(frag_nat(pM + AKR, S32, l31, 16, hi), vf1, YT, 0, 0, 0);
                f32x16 U = {};
                { const bf16x8 r0 = acc_frag(RHS, 0), r1 = acc_frag(RHS, 1);
                  U = __builtin_amdgcn_mfma_f32_32x32x16_bf16(frag_perm(pM + TT, S32, l31, 0, hi), r0, U, 0, 0, 0);
                  U = __builtin_amdgcn_mfma_f32_32x32x16_bf16(frag_perm(pM + TT, S32, l31, 16, hi), r1, U, 0, 0, 0); }
                const bf16x8 u0 = acc_frag(U, 0), u1 = acc_frag(U, 1);
                YT = __builtin_amdgcn_mfma_f32_32x32x16_bf16(frag_perm(pM + ABR, S32, l31, 0, hi), u0, YT, 0, 0, 0);
                YT = __builtin_amdgcn_mfma_f32_32x32x16_bf16(frag_perm(pM + ABR, S32, l31, 16, hi), u1, YT, 0, 0, 0);
                LAS float* yb = (LAS float*)(L + YB + (ch & 1) * 8192);
#pragma unroll
                for (int r = 0; r < 16; ++r) yb[crow(r, hi) * 64 + 32 * vh + l31] = YT[r];
                const LAS float* gc = (const LAS float*)(L + GC + (ch % 3) * 256);
#pragma unroll
                for (int r = 0; r < 16; ++r) { X0[r] *= gc[crow(r, hi)]; X1[r] *= gc[32 + crow(r, hi)]; }
                X0 = __builtin_amdgcn_mfma_f32_32x32x16_bf16(frag_nat(pKB, S32, l31, 0, hi), vf0, X0, 0, 0, 0);
                X1 = __builtin_amdgcn_mfma_f32_32x32x16_bf16(frag_nat(pKB, S32, 32 + l31, 0, hi), vf0, X1, 0, 0, 0);
                X0 = __builtin_amdgcn_mfma_f32_32x32x16_bf16(frag_nat(pKB, S32, l31, 16, hi), vf1, X0, 0, 0, 0);
                X1 = __builtin_amdgcn_mfma_f32_32x32x16_bf16(frag_nat(pKB, S32, 32 + l31, 16, hi), vf1, X1, 0, 0, 0);
                X0 = __builtin_amdgcn_mfma_f32_32x32x16_bf16(frag_perm(pBB, S32, l31, 0, hi), u0, X0, 0, 0, 0);
                X1 = __builtin_amdgcn_mfma_f32_32x32x16_bf16(frag_perm(pBB, S32, 32 + l31, 0, hi), u0, X1, 0, 0, 0);
                X0 = __builtin_amdgcn_mfma_f32_32x32x16_bf16(frag_perm(pBB, S32, l31, 16, hi), u1, X0, 0, 0, 0);
                X1 = __builtin_amdgcn_mfma_f32_32x32x16_bf16(frag_perm(pBB, S32, 32 + l31, 16, hi), u1, X1, 0, 0, 0);
#pragma unroll
                for (int r = 0; r < 16; ++r) { st[r] = X0[r]; st[16 + r] = X1[r]; }
            }
        } else {
            if (it >= 2 && it < NCH + 2 && !(pv & 16)) { const int ch = it - 2;
                const LAS unsigned char* pK = L + KAP + (ch % 3) * I64; const LAS unsigned char* pR = L + RH + (ch % 3) * I64; const LAS unsigned char* pKH = L + KH + (ch & 1) * I64; const LAS unsigned char* pBH = L + BH + (ch & 1) * I64;
                LAS unsigned char* pM = L + MATS + (ch & 1) * MSET;
                if (wave == 6) {
#pragma unroll
                    for (int w3 = 0; w3 < 3; ++w3) { const LAS unsigned char* Aimg = (w3 == 0) ? pK : pR; const LAS unsigned char* Bimg = (w3 == 2) ? pBH : pKH;
                        f32x16 d = {};
#pragma unroll
                        for (int q = 0; q < 4; ++q) d = __builtin_amdgcn_mfma_f32_32x32x16_bf16(frag_nat(Aimg, S64, l31, 16 * q, hi), frag_nat(Bimg, S64, l31, 16 * q, hi), d, 0, 0, 0);
                        const int dst = (w3 == 0) ? AKK : (w3 == 1) ? AKR : ABR; const float sg = (w3 == 2) ? -1.f : 1.f;
#pragma unroll
                        for (int r = 0; r < 16; ++r) { const int t = crow(r, hi); const bool keep = (w3 == 0) ? (l31 < t) : (l31 <= t);
                            *(LAS bf16*)(pM + dst + t * S32 + 2 * l31) = cvt1(keep ? sg * d[r] : 0.f); } }
                } else {
                    f32x16 pw = {}, pT = {};
#pragma unroll
                    for (int q = 0; q < 4; ++q) { const bf16x8 fk = frag_nat(pK, S64, l31, 16 * q, hi), fb = frag_nat(pBH, S64, l31, 16 * q, hi);
                        pw = __builtin_amdgcn_mfma_f32_32x32x16_bf16(fk, fb, pw, 0, 0, 0);
                        pT = __builtin_amdgcn_mfma_f32_32x32x16_bf16(fb, fk, pT, 0, 0, 0); }
#pragma unroll
                    for (int r = 0; r < 16; ++r) { pw[r] = (l31 < crow(r, hi)) ? pw[r] : 0.f; pT[r] = (crow(r, hi) < l31) ? pT[r] : 0.f; }
                    f32x16 P;
#pragma unroll
                    for (int r = 0; r < 16; ++r) P[r] = ((crow(r, hi) == l31) ? 1.f : 0.f) - pw[r];
                    if (!(pv & 1))
#pragma unroll
                    for (int k2 = 0; k2 < 5; ++k2) {
                        const bf16x8 t0 = acc_frag(pT, 0), t1 = acc_frag(pT, 1);
                        if (k2 > 0) { const bf16x8 p0 = acc_frag(P, 0), p1 = acc_frag(P, 1);
                            P = __builtin_amdgcn_mfma_f32_32x32x16_bf16(t0, p0, P, 0, 0, 0); P = __builtin_amdgcn_mfma_f32_32x32x16_bf16(t1, p1, P, 0, 0, 0); }
                        if (k2 < 4) { const bf16x8 w0 = acc_frag(pw, 0), w1 = acc_frag(pw, 1); f32x16 nw = {}, nT = {};
                            nw = __builtin_amdgcn_mfma_f32_32x32x16_bf16(t0, w0, nw, 0, 0, 0); nw = __builtin_amdgcn_mfma_f32_32x32x16_bf16(t1, w1, nw, 0, 0, 0);
                            nT = __builtin_amdgcn_mfma_f32_32x32x16_bf16(w0, t0, nT, 0, 0, 0); nT = __builtin_amdgcn_mfma_f32_32x32x16_bf16(w1, t1, nT, 0, 0, 0);
                            pw = nw; pT = nT; }
                    }
#pragma unroll
                    for (int r = 0; r < 16; ++r) *(LAS bf16*)(pM + TT + crow(r, hi) * S32 + 2 * l31) = cvt1(P[r]);
                }
            }
        }
        __syncthreads();
    }
#undef RW_LOAD
#undef rm
#undef kt
#undef kk
#undef bb
#undef cs
}
__device__ __forceinline__ void mix_phase(Frame& F, int qword = CW_QUEUE, int only = 0) {
    LAS int* slot = (LAS int*)(F.lds + LDS_BYTES - 64);
    for (;;) {
        __syncthreads();
        if (F.tid == 0) slot[0] = (int)__hip_atomic_fetch_add(F.ctl + qword, 1u, RLX_AGENT);
        __syncthreads();
        const int it = slot[0];
        if (it >= 128 + 512) break;
        if (it < 128 && only == 2) continue;
        if (it >= 128 && only == 1) break;
        if (it < 128) {
#ifndef SKIP_RWKV
            rwkv_unit(F, it >> 4, it & 15, only ? (PROBE_VAR) : 0);
#endif
        }
        else {
            const int u = it - 128;
            const int qb = 7 - (u >> 6), bh = u & 63, b = bh >> 3, h = bh & 7, g = h >> 2;
            const size_t m0 = (size_t)b * SEQ, q0 = (size_t)qb * 256;
#ifndef SKIP_ATT
            att::attn_body<NP, NP, DM, true, ATT_SD>(F.P + (m0 + q0) * NP + C_Q + h * 128, F.P + m0 * NP + C_AK + g * 128, F.P + m0 * NP + C_AV + g * 128,
                                             F.Y + (m0 + q0) * DM + 1024 + h * 128, F.MASK + (m0 + q0) * 64, (int)q0 + 256, (char*)F.lds, F.wv);
#endif
        }
    }
}
__device__ __forceinline__ void cross_phase(Frame& F) {
    for (int u = F.bid; u < NB * 4 * 8; u += F.G) {
        const int b = u >> 5, h = (u >> 3) & 3, qb = u & 7;
        const size_t m0 = (size_t)b * SEQ + (size_t)qb * 256, k0 = (size_t)b * NMEM;
        att::attn_body<512, 1024, 512, false, 2>(F.QC + m0 * 512 + h * 128, F.MEMKV + k0 * 1024 + h * 128, F.MEMKV + k0 * 1024 + 512 + h * 128,
                                              F.OC + m0 * 512 + h * 128, nullptr, NMEM, (char*)F.lds, F.wv);
    }
}

#define XB_TMO      128
#define XB_XCNT(j)  (256  + 64 * (j))
#define XB_XSUB(j)  (1280 + 64 * (j))
#define XB_XGEN(j)  (2304 + 64 * (j))
#define XB_TOP      3328
#define XB_TOPGEN   3392
#define XCD_BAR_WORDS 3456
#define XB_SPIN_CAP (1u << 18)

__device__ __forceinline__ unsigned xb_ld(unsigned* p)              { return __hip_atomic_load(p, __ATOMIC_RELAXED, __HIP_MEMORY_SCOPE_AGENT); }
__device__ __forceinline__ unsigned xb_add(unsigned* p, unsigned v) { return __hip_atomic_fetch_add(p, v, __ATOMIC_RELAXED, __HIP_MEMORY_SCOPE_AGENT); }
__device__ __forceinline__ unsigned xb_xcc_id() { return (unsigned)__builtin_amdgcn_s_getreg((3 << 11) | 20) & 0xFu; }
#define XB_SPIN(cond, bar) do { unsigned _sp = 0; while (cond) { __builtin_amdgcn_s_sleep(1); \
    if ((++_sp & 255u) == 0u) { if (xb_ld(&(bar)[XB_TMO])) break; if (_sp > XB_SPIN_CAP) { atomicAdd(&(bar)[XB_TMO], 1u); break; } } } } while (0)

struct XcdBarrier {
    unsigned* bar; unsigned x;
    volatile LAS unsigned* st;
};

__device__ __forceinline__ XcdBarrier xcd_barrier_post(unsigned* bar, volatile LAS unsigned* st, const bool leader) {
    XcdBarrier b; b.bar = bar; b.x = xb_xcc_id(); b.st = st;
    if (leader) (void)xb_add(&bar[XB_XCNT(b.x)], 1u);
    return b;
}
__device__ __forceinline__ void xcd_barrier_complete(unsigned* bar, unsigned x, unsigned& nloc, unsigned& nx) {
    const unsigned G = gridDim.x * gridDim.y * gridDim.z;
    unsigned sum, cnt, mine, sp = 0u;
    for (;;) {
        sum = 0u; cnt = 0u; mine = 0u;
#pragma unroll
        for (unsigned j = 0; j < 16; ++j) { const unsigned c = xb_ld(&bar[XB_XCNT(j)]); sum += c; cnt += (c > 0u) ? 1u : 0u; mine = (j == x) ? c : mine; }
        if (sum == G) break;
        __builtin_amdgcn_s_sleep(1);
        if ((++sp & 255u) == 0u) { if (xb_ld(&bar[XB_TMO])) break; if (sp > XB_SPIN_CAP) { atomicAdd(&bar[XB_TMO], 1u); break; } }
    }
    nloc = mine > 0u ? mine : 1u; nx = cnt > 0u ? cnt : 1u;
}

__device__ __forceinline__ void xcd_barrier(const XcdBarrier& b, const bool leader) {
    asm volatile("s_waitcnt vmcnt(0)" ::: "memory");
    __syncthreads();
    if (leader) {
        unsigned* bar = b.bar;
        __builtin_amdgcn_s_waitcnt(0);
        unsigned nloc = b.st[0], nx = b.st[1];
        if (nloc == 0u) { xcd_barrier_complete(bar, b.x, nloc, nx); b.st[0] = nloc; b.st[1] = nx; }
        const unsigned old = xb_add(&bar[XB_XSUB(b.x)], 1u);
        const unsigned gen = old / nloc;
        if (old + 1u == (gen + 1u) * nloc) {
            __builtin_amdgcn_fence(__ATOMIC_RELEASE, "agent");
            asm volatile("s_waitcnt vmcnt(0)" ::: "memory");
            const unsigned og = xb_add(&bar[XB_TOP], 1u);
            const unsigned tg = og / nx;
            if (og + 1u == (tg + 1u) * nx) xb_add(&bar[XB_TOPGEN], 1u);
            else XB_SPIN(xb_ld(&bar[XB_TOPGEN]) == tg, bar);
            __builtin_amdgcn_fence(__ATOMIC_ACQUIRE, "agent");
            xb_add(&bar[XB_XGEN(b.x)], 1u);
            asm volatile("s_waitcnt vmcnt(0)" ::: "memory");
        } else {
            XB_SPIN(xb_ld(&bar[XB_XGEN(b.x)]) == gen, bar);
            __builtin_amdgcn_fence(__ATOMIC_ACQUIRE, "agent");
            asm volatile("s_waitcnt vmcnt(0)" ::: "memory");
        }
    }
    __syncthreads();
}

template <typename Tp> __device__ __forceinline__ Tp* inp_ptr(int i) {
    asm volatile("" : "+s"(i));
    typedef __attribute__((address_space(1))) Tp* gptr_t;
    Tp* p = (Tp*)(gptr_t)(((const __attribute__((address_space(4))) unsigned long long*)__builtin_amdgcn_kernarg_segment_ptr())[i]);
    return p;
}
constexpr int N_PHASES = 14;
__global__ void __launch_bounds__(NWAVES * 64, 2) mk_fwd(Args args) {
    extern __shared__ __attribute__((aligned(16))) unsigned char lds[];
    Frame F;
    F.lds = (LAS unsigned char*)lds;
    F.wv = __builtin_amdgcn_readfirstlane((int)threadIdx.x >> 6);
    F.lane = (int)__builtin_amdgcn_mbcnt_hi(~0u, __builtin_amdgcn_mbcnt_lo(~0u, 0u)); F.tid = F.wv * 64 + F.lane; F.wave = F.wv;
    F.G = gridDim.x; F.bid = blockIdx.x;
#define INP(i) inp_ptr<const float>(i)
#define WSP(off) ((bf16*)(inp_ptr<unsigned char>(27) + (off)))
    F.out = inp_ptr<float>(26); F.ctl = (unsigned*)inp_ptr<unsigned char>(27);
    for (int u = F.tid; u < 32; u += NWAVES * 64) ((LAS unsigned*)(F.lds + MISC_OFF))[u] = 0u;
    __syncthreads();
    XcdBarrier bar = xcd_barrier_post(F.ctl + CW_BAR, (volatile LAS unsigned*)(F.lds + MISC_OFF) + 8, F.tid == 0);
    const int lo = args.ph_lo, hi = args.ph_hi;
#ifndef PHMASK
#define PHMASK 0xFFFF
#endif
#define IN(k) ((((PHMASK) >> (k)) & 1) && lo <= (k) && (k) < hi)
#define SEAM(k) do { if (IN(k) && IN((k) + 1)) xcd_barrier(bar, F.wv == 0 && (int)__builtin_amdgcn_mbcnt_hi(~0u, __builtin_amdgcn_mbcnt_lo(~0u, 0u)) == 0); { int t_ = F.wv * 64 + (int)__builtin_amdgcn_mbcnt_hi(~0u, __builtin_amdgcn_mbcnt_lo(~0u, 0u)); asm volatile("" : "+v"(t_)); F.tid = t_; F.lane = t_ & 63; F.wave = F.wv; } } while (0)
#define PRB(k) ((PROBE_PH) == (k) || ((k) == 11 && (PROBE_PH) == 110) || ((k) == 4 && ((PROBE_PH) == 40 || (PROBE_PH) == 41)) || ((k) == 0 && ((PROBE_PH) == 100 || (PROBE_PH) == 101)))
#define REP(k) for (int rep_ = 0; rep_ < (PRB(k) ? 2 : 1); ++rep_, (PRB(k) && rep_ < 2) ? xcd_barrier(bar, F.wv == 0 && (int)__builtin_amdgcn_mbcnt_hi(~0u, __builtin_amdgcn_mbcnt_lo(~0u, 0u)) == 0) : (void)0)
    using pg8::Gemm; using pg8::StaticOrder;
    REP(0) if (IN(0)) {
        F.x = INP(0); F.mem = INP(1); F.norm_mix = INP(3); F.w_in = INP(4); F.wd_up = INP(7); F.a_up = INP(9); F.g_up = INP(10); F.w_mix = INP(16); F.norm_mem = INP(18);
        F.norm_cross = INP(17); F.norm_mlp = INP(22); F.w_q = INP(19); F.w_kv = INP(20); F.w_o = INP(21); F.w_up = INP(23); F.w_dn = INP(24);
        F.WIN = WSP(WS_WIN); F.WMIX = WSP(WS_WMIX); F.WQ = WSP(WS_WQ); F.WKV = WSP(WS_WKV); F.WO = WSP(WS_WO); F.WUP = WSP(WS_WUP); F.WDN = WSP(WS_WDN); F.WL = WSP(WS_WL);
        F.XN = WSP(WS_XN); F.MEMN = WSP(WS_MEMN);
        p0_prologue(F, rep_ ? (PROBE_PH) - 99 : 3); } SEAM(0);
    REP(1) if (IN(1)) {
        F.XN = WSP(WS_XN); F.WIN = WSP(WS_WIN); F.P = WSP(WS_P); F.MEMN = WSP(WS_MEMN); F.WKV = WSP(WS_WKV); F.MEMKV = WSP(WS_MEMKV);
        { Gemm g{F.XN, F.WIN, T, NP, DM}; StaticOrder S; S.init(T, NP, F.G, F.bid, WGM_P1); pg8::EpiB16<0> E{F.P, NP, nullptr, 0.f, 0.f};
          pg8::gemm_phase<pg8::EpiB16<0>, StaticOrder, true, true>(F.lds, g, S, E, F.wv); }
    } SEAM(1);
    if (IN(2)) { F.P = WSP(WS_P); F.AL = WSP(WS_AL); F.pos = (const int*)INP(2); F.mu = INP(5); prep_phase(F); } SEAM(2);
    REP(3) if (IN(3)) {
        F.AL = WSP(WS_AL); F.WL = WSP(WS_WL); F.EWAG = (bf16*)F.out; F.w0 = INP(6); F.a0 = INP(8); F.P = WSP(WS_P); F.MASK = (unsigned*)WSP(WS_MASK);
#ifndef SKIP_LORA
        { int kl = 256; asm volatile("" : "+s"(kl)); Gemm g{F.AL, F.WL, T, NL, kl, KL, 8, 256}; StaticOrder S; S.init(T, NL, F.G, F.bid); pg8::EpiLora E{F.EWAG, NL, F.w0, F.a0};
          pg8::gemm_phase<pg8::EpiLora, StaticOrder, true, true>(F.lds, g, S, E, F.wv); }
#endif
#ifndef SKIP_IDX
#if PROBE_PH == 30
        { int nrep = 2; asm volatile("" : "+s"(nrep)); for (int rp = 0; rp < nrep; ++rp) indexer_phase(F); }
#else
        indexer_phase(F);
#endif
#endif
    } SEAM(3);
    REP(4) if (IN(4)) { F.P = WSP(WS_P); F.EWAG = (bf16*)F.out; F.MASK = (unsigned*)WSP(WS_MASK); F.Y = WSP(WS_Y); F.mu = INP(5); F.k_k = INP(11); F.k_a = INP(12); F.r_k = INP(13);
        F.lnx_w = INP(14); F.lnx_b = INP(15); if (rep_) F.Y = WSP(WS_XN);
        mix_phase(F, CW_QUEUE + 64 * rep_, rep_ ? (PROBE_PH) - 39 : 0); } SEAM(4);
    if (IN(5)) { F.Y = WSP(WS_Y); F.WMIX = WSP(WS_WMIX); F.x = INP(0); F.XN = WSP(WS_XN); Gemm g{F.Y, F.WMIX, T, DM, DM}; StaticOrder S; S.init(T, DM, F.G, F.bid, WGM_P5); pg8::EpiResB<false, false> E{F.x, F.XN, DM, nullptr, (float*)(F.ctl + CW_SS1), 0.f, 0.f};
        pg8::gemm_phase<pg8::EpiResB<false, false>, StaticOrder, true, true>(F.lds, g, S, E, F.wv); } SEAM(5);
    if (IN(7)) { F.XN = WSP(WS_XN); F.WQ = WSP(WS_WQ); F.QC = WSP(WS_QC); Gemm g{F.XN, F.WQ, T, 512, DM}; StaticOrder S; S.init(T, 512, F.G, F.bid); pg8::EpiB16<0, true> E{F.QC, 512, (const float*)(F.ctl + CW_SS1), 1.f / DM, NORM_EPS};
        pg8::gemm_phase<pg8::EpiB16<0, true>, StaticOrder, true, true>(F.lds, g, S, E, F.wv);
        F.MEMN = WSP(WS_MEMN); F.WKV = WSP(WS_WKV); F.MEMKV = WSP(WS_MEMKV);
        { Gemm g{F.MEMN, F.WKV, TM, 1024, DM}; StaticOrder S; S.init(TM, 1024, F.G, (F.bid + F.G / 2) % F.G); pg8::EpiB16<0> E{F.MEMKV, 1024, nullptr, 0.f, 0.f};
          pg8::gemm_phase<pg8::EpiB16<0>, StaticOrder, true, true>(F.lds, g, S, E, F.wv); }
        F.w_up = INP(23); F.w_dn = INP(24); F.norm_mlp = INP(22); F.WUP = WSP(WS_WUP); F.WDN = WSP(WS_WDN);
        p7_mlp_weights(F, 160, F.G - 160);
    } SEAM(7);
    if (IN(8)) { F.QC = WSP(WS_QC); F.MEMKV = WSP(WS_MEMKV); F.OC = WSP(WS_OC); cross_phase(F); } SEAM(8);
    if (IN(9)) { F.OC = WSP(WS_OC); F.WO = WSP(WS_WO); int kl = 512; asm volatile("" : "+s"(kl)); F.XN = WSP(WS_XN); Gemm g{F.OC, F.WO, T, DM, kl}; StaticOrder S; S.init(T, DM, F.G, F.bid); pg8::EpiResB<true, false> E{nullptr, F.XN, DM, nullptr, (float*)(F.ctl + CW_SS2), 0.f, 0.f};
        pg8::gemm_phase<pg8::EpiResB<true, false>, StaticOrder, true, true>(F.lds, g, S, E, F.wv); } SEAM(9);
    REP(11) if (IN(11)) { F.XN = WSP(WS_XN); F.WUP = WSP(WS_WUP); F.ACT = WSP(WS_ACT); Gemm g{F.XN, F.WUP, T, DFF, DM}; StaticOrder S; S.init(T, DFF, F.G, F.bid, WGM_P11); pg8::EpiB16<2, false, true> E{F.ACT, DFF, nullptr, 0.f, 0.f};
        #if PROBE_PH == 110
        if (rep_) { pg8::EpiNull EN{}; pg8::gemm_phase<pg8::EpiNull, StaticOrder, true, true>(F.lds, g, S, EN, F.wv); } else
#endif
        pg8::gemm_phase<pg8::EpiB16<2, false, true>, StaticOrder, true, true>(F.lds, g, S, E, F.wv); } SEAM(11);
    if (IN(12)) { F.ACT = WSP(WS_ACT); F.WDN = WSP(WS_WDN); F.XN = WSP(WS_XN); F.norm_final = INP(25);
        Gemm g{F.ACT, F.WDN, T, DM, DFF}; pg8::PanelOrder S{F.bid};
        pg8::EpiFinal E{F.XN, DM, (const float*)(F.ctl + CW_SS2), (float*)(F.ctl + CW_SS3), F.ctl + CW_PCNT, F.norm_final, F.out, 1.f / DM, NORM_EPS, F.ctl + CW_TMO};
        pg8::gemm_phase<pg8::EpiFinal, pg8::PanelOrder, true, true>(F.lds, g, S, E, F.wv); }
#undef IN
#undef SEAM
}

extern "C" void kernel_launch(void* const* d_in, const int* in_sizes, int n_in, void* d_out, int out_size, void* d_ws, size_t ws_size, hipStream_t stream) {
    static int grid = 0;
    if (grid == 0) {
        if (n_in != 26 || in_sizes[0] != T * DM || out_size != T * DM || ws_size < WS_END) {
            fprintf(stderr, "kernel_launch: unexpected shapes: n_in %d in0 %d out %d ws %zu (need %zu)\n", n_in, n_in > 0 ? in_sizes[0] : -1, out_size, ws_size, (size_t)WS_END); grid = -1; return; }
        int dev = 0, cus = 0, per_cu = 0;
        if (hipGetDevice(&dev) != hipSuccess || hipDeviceGetAttribute(&cus, hipDeviceAttributeMultiprocessorCount, dev) != hipSuccess) { grid = -1; return; }
        if (hipFuncSetAttribute((const void*)mk_fwd, hipFuncAttributeMaxDynamicSharedMemorySize, LDS_BYTES) != hipSuccess) { fprintf(stderr, "kernel_launch: hipFuncSetAttribute failed\n"); grid = -1; return; }
        if (hipOccupancyMaxActiveBlocksPerMultiprocessor(&per_cu, (const void*)mk_fwd, NWAVES * 64, LDS_BYTES) != hipSuccess || per_cu < 1) { fprintf(stderr, "kernel_launch: occupancy query says %d\n", per_cu); per_cu = 1; }
        (void)hipGetLastError();
        grid = cus;
    }
    if (grid < 0) return;
    (void)hipMemsetAsync((char*)d_ws + WS_CTL, 0, CTL_ZERO_BYTES, stream);
    Args a{};
    for (int i = 0; i < 26; ++i) a.in[i] = d_in[i];
    a.out = (float*)d_out; a.ws = (unsigned char*)d_ws;
#if MK_ONE_LAUNCH
    a.ph_lo = 0; a.ph_hi = N_PHASES;
    void* kargs[] = {&a};
    hipError_t e = hipLaunchCooperativeKernel((const void*)mk_fwd, dim3(grid), dim3(NWAVES * 64), kargs, LDS_BYTES, stream);
    if (e != hipSuccess) fprintf(stderr, "kernel_launch: cooperative launch failed: %s (grid %d)\n", hipGetErrorString(e), grid);
#else
    for (int p = 0; p < N_PHASES; ++p) { a.ph_lo = p; a.ph_hi = p + 1; hipLaunchKernelGGL(mk_fwd, dim3(grid), dim3(NWAVES * 64), LDS_BYTES, stream, a); }
#endif
}
```

```cpp
#include <hip/hip_runtime.h>
#include <hip/hip_cooperative_groups.h>
#include <cstdio>
#include <cstdint>
namespace pg8 {
#define PG8_LAS __attribute__((address_space(3)))
typedef unsigned short bf16_t;
typedef short bf16x8 __attribute__((ext_vector_type(8)));
typedef float f32x4 __attribute__((ext_vector_type(4)));
typedef unsigned u32x4 __attribute__((ext_vector_type(4)));
constexpr int BM = 256, BK = 64, HALF = 128, HTB = HALF * BK * 2  , STAGE_BYTES = 8 * HTB, NXCD = 8, WGM = 4;

__host__ __device__ __forceinline__ int lds_byte(int r, int c) { const int st = (r >> 4) * 2 + (c >> 5), rr = r & 15, cc = c & 31, ob = rr * 64 + cc * 2; return st * 1024 + (ob ^ (((ob >> 9) & 1) << 5)); }
__host__ __device__ __forceinline__ void stage_rc(int b, int& R, int& C) { const int st = b / 1024, sb = b % 1024, swz = sb ^ (((sb >> 9) & 1) << 5); R = (st >> 1) * 16 + swz / 64; C = (st & 1) * 32 + (swz % 64) / 2; }
__host__ __device__ __forceinline__ int perm32(int rho) { const int n = rho >> 4, i = rho & 15; return 8 * (i >> 2) + 4 * n + (i & 3); }

struct Unit { int pm, pn; };
struct Gemm { const bf16_t* A; const bf16_t* Bt; int M, N, K; int ld, kpn, kofs; };

struct StaticOrder {
    int nM, nN, nwg, G, c, wgm;
    __host__ __device__ void init(int M, int N, int G_, int c_, int wgm_ = WGM) { nM = M / BM; nN = N / BM; nwg = nM * nN; G = G_; c = c_; wgm = wgm_; }
    __host__ __device__ bool next(int i, Unit& u) const {
        const long L = (long)i * G + c; if (L >= nwg) return false;
        int wgid = (int)L; { const int q = nwg / NXCD, r = nwg % NXCD, xcd = wgid % NXCD, off = wgid / NXCD; wgid = (xcd < r ? xcd * (q + 1) : r * (q + 1) + (xcd - r) * q) + off; }
        const int nig = wgm * nN, gid = wgid / nig, fm = gid * wgm, gsz = (nM - fm) < wgm ? (nM - fm) : wgm;
        u.pm = fm + ((wgid % nig) % gsz); u.pn = (wgid % nig) / gsz; return true;
    }
    __device__ __forceinline__ void a_ready(const Unit&) const {}
    __device__ __forceinline__ void done(const Unit&) const {}
};

__device__ __forceinline__ unsigned cvt_pk_bf16(float lo, float hi) { unsigned r; asm volatile("v_cvt_pk_bf16_f32 %0, %1, %2" : "=v"(r) : "v"(lo), "v"(hi)); return r; }
typedef float f32x2 __attribute__((ext_vector_type(2)));
__device__ __forceinline__ float fq_sum(float v) {
    { auto rr = __builtin_amdgcn_permlane16_swap(__float_as_uint(v), __float_as_uint(v), false, false); v = __uint_as_float(rr[0]) + __uint_as_float(rr[1]); }
    { auto rr = __builtin_amdgcn_permlane32_swap(__float_as_uint(v), __float_as_uint(v), false, false); v = __uint_as_float(rr[0]) + __uint_as_float(rr[1]); }
    return v;
}
__device__ __forceinline__ void xch8(const u32x4 a, const u32x4 b, const bool lo  , u32x4& d0, u32x4& d1) {
#pragma unroll
    for (int i = 0; i < 4; ++i) {
        const unsigned give = lo ? b[i] : a[i];
        const unsigned r = (unsigned)__builtin_amdgcn_update_dpp(0, (int)give, 0x128  , 0xF, 0xF, false);
        d0[i] = lo ? a[i] : r; d1[i] = lo ? r : b[i]; }
}
__device__ __forceinline__ u32x4 pack8(const f32x4 v0, const f32x4 v1) { u32x4 w; w.x = cvt_pk_bf16(v0[0], v0[1]); w.y = cvt_pk_bf16(v0[2], v0[3]); w.z = cvt_pk_bf16(v1[0], v1[1]); w.w = cvt_pk_bf16(v1[2], v1[3]); return w; }
template <int ACT, bool ROWSCALE = false, bool NTS = false, bool BLK = false> struct EpiB16 {
    static constexpr bool PERM = true, AFTER_DRAIN = false;
    bf16_t* O; int ldc; const float* ss; float inv_n, eps;
    __device__ __forceinline__ void operator()(const f32x4 (&acc)[2][2][4][2], const Unit& u, int wr, int wc, int fr, int fq) const {
        const int rowg = u.pm * BM + wr * 64; const bool lo = fr < 8;
        const size_t rst = BLK ? (size_t)64 : (size_t)ldc;
        bf16_t* sp = BLK ? O + ((size_t)(u.pm * (ldc >> 6) + u.pn * 4 + wc) * 256 + wr * 64 + (fr & 7)) * 64 + (fr >> 3) * 32 + 8 * fq
                         : O + (size_t)(rowg + (fr & 7)) * ldc + u.pn * BM + wc * 64 + (fr >> 3) * 32 + 8 * fq;
#pragma unroll
        for (int ai = 0; ai < 2; ++ai)
#pragma unroll
            for (int m = 0; m < 4; ++m) {
                float rs = 1.f; if (ROWSCALE) rs = __builtin_amdgcn_rsqf(ss[rowg + ai * HALF + m * 16 + fr] * inv_n + eps);
                u32x4 w[2];
#pragma unroll
                for (int bj = 0; bj < 2; ++bj) { f32x4 v0 = acc[ai][bj][m][0], v1 = acc[ai][bj][m][1];
                    if (ROWSCALE) { v0 = v0 * rs; v1 = v1 * rs; }
                    if (ACT == 2) {
#pragma unroll
                        for (int i = 0; i < 4; ++i) { float a = fmaxf(v0[i], 0.f), b = fmaxf(v1[i], 0.f); v0[i] = a * a; v1[i] = b * b; } }
                    w[bj] = pack8(v0, v1); }
                u32x4 d0, d1; xch8(w[0], w[1], lo, d0, d1);
                bf16_t* p = sp + (size_t)(ai * HALF + m * 16) * rst;
                if (NTS) { __builtin_nontemporal_store(d0, (u32x4*)p); __builtin_nontemporal_store(d1, (u32x4*)(p + 8 * rst)); }
                else { *(u32x4*)p = d0; *(u32x4*)(p + 8 * rst) = d1; } }
    }
};
struct EpiLora {
    static constexpr bool PERM = true, AFTER_DRAIN = false;
    bf16_t* O; int ldc; const float* w0; const float* a0;
    __device__ __forceinline__ void operator()(const f32x4 (&acc)[2][2][4][2], const Unit& u, int wr, int wc, int fr, int fq) const {
        const int rowg = u.pm * BM + wr * 64; const bool lo = fr < 8;
        const int type = u.pn >> 2, cb0 = (u.pn & 3) * BM + wc * 64 + 8 * fq;
        const float* bias = (type == 0) ? w0 : a0;
        const float sc = (type == 0) ? 0.6065306597126334f : 1.0f;
        f32x4 bz[2][2] = {{{0.f, 0.f, 0.f, 0.f}, {0.f, 0.f, 0.f, 0.f}}, {{0.f, 0.f, 0.f, 0.f}, {0.f, 0.f, 0.f, 0.f}}};
        if (type < 2) {
#pragma unroll
            for (int bj = 0; bj < 2; ++bj) { bz[bj][0] = *(const f32x4*)(bias + cb0 + bj * 32); bz[bj][1] = *(const f32x4*)(bias + cb0 + bj * 32 + 4); } }
        bf16_t* sp = O + (size_t)(rowg + (fr & 7)) * ldc + u.pn * BM + wc * 64 + (fr >> 3) * 32 + 8 * fq;
#pragma unroll
        for (int ai = 0; ai < 2; ++ai)
#pragma unroll
            for (int m = 0; m < 4; ++m) { u32x4 w[2];
#pragma unroll
                for (int bj = 0; bj < 2; ++bj) {
                    f32x4 v0 = acc[ai][bj][m][0] + bz[bj][0], v1 = acc[ai][bj][m][1] + bz[bj][1];
                    if (type < 2) {
#pragma unroll
                        for (int i = 0; i < 4; ++i) { v0[i] = sc * __builtin_amdgcn_rcpf(1.f + __expf(-v0[i])); v1[i] = sc * __builtin_amdgcn_rcpf(1.f + __expf(-v1[i])); } }
                    w[bj] = pack8(v0, v1); }
                u32x4 d0, d1; xch8(w[0], w[1], lo, d0, d1);
                bf16_t* p = sp + (size_t)(ai * HALF + m * 16) * ldc;
                __builtin_nontemporal_store(d0, (u32x4*)p); __builtin_nontemporal_store(d1, (u32x4*)(p + (size_t)8 * ldc)); }
    }
};
struct EpiNull {
    static constexpr bool PERM = true, AFTER_DRAIN = false;
    __device__ __forceinline__ void operator()(const f32x4 (&acc)[2][2][4][2], const Unit&, int, int, int, int) const {
#pragma unroll
        for (int ai = 0; ai < 2; ++ai)
#pragma unroll
            for (int bj = 0; bj < 2; ++bj)
#pragma unroll
                for (int m = 0; m < 4; ++m)
#pragma unroll
                    for (int n = 0; n < 2; ++n) asm volatile("" :: "v"(acc[ai][bj][m][n]));
    }
};
template <bool RES_BF16, bool SCALE> struct EpiResB {
    static constexpr bool PERM = true, AFTER_DRAIN = false;
    const float* resf; bf16_t* xn; int ldc; const float* ssin; float* ssout; float inv_n, eps;
    __device__ __forceinline__ void operator()(const f32x4 (&acc)[2][2][4][2], const Unit& u, int wr, int wc, int fr, int fq) const {
        const int rowg = u.pm * BM + wr * 64, colw = u.pn * BM + wc * 64; const bool lo = fr < 8;
        bf16_t* sp = xn + (size_t)(rowg + (fr & 7)) * ldc + colw + (fr >> 3) * 32 + 8 * fq;
        const float* lp = resf + (size_t)(rowg + (fr & 7)) * ldc + colw + 8 * fq + (fr >> 3) * 4;
#pragma unroll
        for (int ai = 0; ai < 2; ++ai)
#pragma unroll
            for (int m = 0; m < 4; ++m) { const int row = rowg + ai * HALF + m * 16 + fr; const size_t go = (size_t)(ai * HALF + m * 16) * ldc; float sq = 0.f;
                float s = 1.f; if (SCALE) s = __builtin_amdgcn_rcpf(ssin[row] * inv_n + eps);
                f32x4 r[2][2];
                if (RES_BF16) { const u32x4 L0 = *(const u32x4*)(sp + go), L1 = *(const u32x4*)(sp + go + (size_t)8 * ldc); u32x4 w[2]; xch8(L0, L1, lo, w[0], w[1]);
#pragma unroll
                    for (int bj = 0; bj < 2; ++bj) {
                        r[bj][0] = (f32x4){__builtin_bit_cast(float, w[bj].x << 16), __builtin_bit_cast(float, w[bj].x & 0xffff0000u), __builtin_bit_cast(float, w[bj].y << 16), __builtin_bit_cast(float, w[bj].y & 0xffff0000u)};
                        r[bj][1] = (f32x4){__builtin_bit_cast(float, w[bj].z << 16), __builtin_bit_cast(float, w[bj].z & 0xffff0000u), __builtin_bit_cast(float, w[bj].w << 16), __builtin_bit_cast(float, w[bj].w & 0xffff0000u)}; } }
                else {
#pragma unroll
                    for (int bj = 0; bj < 2; ++bj) { const u32x4 L0 = __builtin_nontemporal_load((const u32x4*)(lp + go + bj * 32)), L1 = __builtin_nontemporal_load((const u32x4*)(lp + go + bj * 32 + (size_t)8 * ldc));
                        u32x4 w0, w1; xch8(L0, L1, lo, w0, w1); r[bj][0] = __builtin_bit_cast(f32x4, w0); r[bj][1] = __builtin_bit_cast(f32x4, w1); } }
                u32x4 wo[2];
#pragma unroll
                for (int bj = 0; bj < 2; ++bj) {
                    const f32x4 o0 = r[bj][0] + acc[ai][bj][m][0] * s, o1 = r[bj][1] + acc[ai][bj][m][1] * s;
                    sq += (o0[0] * o0[0] + o0[1] * o0[1]) + (o0[2] * o0[2] + o0[3] * o0[3]) + (o1[0] * o1[0] + o1[1] * o1[1]) + (o1[2] * o1[2] + o1[3] * o1[3]);
                    wo[bj] = pack8(o0, o1); }
                u32x4 d0, d1; xch8(wo[0], wo[1], lo, d0, d1);
                *(u32x4*)(sp + go) = d0; *(u32x4*)(sp + go + (size_t)8 * ldc) = d1;
                sq = fq_sum(sq);
                if (fq == 0) atomicAdd(ssout + row, sq);
                asm volatile("" ::: "memory"); }
    }
};
struct PanelOrder {
    int c;
    __device__ __forceinline__ bool next(int i, Unit& u) const { if (i >= 2 || c >= 256) return false; u.pm = 32 * i + (c & 31); u.pn = c >> 5; return true; }
    __device__ __forceinline__ void a_ready(const Unit&) const {}
    __device__ __forceinline__ void done(const Unit&) const {}
};
struct EpiFinal {
    static constexpr bool PERM = true, AFTER_DRAIN = false;
    const bf16_t* xn; int ldc; const float* ssin; float* ss3; unsigned* pcnt; const float* gain; float* out; float inv_n, eps; unsigned* tmo;
    __device__ __forceinline__ void operator()(const f32x4 (&acc_)[2][2][4][2], const Unit& u, int wr, int wc, int fr, int fq) const {
        f32x4 (&acc)[2][2][4][2] = const_cast<f32x4 (&)[2][2][4][2]>(acc_);
        const int row0 = u.pm * BM + wr * 64 + fr, col0 = u.pn * BM + wc * 64 + 8 * fq; const bool lo = fr < 8;
#pragma unroll
        for (int ai = 0; ai < 2; ++ai)
#pragma unroll
            for (int m = 0; m < 4; ++m) { const int row = row0 + ai * HALF + m * 16; float sq = 0.f;
                const float s = __builtin_amdgcn_rcpf(ssin[row] * inv_n + eps);
                const bf16_t* lp = xn + (size_t)(row - fr + (fr & 7)) * ldc + u.pn * BM + wc * 64 + (fr >> 3) * 32 + 8 * fq;
                u32x4 wx[2]; { const u32x4 L0 = *(const u32x4*)lp, L1 = *(const u32x4*)(lp + (size_t)8 * ldc); xch8(L0, L1, lo, wx[0], wx[1]); }
#pragma unroll
                for (int bj = 0; bj < 2; ++bj) { const u32x4 w = wx[bj];
                    const f32x4 r0 = {__builtin_bit_cast(float, w.x << 16), __builtin_bit_cast(float, w.x & 0xffff0000u), __builtin_bit_cast(float, w.y << 16), __builtin_bit_cast(float, w.y & 0xffff0000u)};
                    const f32x4 r1 = {__builtin_bit_cast(float, w.z << 16), __builtin_bit_cast(float, w.z & 0xffff0000u), __builtin_bit_cast(float, w.w << 16), __builtin_bit_cast(float, w.w & 0xffff0000u)};
                    const f32x4 o0 = r0 + acc[ai][bj][m][0] * s, o1 = r1 + acc[ai][bj][m][1] * s; acc[ai][bj][m][0] = o0; acc[ai][bj][m][1] = o1;
                    sq += (o0[0] * o0[0] + o0[1] * o0[1]) + (o0[2] * o0[2] + o0[3] * o0[3]) + (o1[0] * o1[0] + o1[1] * o1[1]) + (o1[2] * o1[2] + o1[3] * o1[3]); }
                sq = fq_sum(sq);
                if (fq == 0) atomicAdd(ss3 + row, sq);
                asm volatile("" ::: "memory"); }
        asm volatile("s_waitcnt vmcnt(0)" ::: "memory"); __syncthreads();
        unsigned* cw = pcnt + 64 * u.pm;
        if (wr == 0 && wc == 0) {
            if (fr == 0 && fq == 0) { __builtin_amdgcn_fence(__ATOMIC_RELEASE, "agent"); asm volatile("s_waitcnt vmcnt(0)" ::: "memory"); __hip_atomic_fetch_add(cw, 1u, __ATOMIC_RELAXED, __HIP_MEMORY_SCOPE_AGENT); }
            unsigned spins = 0;
            while ((unsigned)__builtin_amdgcn_readfirstlane(__hip_atomic_load(cw, __ATOMIC_RELAXED, __HIP_MEMORY_SCOPE_AGENT)) < 8u) {
                __builtin_amdgcn_s_sleep(2);
                if (++spins > (1u << 22)) { if (fr == 0 && fq == 0) __hip_atomic_store(tmo, 1u, __ATOMIC_RELAXED, __HIP_MEMORY_SCOPE_AGENT); break; } }
            __builtin_amdgcn_fence(__ATOMIC_ACQUIRE, "agent"); asm volatile("s_waitcnt vmcnt(0)" ::: "memory");
        }
        __syncthreads();
#pragma unroll
        for (int ai = 0; ai < 2; ++ai)
#pragma unroll
            for (int m = 0; m < 4; ++m) { const int row = row0 + ai * HALF + m * 16;
                const float rs = __builtin_amdgcn_rsqf(__hip_atomic_load(ss3 + row, __ATOMIC_RELAXED, __HIP_MEMORY_SCOPE_AGENT) * inv_n + eps);
                float* p = out + (size_t)(row - fr + (fr & 7)) * ldc + col0 + (fr >> 3) * 4;
#pragma unroll
                for (int bj = 0; bj < 2; ++bj) { const f32x4 g0 = *(const f32x4*)(gain + col0 + bj * 32), g1 = *(const f32x4*)(gain + col0 + bj * 32 + 4);
                    const f32x4 y0 = acc[ai][bj][m][0] * rs * g0, y1 = acc[ai][bj][m][1] * rs * g1;
                    u32x4 d0, d1; xch8(__builtin_bit_cast(u32x4, y0), __builtin_bit_cast(u32x4, y1), lo, d0, d1);
                    __builtin_nontemporal_store(d0, (u32x4*)(p + bj * 32));
                    __builtin_nontemporal_store(d1, (u32x4*)(p + bj * 32 + (size_t)8 * ldc)); } }
    }
};
template <class Epi, class Sched, bool ALIGN_EPI = false, bool SP2 = false, bool ABLK = false>
__device__ __forceinline__ void gemm_phase(PG8_LAS unsigned char* lds, const Gemm g, const Sched& S, const Epi& E, const int wv  ) {
    int tid_ = wv * 64 + (int)__builtin_amdgcn_mbcnt_hi(~0u, __builtin_amdgcn_mbcnt_lo(~0u, 0u)); asm volatile("" : "+v"(tid_));
    const int tid = tid_, wid = __builtin_amdgcn_readfirstlane(tid >> 6), lane = tid & 63, wr = wid >> 2, wc = wid & 3, fr = lane & 15, fq = lane >> 4;
    const int K = g.K, nt = K / BK, LD = g.ld ? g.ld : g.K;
    unsigned voffA[2], voffB[2];
#pragma unroll
    for (int i = 0; i < 2; ++i) { int R, C; stage_rc(tid * 16 + i * 8192, R, C); const int Rb = (R >> 5) * 64 + (Epi::PERM ? perm32(R & 31) : (R & 31));
        voffA[i] = (unsigned)(R * (ABLK ? BK : LD) + C) * 2u; voffB[i] = (unsigned)(Rb * LD + C) * 2u; }
    const size_t kstep = (size_t)(BK * 2);
    const size_t hstep = (size_t)HALF * LD * 2;
    const size_t tstep = 2 * hstep;
    const size_t kstepA = ABLK ? (size_t)BM * BK * 2 : kstep, hstepA = ABLK ? (size_t)HALF * BK * 2 : hstep, tstepA = ABLK ? (size_t)(K / BK) * kstepA : tstep;
    const size_t hstepB = (size_t)32 * LD * 2;
    const unsigned ldsw = (unsigned)wid * 1024u;
    const int aoff = lds_byte(wr * 64 + fr, fq * 8), boff = lds_byte(wc * 32 + fr, fq * 8);
#define PG8_SA(b, h) (((b) * 2 + (h)) * HTB)
#define PG8_SB(b, h) ((4 + (b) * 2 + (h)) * HTB)
#define PG8_STAGE(bufoff, gbase, voff) do { _Pragma("unroll") for (int _i = 0; _i < 2; ++_i) \
        __builtin_amdgcn_global_load_lds((const unsigned*)((const char*)(gbase) + (voff)[_i]), (PG8_LAS unsigned*)(lds + (bufoff) + ldsw + _i * 8192), 16, 0, 0); } while (0)
#define PG8_LDA(dst, b, h) do { _Pragma("unroll") for (int m = 0; m < 4; ++m) _Pragma("unroll") for (int k = 0; k < 2; ++k) dst[m][k] = *(const PG8_LAS bf16x8*)(lds + PG8_SA(b, h) + aoff + m * 2048 + k * 1024); } while (0)
#define PG8_LDB(dst, b, h) do { _Pragma("unroll") for (int n = 0; n < 2; ++n) _Pragma("unroll") for (int k = 0; k < 2; ++k) dst[n][k] = *(const PG8_LAS bf16x8*)(lds + PG8_SB(b, h) + boff + n * 2048 + k * 1024); } while (0)
#define PG8_MMA(ai, bj, At, Bt) do { __builtin_amdgcn_s_setprio(1); _Pragma("unroll") for (int m = 0; m < 4; ++m) _Pragma("unroll") for (int n = 0; n < 2; ++n) _Pragma("unroll") for (int k = 0; k < 2; ++k) \
        acc[ai][bj][m][n] = __builtin_amdgcn_mfma_f32_16x16x32_bf16(Bt[n][k], At[m][k], acc[ai][bj][m][n], 0, 0, 0); __builtin_amdgcn_s_setprio(0); } while (0)
#define PG8_WAIT_V(n) asm volatile("s_waitcnt vmcnt(" #n ")" ::: "memory")
#define PG8_WAIT_L(n) asm volatile("s_waitcnt lgkmcnt(" #n ")" ::: "memory")
#define PG8_BAR __builtin_amdgcn_s_barrier()
#define PG8_SCHED __builtin_amdgcn_sched_barrier(0)
    Unit cur, nxt; int ui = 0;
    if (!S.next(0, cur)) return;
    f32x4 acc[2][2][4][2];
#pragma unroll
    for (int a = 0; a < 2; ++a)
#pragma unroll
        for (int b = 0; b < 2; ++b)
#pragma unroll
            for (int m = 0; m < 4; ++m)
#pragma unroll
                for (int n = 0; n < 2; ++n) acc[a][b][m][n] = (f32x4){0.f, 0.f, 0.f, 0.f};
    bf16x8 At[4][2], B0[2][2], B1[2][2];
#define PG8_KOF(u) ((size_t)((g.kofs && (u).pn >= g.kpn) ? g.kofs : 0))
    const char* cA = (const char*)g.A + (size_t)cur.pm * tstepA + PG8_KOF(cur); const char* cB = (const char*)g.Bt + (size_t)cur.pn * tstep + PG8_KOF(cur);
    S.a_ready(cur);
    if constexpr (SP2) {
        PG8_STAGE(PG8_SB(0, 0), cB, voffB); PG8_STAGE(PG8_SB(0, 1), cB + hstepB, voffB); PG8_STAGE(PG8_SA(0, 0), cA, voffA); PG8_STAGE(PG8_SA(0, 1), cA + hstepA, voffA);
        if (wr == 1) PG8_BAR;
        PG8_WAIT_V(2); PG8_BAR;
        PG8_STAGE(PG8_SB(1, 0), cB + kstep, voffB); PG8_STAGE(PG8_SA(1, 0), cA + kstepA, voffA); PG8_STAGE(PG8_SB(1, 1), cB + hstepB + kstep, voffB);
        PG8_WAIT_V(6); PG8_BAR;
    } else {
        PG8_STAGE(PG8_SB(0, 0), cB, voffB); PG8_STAGE(PG8_SA(0, 0), cA, voffA); PG8_STAGE(PG8_SB(0, 1), cB + hstepB, voffB); PG8_STAGE(PG8_SA(0, 1), cA + hstepA, voffA);
        if (wr == 1) PG8_BAR;
        PG8_WAIT_V(4); PG8_BAR;
        PG8_STAGE(PG8_SB(1, 0), cB + kstep, voffB); PG8_STAGE(PG8_SA(1, 0), cA + kstepA, voffA); PG8_STAGE(PG8_SB(1, 1), cB + hstepB + kstep, voffB);
        PG8_WAIT_V(6); PG8_BAR;
    }
    for (;;) {
        const bool has_next = S.next(ui + 1, nxt);
        const char* nA = has_next ? (const char*)g.A + (size_t)nxt.pm * tstepA + PG8_KOF(nxt) : cA; const char* nB = has_next ? (const char*)g.Bt + (size_t)nxt.pn * tstep + PG8_KOF(nxt) : cB;
        for (int t = 0; t < nt; t += 2) {
            const bool last = (t == nt - 2);
            const char* a1 = cA + (size_t)(t + 1) * kstepA;
            const char* a2 = last ? nA : cA + (size_t)(t + 2) * kstepA; const char* b2 = last ? nB : cB + (size_t)(t + 2) * kstep;
            const char* a3 = a2 + kstepA; const char* b3 = b2 + kstep;
            if (last && has_next) S.a_ready(nxt);
            if constexpr (SP2) {
            PG8_LDB(B0, 0, 0); PG8_LDB(B1, 0, 1); PG8_SCHED; PG8_LDA(At, 0, 0); PG8_STAGE(PG8_SA(1, 1), a1 + hstepA, voffA);
            PG8_WAIT_V(8); PG8_WAIT_L(0); PG8_BAR; PG8_MMA(0, 0, At, B0); PG8_MMA(0, 1, At, B1); PG8_BAR; PG8_SCHED;
            PG8_LDA(At, 0, 1); PG8_STAGE(PG8_SB(0, 0), b2, voffB); PG8_STAGE(PG8_SB(0, 1), b2 + hstepB, voffB); PG8_STAGE(PG8_SA(0, 0), a2, voffA);
            PG8_WAIT_V(8); PG8_WAIT_L(0); PG8_BAR; PG8_MMA(1, 0, At, B0); PG8_MMA(1, 1, At, B1); PG8_BAR; PG8_SCHED;
            PG8_LDB(B0, 1, 0); PG8_LDB(B1, 1, 1); PG8_SCHED; PG8_LDA(At, 1, 0); PG8_STAGE(PG8_SA(0, 1), a2 + hstepA, voffA);
            PG8_WAIT_V(8); PG8_WAIT_L(0); PG8_BAR; PG8_MMA(0, 0, At, B0); PG8_MMA(0, 1, At, B1); PG8_BAR; PG8_SCHED;
            PG8_LDA(At, 1, 1); PG8_STAGE(PG8_SB(1, 0), b3, voffB); PG8_STAGE(PG8_SB(1, 1), b3 + hstepB, voffB); PG8_STAGE(PG8_SA(1, 0), a3, voffA);
            PG8_WAIT_V(8); PG8_WAIT_L(0); PG8_BAR; PG8_MMA(1, 0, At, B0); PG8_MMA(1, 1, At, B1); PG8_BAR; PG8_SCHED;
            } else {
            PG8_LDB(B0, 0, 0); PG8_SCHED; PG8_LDA(At, 0, 0); PG8_STAGE(PG8_SA(1, 1), a1 + hstepA, voffA);
            PG8_WAIT_L(8); PG8_BAR; PG8_WAIT_L(0); PG8_MMA(0, 0, At, B0); PG8_BAR; PG8_SCHED;
            PG8_LDB(B1, 0, 1); PG8_STAGE(PG8_SB(0, 0), b2, voffB);
            PG8_BAR; PG8_WAIT_L(0); PG8_MMA(0, 1, At, B1); PG8_BAR;
            PG8_LDA(At, 0, 1); PG8_STAGE(PG8_SA(0, 0), a2, voffA);
            PG8_BAR; PG8_WAIT_L(0); PG8_MMA(1, 0, At, B0); PG8_BAR; PG8_SCHED;
            PG8_STAGE(PG8_SB(0, 1), b2 + hstepB, voffB);
            PG8_WAIT_V(6); PG8_BAR; PG8_MMA(1, 1, At, B1); PG8_BAR;
            PG8_LDB(B0, 1, 0); PG8_SCHED; PG8_LDA(At, 1, 0); PG8_STAGE(PG8_SA(0, 1), a2 + hstepA, voffA);
            PG8_WAIT_L(8); PG8_BAR; PG8_WAIT_L(0); PG8_MMA(0, 0, At, B0); PG8_BAR; PG8_SCHED;
            PG8_LDB(B1, 1, 1); PG8_STAGE(PG8_SB(1, 0), b3, voffB);
            PG8_BAR; PG8_WAIT_L(0); PG8_MMA(0, 1, At, B1); PG8_BAR;
            PG8_LDA(At, 1, 1); PG8_STAGE(PG8_SA(1, 0), a3, voffA);
            PG8_BAR; PG8_WAIT_L(0); PG8_MMA(1, 0, At, B0); PG8_BAR; PG8_SCHED;
            PG8_STAGE(PG8_SB(1, 1), b3 + hstepB, voffB);
            PG8_WAIT_V(6); PG8_BAR; PG8_MMA(1, 1, At, B1); PG8_BAR;
            }
        }
        if constexpr (ALIGN_EPI) { if (wr == 0) PG8_BAR; }
        if constexpr (!Epi::AFTER_DRAIN) { E(acc, cur, wr, wc, fr, fq); S.done(cur); }
        if (!has_next) break;
#pragma unroll
        for (int a = 0; a < 2; ++a)
#pragma unroll
            for (int b = 0; b < 2; ++b)
#pragma unroll
                for (int m = 0; m < 4; ++m)
#pragma unroll
                    for (int n = 0; n < 2; ++n) acc[a][b][m][n] = (f32x4){0.f, 0.f, 0.f, 0.f};
        cur = nxt; cA = nA; cB = nB; ++ui;
        if constexpr (ALIGN_EPI) { if (wr == 1) PG8_BAR; }
    }
    PG8_WAIT_V(0);
    if constexpr (!ALIGN_EPI) { if (wr == 0) PG8_BAR; }
    PG8_BAR;
    if constexpr (Epi::AFTER_DRAIN) { E.fused(acc, cur, wr, wc, fr, fq, lds, wid, lane); S.done(cur); }
#undef PG8_KOF
#undef PG8_SA
#undef PG8_SB
#undef PG8_STAGE
#undef PG8_LDA
#undef PG8_LDB
#undef PG8_MMA
#undef PG8_WAIT_V
#undef PG8_WAIT_L
#undef PG8_BAR
#undef PG8_SCHED
}
}
namespace att {
typedef unsigned short bf16;
constexpr int   D = 128, NW = 8, QBLK = 32, KVBLK = 64;
constexpr float SCALE = 0.088388347648318440f;
constexpr float THR = 8.f;
constexpr size_t SHM_V = KVBLK * D * 2, SHM_K = KVBLK * D * 2, SHM_ATTN = 2 * SHM_V + 2 * SHM_K + NW * 64 * 4;
using bf16x8 = __attribute__((ext_vector_type(8))) short;
using s16x4  = __attribute__((ext_vector_type(4))) short;
using f32x16 = __attribute__((ext_vector_type(16))) float;
using u32x4  = __attribute__((ext_vector_type(4))) unsigned;
using u32x2  = __attribute__((ext_vector_type(2))) unsigned;
#define KSWZ(row, colB) ((row) * 256 + ((colB) ^ (((row) & 7) << 4)))
#define SBAR() __builtin_amdgcn_sched_barrier(0)
__device__ __forceinline__ int crow(int r, int hi) { return (r & 3) + 8 * (r >> 2) + 4 * hi; }
__device__ __forceinline__ unsigned cvtpk(float lo, float hi) { unsigned r; asm volatile("v_cvt_pk_bf16_f32 %0, %1, %2" : "=v"(r) : "v"(lo), "v"(hi)); return r; }
__device__ __forceinline__ void mask16(f32x16& p, unsigned mw) {
#pragma unroll
  for (int r = 0; r < 16; ++r) { const int cr = (r & 3) + 8 * (r >> 2); const int m = __builtin_amdgcn_sbfe((int)mw, cr, 1); p[r] = __uint_as_float(__float_as_uint(p[r]) & (unsigned)m); }
}
template <bool MASKED>
__device__ __forceinline__ void partialSM(f32x16& p0, f32x16& p1, float& m_reg, float& mn, float& alpha) {
  constexpr float C = SCALE * 1.4426950408889634f;
  float pmax = p0[0];
#pragma unroll
  for (int r = 1; r < 16; ++r) pmax = fmaxf(pmax, p0[r]);
#pragma unroll
  for (int r = 0; r < 16; ++r) pmax = fmaxf(pmax, p1[r]);
  { auto rr = __builtin_amdgcn_permlane32_swap(__float_as_uint(pmax), __float_as_uint(pmax), false, false);
    pmax = fmaxf(__uint_as_float(rr[0]), __uint_as_float(rr[1])); }
  if (__builtin_expect(__all(pmax - m_reg <= THR / SCALE), 1)) { mn = m_reg; alpha = 1.f; }
  else { mn = fmaxf(m_reg, pmax); alpha = __builtin_amdgcn_exp2f((m_reg - mn) * C); m_reg = mn; }
  float mnC = -mn * C;
#pragma unroll
  for (int r = 0; r < 16; ++r) p0[r] = fmaf(p0[r], C, mnC);
#pragma unroll
  for (int r = 0; r < 16; ++r) p1[r] = fmaf(p1[r], C, mnC);
#pragma unroll
  for (int r = 0; r < 16; ++r) p0[r] = __builtin_amdgcn_exp2f(p0[r]);
}
template <bool MASKED>
__device__ __forceinline__ void finishSM(f32x16& p0, f32x16& p1, float alpha, float& l_reg, bf16x8& pa0, bf16x8& pa1, bf16x8& pa2, bf16x8& pa3, unsigned mw0, unsigned mw1) {
#pragma unroll
  for (int r = 0; r < 16; ++r) p1[r] = __builtin_amdgcn_exp2f(p1[r]);
  if (MASKED) { mask16(p0, mw0); mask16(p1, mw1); }
  float ps = 0;
#pragma unroll
  for (int r = 0; r < 16; ++r) ps += p0[r];
#pragma unroll
  for (int r = 0; r < 16; ++r) ps += p1[r];
  { auto rr = __builtin_amdgcn_permlane32_swap(__float_as_uint(ps), __float_as_uint(ps), false, false);
    ps = __uint_as_float(rr[0]) + __uint_as_float(rr[1]); }
  l_reg = l_reg * alpha + ps;
#define PK4(P, BASE, OUT) do { unsigned a0 = cvtpk(P[BASE + 0], P[BASE + 1]), a1 = cvtpk(P[BASE + 2], P[BASE + 3]);   \
    unsigned b0 = cvtpk(P[BASE + 4], P[BASE + 5]), b1 = cvtpk(P[BASE + 6], P[BASE + 7]);                              \
    auto r0 = __builtin_amdgcn_permlane32_swap(a0, b0, false, false); auto r1 = __builtin_amdgcn_permlane32_swap(a1, b1, false, false); \
    u32x4 w = {r0[0], r1[0], r0[1], r1[1]}; OUT = *reinterpret_cast<bf16x8*>(&w); } while (0)
  PK4(p0, 0, pa0); PK4(p0, 8, pa1); PK4(p1, 0, pa2); PK4(p1, 8, pa3);
#undef PK4
}
__device__ __forceinline__ void qkt(f32x16& p0, f32x16& p1, const bf16* Ks, const bf16x8* qr, int r32, int hi) {
  p0 = f32x16{}; p1 = f32x16{};
#pragma unroll
  for (int d0 = 0; d0 < 8; ++d0) { int cb = (d0 * 16 + hi * 8) * 2;
    bf16x8 b0 = *reinterpret_cast<const bf16x8*>((const char*)Ks + KSWZ(r32, cb));
    bf16x8 b1 = *reinterpret_cast<const bf16x8*>((const char*)Ks + KSWZ(32 + r32, cb));
    p0 = __builtin_amdgcn_mfma_f32_32x32x16_bf16(b0, qr[d0], p0, 0, 0, 0);
    p1 = __builtin_amdgcn_mfma_f32_32x32x16_bf16(b1, qr[d0], p1, 0, 0, 0); }
}
__device__ __forceinline__ int v_st(int k, int c) { const int kk = (k & ~0xC) | ((k & 4) << 1) | ((k & 8) >> 1); return ((kk >> 3) * 4 + (c >> 5)) * 512 + ((kk & 7) * 32 + (c & 31)) * 2; }
__device__ __forceinline__ int v_rd_base(int lane) { return ((lane & 3) << 3) | (((lane >> 2) & 3) << 6) | (((lane >> 4) & 1) << 5) | (((lane >> 5) & 1) << 8); }
constexpr int v_rd_off(int d0, int ks, int half) { return d0 * 512 + ks * 4096 + half * 2048; }
template <int OFF> __device__ __forceinline__ s16x4 tr_read(int vb) {
  s16x4 r; asm volatile("ds_read_b64_tr_b16 %0, %1 offset:%2" : "=&v"(r) : "v"(vb), "i"(OFF) : "memory"); return r;
}
template <int D0> __device__ __forceinline__ void pv_one(f32x16& od, int vb, bf16x8 pa0, bf16x8 pa1, bf16x8 pa2, bf16x8 pa3) {
  const s16x4 l0 = tr_read<v_rd_off(D0, 0, 0)>(vb), h0 = tr_read<v_rd_off(D0, 0, 1)>(vb), l1 = tr_read<v_rd_off(D0, 1, 0)>(vb), h1 = tr_read<v_rd_off(D0, 1, 1)>(vb);
  const s16x4 l2 = tr_read<v_rd_off(D0, 2, 0)>(vb), h2 = tr_read<v_rd_off(D0, 2, 1)>(vb), l3 = tr_read<v_rd_off(D0, 3, 0)>(vb), h3 = tr_read<v_rd_off(D0, 3, 1)>(vb);
  asm volatile("s_waitcnt lgkmcnt(0)" ::: "memory"); SBAR();
#define PK(L, H) (bf16x8){L[0], L[1], L[2], L[3], H[0], H[1], H[2], H[3]}
  od = __builtin_amdgcn_mfma_f32_32x32x16_bf16(pa0, PK(l0, h0), od, 0, 0, 0);
  od = __builtin_amdgcn_mfma_f32_32x32x16_bf16(pa1, PK(l1, h1), od, 0, 0, 0);
  od = __builtin_amdgcn_mfma_f32_32x32x16_bf16(pa2, PK(l2, h2), od, 0, 0, 0);
  od = __builtin_amdgcn_mfma_f32_32x32x16_bf16(pa3, PK(l3, h3), od, 0, 0, 0);
#undef PK
}
__device__ __forceinline__ void pv_d0(f32x16* o, int vb, bf16x8 pa0, bf16x8 pa1, bf16x8 pa2, bf16x8 pa3) {
  pv_one<0>(o[0], vb, pa0, pa1, pa2, pa3); pv_one<1>(o[1], vb, pa0, pa1, pa2, pa3); pv_one<2>(o[2], vb, pa0, pa1, pa2, pa3); pv_one<3>(o[3], vb, pa0, pa1, pa2, pa3);
}
template <int LDQ, int LDK, int LDO, bool MASKED, int SDEPTH>
__device__ __forceinline__ void attn_body(const bf16* __restrict__ Qb, const bf16* __restrict__ Kh, const bf16* __restrict__ Vh,
                                          bf16* __restrict__ Ob, const unsigned* __restrict__ mrow0, int seq, char* lds, const int wv) {
  int tid_ = wv * 64 + (int)__builtin_amdgcn_mbcnt_hi(~0u, __builtin_amdgcn_mbcnt_lo(~0u, 0u)); asm volatile("" : "+v"(tid_));
  const int tid = tid_, wid = tid >> 6, lane = tid & 63, r32 = lane & 31, hi = lane >> 5;
  bf16* V_lds = (bf16*)lds; bf16* K_lds = (bf16*)(lds + 2 * SHM_V);
  float* ws = (float*)(lds + 2 * SHM_V + 2 * SHM_K) + wid * 64; float* li_l = ws; float* al_l = ws + 32;
  float m_reg = -1e30f, l_reg = 0; f32x16 o[4] = {}; bf16x8 qr[8];
  const bf16* Qw = Qb + (long)(wid * QBLK + r32) * LDQ + hi * 8;
#pragma unroll
  for (int d0 = 0; d0 < 8; ++d0) qr[d0] = *reinterpret_cast<const bf16x8*>(Qw + d0 * 16);
  const int msh = 4 * hi;
  u32x2* mlds = (u32x2*)(lds + SHM_ATTN);
  if (MASKED) {
#pragma unroll 4
    for (int i = 0; i < 16; ++i) { const int idx = tid + 512 * i; mlds[(idx >> 5) * 33 + (idx & 31)] = *reinterpret_cast<const u32x2*>(mrow0 + 2 * idx); }
  }
  const int mro = (wid * QBLK + r32) * 33;
#define MLOAD(j) (MASKED ? mlds[mro + (j)] : (u32x2){0u, 0u})
  const int sr = tid >> 4, sc = (tid & 15) * 8, vst0 = v_st(sr, sc), vst1 = v_st(32 + sr, sc);
  const int vb0 = (int)(uintptr_t)V_lds + v_rd_base(lane);
  struct { bf16x8 vs0, vs1, ks0, ks1; } sr_[SDEPTH];
#define SLOAD(i, k0) do { sr_[i].vs0 = *reinterpret_cast<const bf16x8*>(&Vh[(long)((k0) + sr) * LDK + sc]); sr_[i].vs1 = *reinterpret_cast<const bf16x8*>(&Vh[(long)((k0) + 32 + sr) * LDK + sc]); \
    sr_[i].ks0 = *reinterpret_cast<const bf16x8*>(&Kh[(long)((k0) + sr) * LDK + sc]); sr_[i].ks1 = *reinterpret_cast<const bf16x8*>(&Kh[(long)((k0) + 32 + sr) * LDK + sc]); } while (0)
#define SWRITE(b, i) do { *(bf16x8*)((char*)V_lds + (b) * SHM_V + vst0) = sr_[i].vs0;          \
    *(bf16x8*)((char*)V_lds + (b) * SHM_V + vst1) = sr_[i].vs1; int kc = sc * 2;               \
    *(bf16x8*)((char*)K_lds + (b) * SHM_K + KSWZ(sr, kc)) = sr_[i].ks0;                       \
    *(bf16x8*)((char*)K_lds + (b) * SHM_K + KSWZ(32 + sr, kc)) = sr_[i].ks1; } while (0)
#define SWAIT() do { if constexpr (SDEPTH == 2) asm volatile("s_waitcnt vmcnt(4)" ::: "memory"); else asm volatile("s_waitcnt vmcnt(0)" ::: "memory"); } while (0)
#define RESC(a) do { if (__any((a) < 1.f)) { if (hi == 0) al_l[r32] = (a); asm volatile("s_waitcnt lgkmcnt(0)" ::: "memory"); \
    _Pragma("unroll") for (int d = 0; d < 4; ++d) _Pragma("unroll") for (int r = 0; r < 16; ++r) o[d][r] *= al_l[crow(r, hi)]; } } while (0)
  f32x16 pA0, pA1, pB0, pB1; float mnA, mnB, alA, alB; bf16x8 pa0, pa1, pa2, pa3; const int NT = seq / KVBLK;
  u32x2 mwA, mwB;
  constexpr int SE = 0, SO = SDEPTH - 1;
  SLOAD(SE, 0); asm volatile("s_waitcnt vmcnt(0)" ::: "memory"); SWRITE(0, SE); __syncthreads();
  qkt(pA0, pA1, K_lds, qr, r32, hi); partialSM<MASKED>(pA0, pA1, m_reg, mnA, alA);
  SLOAD(SO, KVBLK); if constexpr (SDEPTH == 2) { if (2 < NT) SLOAD(SE, 2 * KVBLK); }
  SWAIT(); SWRITE(1, SO); __syncthreads();
  for (int j = 1; j + 1 < NT; j += 2) {
    mwA = MLOAD(j - 1);
    SBAR(); qkt(pB0, pB1, (bf16*)((char*)K_lds + SHM_K), qr, r32, hi);
    finishSM<MASKED>(pA0, pA1, alA, l_reg, pa0, pa1, pa2, pa3, mwA[0] >> msh, mwA[1] >> msh); SBAR();
    SLOAD(SO, (j + SDEPTH) * KVBLK); SBAR();
    pv_d0(o, vb0, pa0, pa1, pa2, pa3); partialSM<MASKED>(pB0, pB1, m_reg, mnB, alB);
    __syncthreads(); SWAIT(); SWRITE(0, SE);
    RESC(alB); __syncthreads();
    mwB = MLOAD(j);
    SBAR(); qkt(pA0, pA1, K_lds, qr, r32, hi);
    finishSM<MASKED>(pB0, pB1, alB, l_reg, pa0, pa1, pa2, pa3, mwB[0] >> msh, mwB[1] >> msh); SBAR();
    if (SDEPTH == 1 || j + 3 < NT) SLOAD(SE, (j + 1 + SDEPTH) * KVBLK); SBAR();
    pv_d0(o, vb0 + (int)SHM_V, pa0, pa1, pa2, pa3); partialSM<MASKED>(pA0, pA1, m_reg, mnA, alA);
    __syncthreads(); SWAIT(); SWRITE(1, SO);
    RESC(alA); __syncthreads();
  }
  mwA = MLOAD(NT - 2);
  SBAR(); qkt(pB0, pB1, (bf16*)((char*)K_lds + SHM_K), qr, r32, hi);
  finishSM<MASKED>(pA0, pA1, alA, l_reg, pa0, pa1, pa2, pa3, mwA[0] >> msh, mwA[1] >> msh); SBAR();
  pv_d0(o, vb0, pa0, pa1, pa2, pa3); partialSM<MASKED>(pB0, pB1, m_reg, mnB, alB);
  __syncthreads(); RESC(alB);
  mwB = MLOAD(NT - 1);
  finishSM<MASKED>(pB0, pB1, alB, l_reg, pa0, pa1, pa2, pa3, mwB[0] >> msh, mwB[1] >> msh); SBAR();
  pv_d0(o, vb0 + (int)SHM_V, pa0, pa1, pa2, pa3);
  if (hi == 0) li_l[r32] = l_reg; asm volatile("s_waitcnt lgkmcnt(0)" ::: "memory");
  float rli[16];
#pragma unroll
  for (int r = 0; r < 16; ++r) rli[r] = __builtin_amdgcn_rcpf(li_l[crow(r, hi)]);
  bf16* Ow = Ob + (long)(wid * QBLK) * LDO;
#pragma unroll
  for (int r = 0; r < 16; ++r) { int orow = crow(r, hi);
#pragma unroll
    for (int d0 = 0; d0 < 4; ++d0) { const float v = o[d0][r] * rli[r]; unsigned u = __float_as_uint(v); u = (u + 0x7fffu + ((u >> 16) & 1u)) >> 16;
      Ow[(long)orow * LDO + d0 * 32 + r32] = (bf16)u; } }
  __syncthreads();
#undef SLOAD
#undef SWRITE
#undef SWAIT
#undef RESC
#undef MLOAD
}
#undef KSWZ
#undef SBAR
}
namespace cg = cooperative_groups;
constexpr int NWAVES = 8;
#ifndef WGM_P1
#define WGM_P1 4
#endif
#ifndef WGM_P11
#define WGM_P11 4
#endif
#ifndef WGM_P5
#define WGM_P5 2
#endif
#ifndef PROBE_PH
#define PROBE_PH -1
#endif
#ifndef ATT_SD
#define ATT_SD 2
#endif
#ifndef MK_ONE_LAUNCH
#define MK_ONE_LAUNCH 1
#endif
constexpr int NB = 8, SEQ = 2048, DM = 2048, T = NB * SEQ, NMEM = 256, TM = NB * NMEM;
constexpr int NIN = 6000, NP = 6144;
constexpr int C_R = 0, C_K = 1024, C_V = 2048, C_XW = 3072, C_XA = 3136, C_XG = 3200, C_Q = 3360, C_AK = 4384, C_AV = 4640, C_QI = 4896, C_KI = 5920, C_WI = 5984;
constexpr int DFF = 8192, NL = 3072, KL = 384;
constexpr float NORM_EPS = 1e-5f, RWKV_LN_EPS = 64e-5f;
constexpr size_t MiB = 1u << 20;
constexpr size_t WS_CTL = 0, CTL_ZERO_BYTES = 384 * 1024;
constexpr size_t WS_WIN = 2 * MiB, WS_WMIX = 26 * MiB, WS_WQ = 34 * MiB, WS_WKV = 36 * MiB, WS_WO = 40 * MiB, WS_WUP = 42 * MiB, WS_WDN = 74 * MiB, WS_WL = 106 * MiB;
constexpr size_t WS_XN = 110 * MiB, WS_MEMN = 174 * MiB, WS_MEMKV = 182 * MiB, WS_AL = 186 * MiB, WS_MASK = 198 * MiB, WS_QC = 202 * MiB, WS_OC = 218 * MiB;
constexpr size_t WS_Y = 236 * MiB, WS_P = 300 * MiB, WS_ACT = 236 * MiB, WS_END = 492 * MiB;
static_assert(WS_WL + (size_t)NL * KL * 2 <= WS_XN && WS_AL + (size_t)T * KL * 2 <= WS_MASK && WS_P + (size_t)T * NP * 2 <= WS_END && WS_ACT + (size_t)T * DFF * 2 <= WS_END, "ws map");
constexpr int CW_QUEUE = 64;
constexpr int CW_BAR = 4096;
constexpr int CW_SS1 = 32768, CW_SS2 = CW_SS1 + T, CW_SS3 = CW_SS2 + T, CW_PCNT = CW_SS3 + T + 64, CW_TMO = 2048;
static_assert((CW_PCNT + 64 * 64) * 4 <= (int)CTL_ZERO_BYTES, "control words inside the memset");
constexpr int RING_BYTES = 131072, LDS_BYTES = 147456, MISC_OFF = LDS_BYTES - 256;

#define GAS __attribute__((address_space(1)))
#define LAS __attribute__((address_space(3)))
typedef unsigned short bf16;
typedef unsigned v4u __attribute__((ext_vector_type(4)));
typedef unsigned v2u __attribute__((ext_vector_type(2)));
typedef float f32x4 __attribute__((ext_vector_type(4)));
typedef float f32x16 __attribute__((ext_vector_type(16)));
typedef short bf16x8 __attribute__((ext_vector_type(8)));
typedef GAS unsigned gu32;
#define RLX_AGENT __ATOMIC_RELAXED, __HIP_MEMORY_SCOPE_AGENT
#define LDS_WAIT() asm volatile("s_waitcnt lgkmcnt(0)" ::: "memory")
#define VM_WAIT() asm volatile("s_waitcnt vmcnt(0)" ::: "memory")
__device__ __forceinline__ unsigned f2bf(float f) { unsigned u = __builtin_bit_cast(unsigned, f); return (u + 0x7fffu + ((u >> 16) & 1u)) >> 16; }
__device__ __forceinline__ unsigned pk2(float lo, float hi) { return f2bf(lo) | (f2bf(hi) << 16); }
__device__ __forceinline__ float bf2f(unsigned short h) { return __builtin_bit_cast(float, (unsigned)h << 16); }
__device__ __forceinline__ float bflo(unsigned w) { return __builtin_bit_cast(float, w << 16); }
__device__ __forceinline__ float bfhi(unsigned w) { return __builtin_bit_cast(float, w & 0xffff0000u); }
__device__ __forceinline__ float wave_sum(float v) {
#pragma unroll
    for (int o = 1; o < 64; o <<= 1) v += __shfl_xor(v, o);
    return v;
}
__device__ __forceinline__ float quad_sum(float v) {
    v += __builtin_bit_cast(float, __builtin_amdgcn_update_dpp(0, __builtin_bit_cast(int, v), 0xB1, 0xF, 0xF, false));
    v += __builtin_bit_cast(float, __builtin_amdgcn_update_dpp(0, __builtin_bit_cast(int, v), 0x4E, 0xF, 0xF, false));
    return v;
}

struct Args { const void* in[26]; float* out; unsigned char* ws; int ph_lo, ph_hi; };

struct Frame {
    LAS unsigned char* lds; int tid, lane, wave, G, bid, wv;
    const float *x, *mem; const int* pos;
    const float *norm_mix, *w_in, *mu, *w0, *wd_up, *a0, *a_up, *g_up, *k_k, *k_a, *r_k, *lnx_w, *lnx_b, *w_mix, *norm_cross, *norm_mem, *w_q, *w_kv, *w_o, *norm_mlp, *w_up, *w_dn, *norm_final;
    float* out; unsigned* ctl;
    bf16 *WIN, *WMIX, *WQ, *WKV, *WO, *WUP, *WDN, *WL, *XN, *MEMN, *MEMKV, *AL, *QC, *OC, *Y, *P, *ACT, *EWAG; unsigned* MASK;
};

__device__ __forceinline__ void p0_transpose_item(const float* W, int K, int N, int NPAD, bf16* WT, LAS float* scr, int item, int lane, const float* gain = nullptr) {
    const int nblk = NPAD / 64, kb = item / nblk, nb = item % nblk, k0 = 64 * kb, n0 = 64 * nb;
    const int c4 = (lane & 15) * 4, kr = lane >> 4; const bool ok = (n0 + c4) < N;
    f32x4 v[16];
#pragma unroll
    for (int i = 0; i < 16; ++i) v[i] = ok ? __builtin_nontemporal_load((const f32x4*)(W + (size_t)(k0 + kr + 4 * i) * N + n0 + c4)) : (f32x4){0.f, 0.f, 0.f, 0.f};
#pragma unroll
    for (int i = 0; i < 16; ++i) { LAS float* s = scr + (kr + 4 * i) * 65 + c4; const float gk = gain ? gain[k0 + kr + 4 * i] : 1.f; s[0] = v[i].x * gk; s[1] = v[i].y * gk; s[2] = v[i].z * gk; s[3] = v[i].w * gk; }
    LDS_WAIT(); asm volatile("" ::: "memory");
    const int c = lane & 7;
#pragma unroll
    for (int j = 0; j < 8; ++j) { const int n = (lane >> 3) + 8 * j; const LAS float* s = scr + (8 * c) * 65 + n;
        v4u o; o.x = pk2(s[0 * 65], s[1 * 65]); o.y = pk2(s[2 * 65], s[3 * 65]); o.z = pk2(s[4 * 65], s[5 * 65]); o.w = pk2(s[6 * 65], s[7 * 65]);
        *(v4u*)(WT + (size_t)(n0 + n) * K + k0 + 8 * c) = o; }
    LDS_WAIT(); asm volatile("" ::: "memory");
}
__device__ __forceinline__ void rms_row_to_bf16(const float* xrow, const float* g, bf16* orow, int lane) {
    const f32x4* xr = (const f32x4*)xrow + lane; const f32x4* gr = (const f32x4*)g + lane;
    f32x4 v[8]; float s = 0.f;
#pragma unroll
    for (int j = 0; j < 8; ++j) { v[j] = __builtin_nontemporal_load(xr + 64 * j); s += (v[j].x * v[j].x + v[j].y * v[j].y) + (v[j].z * v[j].z + v[j].w * v[j].w); }
    const float rstd = 1.f / sqrtf(wave_sum(s) * (1.f / DM) + NORM_EPS);
    v2u* o8 = (v2u*)orow + lane;
#pragma unroll
    for (int j = 0; j < 8; ++j) { const f32x4 gg = gr[64 * j]; v2u w; w.x = pk2(v[j].x * rstd * gg.x, v[j].y * rstd * gg.y); w.y = pk2(v[j].z * rstd * gg.z, v[j].w * rstd * gg.w); o8[64 * j] = w; }
}
__device__ __forceinline__ void p0_prologue(Frame& F, int part = 3) {
    LAS float* scr = (LAS float*)(F.lds + F.wave * 16640);
    const int gw = F.bid * NWAVES + F.wave, NGW = F.G * NWAVES;
    constexpr int I_IN = (DM / 64) * (NP / 64), I_MIX = (DM / 64) * (DM / 64), I_Q = (DM / 64) * (512 / 64), I_KV = (DM / 64) * (1024 / 64), I_O = (512 / 64) * (DM / 64),
                  I_UP = (DM / 64) * (DFF / 64), I_DN = (DFF / 64) * (DM / 64);
    constexpr int NITEMS = I_IN + I_MIX + I_Q + I_KV + I_O;
    if (part & 1)
    for (int it = gw; it < NITEMS; it += NGW) {
        int r = it;
        if (r < I_IN) { p0_transpose_item(F.w_in, DM, NIN, NP, F.WIN, scr, r, F.lane); continue; } r -= I_IN;
        if (r < I_MIX) { p0_transpose_item(F.w_mix, DM, DM, DM, F.WMIX, scr, r, F.lane); continue; } r -= I_MIX;
        if (r < I_Q) { p0_transpose_item(F.w_q, DM, 512, 512, F.WQ, scr, r, F.lane, F.norm_cross); continue; } r -= I_Q;
        if (r < I_KV) { p0_transpose_item(F.w_kv, DM, 1024, 1024, F.WKV, scr, r, F.lane); continue; } r -= I_KV;
        if (r < I_O) { p0_transpose_item(F.w_o, 512, DM, DM, F.WO, scr, r, F.lane); continue; } r -= I_O;
    }
    if (part & 1)
    for (int idx = F.bid * 512 + F.tid; idx < NL * (KL / 8); idx += F.G * 512) {
        const int n = idx % NL, k0 = (idx / NL) * 8, ty = n >> 10, c = n & 1023; float v[8];
#pragma unroll
        for (int i = 0; i < 8; ++i) { const int k = k0 + i; float x = 0.f;
            if (ty == 0) { if (k < 64) x = F.wd_up[(size_t)k * 1024 + c]; }
            else if (ty == 1) { if (k >= 64 && k < 128) x = F.a_up[(size_t)(k - 64) * 1024 + c]; }
            else { if (k >= 128 && k < 288) x = F.g_up[(size_t)(k - 128) * 1024 + c]; }
            v[i] = x; }
        v4u o; o.x = pk2(v[0], v[1]); o.y = pk2(v[2], v[3]); o.z = pk2(v[4], v[5]); o.w = pk2(v[6], v[7]);
        *(v4u*)(F.WL + (size_t)n * KL + k0) = o;
    }
    if (part & 2)
    for (int m = gw; m < T; m += NGW) rms_row_to_bf16(F.x + (size_t)m * DM, F.norm_mix, F.XN + (size_t)m * DM, F.lane);
    for (int m = gw; m < TM; m += NGW) rms_row_to_bf16(F.mem + (size_t)m * DM, F.norm_mem, F.MEMN + (size_t)m * DM, F.lane);
}
__device__ __forceinline__ void p7_mlp_weights(Frame& F, int blk0, int nblk) {
    const int me = F.bid - blk0; if (me < 0 || me >= nblk) return;
    LAS float* scr = (LAS float*)(F.lds + F.wave * 16640);
    constexpr int I_UP = (DM / 64) * (DFF / 64), I_DN = (DFF / 64) * (DM / 64);
    for (int it = me * NWAVES + F.wave; it < I_UP + I_DN; it += nblk * NWAVES) {
        if (it < I_UP) p0_transpose_item(F.w_up, DM, DFF, DFF, F.WUP, scr, it, F.lane, F.norm_mlp);
        else p0_transpose_item(F.w_dn, DFF, DM, DM, F.WDN, scr, it - I_UP, F.lane);
    }
}
__device__ __forceinline__ void norm_phase(Frame& F, const float* g) {
    const int gw = F.bid * NWAVES + F.wave, NGW = F.G * NWAVES;
    for (int m = gw; m < T; m += NGW) rms_row_to_bf16(F.out + (size_t)m * DM, g, F.XN + (size_t)m * DM, F.lane);
}
__device__ __forceinline__ void final_norm_phase(Frame& F) {
    const int gw = F.bid * NWAVES + F.wave, NGW = F.G * NWAVES;
    for (int m = gw; m < T; m += NGW) {
        const v4u* xr = (const v4u*)(F.XN + (size_t)m * DM) + F.lane; f32x4* orow = (f32x4*)(F.out + (size_t)m * DM); const f32x4* gr = (const f32x4*)F.norm_final;
        v4u w[4]; float s = 0.f;
#pragma unroll
        for (int j = 0; j < 4; ++j) { w[j] = __builtin_nontemporal_load(xr + 64 * j);
            const float a0 = bflo(w[j].x), a1 = bfhi(w[j].x), a2 = bflo(w[j].y), a3 = bfhi(w[j].y), a4 = bflo(w[j].z), a5 = bfhi(w[j].z), a6 = bflo(w[j].w), a7 = bfhi(w[j].w);
            s += (a0 * a0 + a1 * a1) + (a2 * a2 + a3 * a3) + (a4 * a4 + a5 * a5) + (a6 * a6 + a7 * a7); }
        const float rstd = 1.f / sqrtf(wave_sum(s) * (1.f / DM) + NORM_EPS);
#pragma unroll
        for (int j = 0; j < 4; ++j) { const int c4 = (64 * j + F.lane) * 2; const f32x4 g0 = gr[c4], g1 = gr[c4 + 1];
            __builtin_nontemporal_store((f32x4){bflo(w[j].x) * rstd * g0.x, bfhi(w[j].x) * rstd * g0.y, bflo(w[j].y) * rstd * g0.z, bfhi(w[j].y) * rstd * g0.w}, orow + c4);
            __builtin_nontemporal_store((f32x4){bflo(w[j].z) * rstd * g1.x, bfhi(w[j].z) * rstd * g1.y, bflo(w[j].w) * rstd * g1.z, bfhi(w[j].w) * rstd * g1.w}, orow + c4 + 1); }
    }
}

__device__ __forceinline__ void prep_phase(Frame& F) {
    const int gw = F.bid * NWAVES + F.wave, NGW = F.G * NWAVES, lane = F.lane;
    LAS float* cs0 = (LAS float*)(F.lds + F.wave * 512);
    int c1 = 0, c2 = 0, fi0 = 0;
    if (lane < 16) { c1 = C_Q + (lane >> 1) * 128 + (lane & 1) * 8; c2 = c1 + 16; fi0 = (lane & 1) * 8; }
    else if (lane < 20) { const int j = lane - 16; c1 = C_AK + (j >> 1) * 128 + (j & 1) * 8; c2 = c1 + 16; fi0 = (j & 1) * 8; }
    else if (lane < 36) { c1 = C_QI + (lane - 20) * 64; c2 = c1 + 8; fi0 = 16; }
    else { c1 = C_KI; c2 = c1 + 8; fi0 = 16; }
    const bool rope_l = lane < 37, lora_l = lane < 36, pad_l = lane < 48;
    const int j0 = lane * 8;
    f32x4 mu0 = {0.f, 0.f, 0.f, 0.f}, mu1 = mu0;
    if (lora_l) { mu0 = *(const f32x4*)(F.mu + C_XW + j0); mu1 = *(const f32x4*)(F.mu + C_XW + j0 + 4); }
    const float fe = (lane < 16) ? (float)lane * (1.f / 16.f) : (float)(lane - 16) * (1.f / 8.f);
    const float invf = exp2f(-fe * 18.931568569324174f);
    for (int mb = gw; mb < T; mb += 2 * NGW) {
        v4u x1[2], x2[2], cu[2], pv[2]; float posf[2]; bool val[2];
#pragma unroll
        for (int u = 0; u < 2; ++u) { const int mm = mb + u * NGW; val[u] = mm < T; const int ms = val[u] ? mm : mb; bf16* prow = F.P + (size_t)ms * NP;
            x1[u] = (v4u){0u, 0u, 0u, 0u}; x2[u] = x1[u]; cu[u] = x1[u]; pv[u] = x1[u];
            if (rope_l) { x1[u] = *(const v4u*)(prow + c1); x2[u] = *(const v4u*)(prow + c2); }
            if (lora_l) { cu[u] = *(const v4u*)(prow + C_XW + j0); if ((ms & (SEQ - 1)) > 0) pv[u] = *(const v4u*)(prow - NP + C_XW + j0); }
            posf[u] = (float)F.pos[ms]; }
#pragma unroll
        for (int u = 0; u < 2; ++u) if (lane < 24) {
            const float ang = posf[u] * invf; const float k = rintf(ang * 0.15915494309189535f);
            float r = fmaf(-k, 6.2831854820251465f, ang); r = fmaf(-k, -1.7484555e-7f, r);
            cs0[u * 64 + lane] = __cosf(r); cs0[u * 64 + 32 + lane] = __sinf(r); }
        LDS_WAIT(); asm volatile("" ::: "memory");
#pragma unroll
        for (int u = 0; u < 2; ++u) { const int mm = mb + u * NGW; if (!val[u]) continue; bf16* prow = F.P + (size_t)mm * NP;
            if (rope_l) { const LAS float* cs = cs0 + u * 64 + fi0;
                const f32x4 ca = *(const LAS f32x4*)(cs), cb = *(const LAS f32x4*)(cs + 4), sa = *(const LAS f32x4*)(cs + 32), sb = *(const LAS f32x4*)(cs + 36);
                const float co[8] = {ca.x, ca.y, ca.z, ca.w, cb.x, cb.y, cb.z, cb.w}, si[8] = {sa.x, sa.y, sa.z, sa.w, sb.x, sb.y, sb.z, sb.w};
                const unsigned a[4] = {x1[u].x, x1[u].y, x1[u].z, x1[u].w}, bq[4] = {x2[u].x, x2[u].y, x2[u].z, x2[u].w}; unsigned o1[4], o2[4];
#pragma unroll
                for (int e = 0; e < 4; ++e) { const float p0 = bflo(a[e]), p1 = bfhi(a[e]), q0 = bflo(bq[e]), q1 = bfhi(bq[e]);
                    o1[e] = pk2(p0 * co[2 * e] - q0 * si[2 * e], p1 * co[2 * e + 1] - q1 * si[2 * e + 1]);
                    o2[e] = pk2(q0 * co[2 * e] + p0 * si[2 * e], q1 * co[2 * e + 1] + p1 * si[2 * e + 1]); }
                *(v4u*)(prow + c1) = (v4u){o1[0], o1[1], o1[2], o1[3]}; *(v4u*)(prow + c2) = (v4u){o2[0], o2[1], o2[2], o2[3]}; }
            if (pad_l) { unsigned o[4] = {0u, 0u, 0u, 0u};
                if (lora_l) { const unsigned cw[4] = {cu[u].x, cu[u].y, cu[u].z, cu[u].w}, pw_[4] = {pv[u].x, pv[u].y, pv[u].z, pv[u].w};
                    const float mu8[8] = {mu0.x, mu0.y, mu0.z, mu0.w, mu1.x, mu1.y, mu1.z, mu1.w};
#pragma unroll
                    for (int e = 0; e < 4; ++e) { float v2[2];
#pragma unroll
                        for (int q = 0; q < 2; ++q) { const float xc = q ? bfhi(cw[e]) : bflo(cw[e]), xp = q ? bfhi(pw_[e]) : bflo(pw_[e]); const float xm = xc + (xp - xc) * mu8[2 * e + q];
                            float v = xm;
                            if (j0 < 64) v = 1.f - 2.f * __builtin_amdgcn_rcpf(1.f + __expf(2.f * xm));
                            else if (j0 >= 128) v = __builtin_amdgcn_rcpf(1.f + __expf(-xm));
                            v2[q] = v; }
                        o[e] = pk2(v2[0], v2[1]); } }
                *(v4u*)(F.AL + (size_t)mm * KL + j0) = (v4u){o[0], o[1], o[2], o[3]}; }
        }
        LDS_WAIT(); asm volatile("" ::: "memory");
    }
}

__device__ __forceinline__ void indexer_unit(Frame& F, int b, int qblk) {
    int t_ = F.wv * 64 + (int)__builtin_amdgcn_mbcnt_hi(~0u, __builtin_amdgcn_mbcnt_lo(~0u, 0u)); asm volatile("" : "+v"(t_));
    const int tid = t_, lane = tid & 63, wave = F.wv, col = lane & 31, hf = lane >> 5;
    const int q0 = qblk * 16, t0 = q0 + 2 * wave, my_t = t0 + hf;
    const bf16* Pb = F.P + (size_t)b * SEQ * NP;
    LAS unsigned char* L = F.lds;
    bf16x8 af[4];
    { const int rho = col, sel = (rho >> 2) & 1, head = (rho & 3) + 4 * (rho >> 3);
      const bf16* qrow = Pb + (size_t)(t0 + sel) * NP + C_QI + head * 64 + hf * 8;
#pragma unroll
      for (int s = 0; s < 4; ++s) af[s] = *(const bf16x8*)(qrow + 16 * s); }
    float wq[16];
    { const v4u* wr = (const v4u*)(Pb + (size_t)my_t * NP + C_WI); const v4u a = wr[0], c = wr[1];
      wq[0] = bflo(a.x); wq[1] = bfhi(a.x); wq[2] = bflo(a.y); wq[3] = bfhi(a.y); wq[4] = bflo(a.z); wq[5] = bfhi(a.z); wq[6] = bflo(a.w); wq[7] = bfhi(a.w);
      wq[8] = bflo(c.x); wq[9] = bfhi(c.x); wq[10] = bflo(c.y); wq[11] = bfhi(c.y); wq[12] = bflo(c.z); wq[13] = bfhi(c.z); wq[14] = bflo(c.w); wq[15] = bfhi(c.w); }
    const int nch = (q0 + 15) / 128 + 1;
    const int srow = tid >> 3, sc16 = tid & 7;
    const bf16* ksrc = Pb + (size_t)srow * NP + C_KI + sc16 * 8;
    v4u st0 = *(const v4u*)(ksrc), st1 = *(const v4u*)(ksrc + (size_t)64 * NP);
    *(LAS v4u*)(L + srow * 144 + sc16 * 16) = st0; *(LAS v4u*)(L + (srow + 64) * 144 + sc16 * 16) = st1;
    __syncthreads();
    unsigned key[64];
#pragma unroll
    for (int ch = 0; ch < 16; ++ch) {
        if (ch < nch) {
            const bool more = (ch + 1 < nch);
            if (more) { st0 = *(const v4u*)(ksrc + (size_t)(128 * (ch + 1)) * NP); st1 = *(const v4u*)(ksrc + (size_t)(128 * (ch + 1) + 64) * NP); }
            const LAS unsigned char* kb0 = L + (ch & 1) * 18432 + col * 144 + hf * 16;
#pragma unroll
            for (int sub = 0; sub < 4; ++sub) { const int kb = 4 * ch + sub;
                f32x16 c = {};
#pragma unroll
                for (int s = 0; s < 4; ++s) { const bf16x8 bfr = *(const LAS bf16x8*)(kb0 + sub * 32 * 144 + s * 32); c = __builtin_amdgcn_mfma_f32_32x32x16_bf16(af[s], bfr, c, 0, 0, 0); }
                float sc = 0.f;
#pragma unroll
                for (int r = 0; r < 16; ++r) sc = fmaf(fmaxf(c[r], 0.f), wq[r], sc);
                unsigned u = __float_as_uint(sc); u = (u & 0x80000000u) ? ~u : (u | 0x80000000u);
                key[kb] = (kb * 32 + col <= my_t) ? u : 0u; }
            if (more) { LAS unsigned char* dst = L + ((ch + 1) & 1) * 18432; *(LAS v4u*)(dst + srow * 144 + sc16 * 16) = st0; *(LAS v4u*)(dst + (srow + 64) * 144 + sc16 * 16) = st1; }
            __syncthreads();
        } else {
#pragma unroll
            for (int sub = 0; sub < 4; ++sub) key[4 * ch + sub] = 0u;
        }
    }
    bool done = (my_t + 1 <= 256);
    unsigned tau = done ? 1u : 0u;
    const int nch8 = (q0 + 15) / 256 + 1;
    for (int bit = 31; bit >= 0; --bit) {
        if (__all(done)) break;
        const unsigned cand = tau | (1u << bit);
        int cnt = 0;
#pragma unroll
        for (int g8 = 0; g8 < 8; ++g8) if (g8 < nch8) {
#pragma unroll
            for (int j = 0; j < 8; ++j) cnt += (key[8 * g8 + j] >= cand) ? 1 : 0; }
        cnt += __builtin_amdgcn_update_dpp(0, cnt, 0xB1, 0xF, 0xF, false); cnt += __builtin_amdgcn_update_dpp(0, cnt, 0x4E, 0xF, 0xF, false);
        cnt += __builtin_amdgcn_update_dpp(0, cnt, 0x141, 0xF, 0xF, false); cnt += __builtin_amdgcn_update_dpp(0, cnt, 0x140, 0xF, 0xF, false);
        { auto rr = __builtin_amdgcn_permlane16_swap((unsigned)cnt, (unsigned)cnt, false, false); cnt = (int)(rr[0] + rr[1]); }
        if (!done && cnt >= 256) { tau = cand; if (cnt == 256) done = true; }
    }
    unsigned* ma = F.MASK + (size_t)(b * SEQ + t0) * 64;
    unsigned wa = 0u, wb = 0u;
#pragma unroll
    for (int kb = 0; kb < 64; ++kb) {
        const unsigned long long bal = __ballot(key[kb] >= tau);
        asm volatile("s_nop 4\n\tv_writelane_b32 %0, %2, %4\n\tv_writelane_b32 %1, %3, %4" : "+v"(wa), "+v"(wb) : "s"((unsigned)bal), "s"((unsigned)(bal >> 32)), "i"(kb));
    }
    ma[lane] = wa; ma[64 + lane] = wb;
    __syncthreads();
}
__device__ __forceinline__ void indexer_phase(Frame& F) {
    for (int i = 0; i < (NB * (SEQ / 16) + F.G - 1) / F.G; ++i) {
        const int j = i * F.G + ((i & 1) ? (F.G - 1 - F.bid) : F.bid);
        if (j < NB * (SEQ / 16)) indexer_unit(F, j & 7, j >> 3);
    }
}

template <int CTRL> __device__ __forceinline__ float dppx(float v) { return __builtin_bit_cast(float, __builtin_amdgcn_update_dpp(0, __builtin_bit_cast(int, v), CTRL, 0xF, 0xF, false)); }
__device__ __forceinline__ float row16_sum(float v) {
    v += dppx<0xB1>(v); v += dppx<0x4E>(v); v += dppx<0x141>(v); v += dppx<0x140>(v); return v;
}
__device__ __forceinline__ void row16_sum2(float& a, float& b) {
    asm volatile("s_nop 1\n\t"
        "v_add_f32_dpp %0, %0, %0 quad_perm:[1,0,3,2] row_mask:0xf bank_mask:0xf\n\t"
        "v_add_f32_dpp %1, %1, %1 quad_perm:[1,0,3,2] row_mask:0xf bank_mask:0xf\n\t"
        "s_nop 0\n\t"
        "v_add_f32_dpp %0, %0, %0 quad_perm:[2,3,0,1] row_mask:0xf bank_mask:0xf\n\t"
        "v_add_f32_dpp %1, %1, %1 quad_perm:[2,3,0,1] row_mask:0xf bank_mask:0xf\n\t"
        "s_nop 0\n\t"
        "v_add_f32_dpp %0, %0, %0 row_half_mirror row_mask:0xf bank_mask:0xf\n\t"
        "v_add_f32_dpp %1, %1, %1 row_half_mirror row_mask:0xf bank_mask:0xf\n\t"
        "s_nop 0\n\t"
        "v_add_f32_dpp %0, %0, %0 row_mirror row_mask:0xf bank_mask:0xf\n\t"
        "v_add_f32_dpp %1, %1, %1 row_mirror row_mask:0xf bank_mask:0xf\n\t"
        "s_nop 1"
        : "+v"(a), "+v"(b));
}
__device__ __forceinline__ float wave_sum_d(float v) { v = row16_sum(v); v += __shfl_xor(v, 16); v += __shfl_xor(v, 32); return v; }
namespace rw {
typedef short bf16x8 __attribute__((ext_vector_type(8)));
typedef short s16x4 __attribute__((ext_vector_type(4)));
typedef float f32x16 __attribute__((ext_vector_type(16)));
constexpr int KAP = 0, RH = 13824, KBT = 27648, BBT = 43008, VT = 58368, KH = 78848, BH = 88064, MATS = 97280, YB = 122880, GC = 139264, WTOT = 140032, BON = 144128;
constexpr int I64 = 4608, I32 = 5120, M32 = 2560, MSET = 12800;
constexpr int AKK = 0, AKR = 2560, ABR = 5120, TT = 7680, SCR = 10240;
constexpr int S64 = 144, S32 = 80;
typedef float f32x2_t __attribute__((ext_vector_type(2))); typedef __bf16 bf16x2_t __attribute__((ext_vector_type(2)));
__device__ __forceinline__ unsigned cvtpk(float lo, float hi) { f32x2_t v = {lo, hi}; bf16x2_t b = __builtin_convertvector(v, bf16x2_t); return __builtin_bit_cast(unsigned, b); }
__device__ __forceinline__ unsigned short cvt1(float x) { return (unsigned short)cvtpk(x, 0.f); }
__device__ __forceinline__ bf16x8 frag_nat(const LAS unsigned char* base, int stride, int row, int kb, int h) { return *(const LAS bf16x8*)(base + row * stride + (kb + 8 * h) * 2); }
__device__ __forceinline__ bf16x8 frag_perm(const LAS unsigned char* base, int stride, int row, int kb, int h) {
    const s16x4 lo = *(const LAS s16x4*)(base + row * stride + (kb + 4 * h) * 2), hi = *(const LAS s16x4*)(base + row * stride + (kb + 8 + 4 * h) * 2);
    return (bf16x8){lo[0], lo[1], lo[2], lo[3], hi[0], hi[1], hi[2], hi[3]};
}
__device__ __forceinline__ bf16x8 acc_frag(const f32x16& x, int s) {
    typedef unsigned u32x4 __attribute__((ext_vector_type(4)));
    u32x4 w; w.x = cvtpk(x[8 * s + 0], x[8 * s + 1]); w.y = cvtpk(x[8 * s + 2], x[8 * s + 3]); w.z = cvtpk(x[8 * s + 4], x[8 * s + 5]); w.w = cvtpk(x[8 * s + 6], x[8 * s + 7]);
    return __builtin_bit_cast(bf16x8, w);
}
__device__ __forceinline__ int crow(int r, int hi) { return (r & 3) + 8 * (r >> 2) + 4 * hi; }
}

#ifndef PROBE_VAR
#define PROBE_VAR 0
#endif
__device__ __forceinline__ void wave_sum2(float& a, float& b) {
    row16_sum2(a, b);
    const float a1 = __shfl_xor(a, 16), b1 = __shfl_xor(b, 16); a += a1; b += b1;
    const float a2 = __shfl_xor(a, 32), b2 = __shfl_xor(b, 32); a += a2; b += b2;
}
template <int N> __device__ __forceinline__ void wave_sum_n(float (&v)[N]) {
#pragma unroll
    for (int i = 0; i < N; ++i) v[i] += dppx<0xB1>(v[i]);
#pragma unroll
    for (int i = 0; i < N; ++i) v[i] += dppx<0x4E>(v[i]);
#pragma unroll
    for (int i = 0; i < N; ++i) v[i] += dppx<0x141>(v[i]);
#pragma unroll
    for (int i = 0; i < N; ++i) v[i] += dppx<0x140>(v[i]);
#pragma unroll
    for (int i = 0; i < N; ++i) { auto rr = __builtin_amdgcn_permlane16_swap(__float_as_uint(v[i]), __float_as_uint(v[i]), false, false);
        v[i] = __uint_as_float(rr[0]) + __uint_as_float(rr[1]); }
#pragma unroll
    for (int i = 0; i < N; ++i) { auto rr = __builtin_amdgcn_permlane32_swap(__float_as_uint(v[i]), __float_as_uint(v[i]), false, false);
        v[i] = __uint_as_float(rr[0]) + __uint_as_float(rr[1]); }
}
__device__ __forceinline__ void rwkv_unit(Frame& F, int b, int h, const int pv = 0) {
    using namespace rw;
    int t_ = F.wv * 64 + (int)__builtin_amdgcn_mbcnt_hi(~0u, __builtin_amdgcn_mbcnt_lo(~0u, 0u)); asm volatile("" : "+v"(t_));
    const int lane = t_ & 63, wave = __builtin_amdgcn_readfirstlane(t_ >> 6), l31 = lane & 31, hi = lane >> 5;
    LAS unsigned char* L = F.lds;
    const int c = lane, col = h * 64 + c;
    const float mu_r = F.mu[C_R + col], mu_k = F.mu[C_K + col], mu_v = F.mu[C_V + col];
    const float kkc = F.k_k[col], kac = F.k_a[col], rkc = F.r_k[col], lw = F.lnx_w[col], lb = F.lnx_b[col];
    const size_t m0 = (size_t)b * SEQ;
    const int vh = wave & 1;
    constexpr int NCH = SEQ / 32;
    float st[40];
#pragma unroll
    for (int i = 0; i < 40; ++i) st[i] = 0.f;
#define rm(j) st[(j)]
#define kt(j) st[8 + (j)]
#define kk(j) st[16 + (j)]
#define bb(j) st[24 + (j)]
#define cs(j) st[32 + (j)]
    unsigned raw[8][5]; unsigned rawp[3]; unsigned gq[8];
#define RW_LOAD(ch) do { { const int tk0 = (ch) * 32 + 8 * wave; const bf16* pp = F.P + (m0 + tk0 - (tk0 > 0 ? 1 : 0)) * NP; rawp[0] = pp[C_R + col]; rawp[1] = pp[C_K + col]; rawp[2] = pp[C_V + col]; } \
        _Pragma("unroll") for (int j = 0; j < 8; ++j) { const size_t m = m0 + (ch) * 32 + 8 * wave + j; const bf16* pr = F.P + m * NP; const bf16* er = F.EWAG + m * NL; \
        raw[j][0] = __builtin_nontemporal_load(pr + C_R + col); raw[j][1] = __builtin_nontemporal_load(pr + C_K + col); raw[j][2] = __builtin_nontemporal_load(pr + C_V + col); \
        raw[j][3] = __builtin_nontemporal_load(er + col); raw[j][4] = __builtin_nontemporal_load(er + 1024 + col); } } while (0)
    if (pv & 128) return;
    if (wave < 4) RW_LOAD(0);
    for (int it = 0; it < NCH + 4; ++it) {
        if (wave < 4) {
            bf16x8 vv = {}; float bon8[8];
#pragma unroll
            for (int j = 0; j < 8; ++j) bon8[j] = 0.f;
            if (it >= 4) { const int ch = it - 4; vv = *(const LAS bf16x8*)(L + VT + (ch & 3) * I32 + c * S32 + 16 * wave);
#pragma unroll
                for (int j = 0; j < 8; ++j) bon8[j] = ((const LAS float*)(L + BON + (ch & 3) * 128))[8 * wave + j]; }
            if (it >= 1 && it <= NCH && !(pv & 32)) { const int ch = it - 1; const LAS float* wt = (const LAS float*)(L + WTOT + (ch & 1) * 2048);
                float off = 0.f, tot = 0.f;
#pragma unroll
                for (int w2 = 0; w2 < 4; ++w2) { const float x = wt[w2 * 64 + c]; tot += x; off += (w2 < wave) ? x : 0.f; }
                const float lgC = -tot;
                LAS unsigned char* pK = L + KAP + (ch % 3) * I64; LAS unsigned char* pR = L + RH + (ch % 3) * I64; LAS unsigned char* pKH = L + KH + (ch & 1) * I64; LAS unsigned char* pBH = L + BH + (ch & 1) * I64;
                LAS unsigned char* pKB = L + KBT + (ch % 3) * I32; LAS unsigned char* pBB = L + BBT + (ch % 3) * I32;
                const float eC = __expf(lgC); float egp = __expf(-off);
                unsigned kb4[4], bb4[4];
#pragma unroll
                for (int j = 0; j < 8; ++j) { const int i = 8 * wave + j;
                    const float e_g = __expf(-(off + cs(j))), e_m = __builtin_amdgcn_rcpf(e_g), e_c = eC * e_m;
                    *(LAS bf16*)(pK + i * S64 + 2 * c) = cvt1(kk(j) * egp); *(LAS bf16*)(pR + i * S64 + 2 * c) = cvt1(rm(j) * e_g);
                    *(LAS bf16*)(pKH + i * S64 + 2 * c) = cvt1(kt(j) * e_m); *(LAS bf16*)(pBH + i * S64 + 2 * c) = cvt1(bb(j) * e_m);
                    const float kbv = kt(j) * e_c, bbv = -bb(j) * e_c;
                    if (j & 1) { kb4[j >> 1] = cvtpk(__uint_as_float(kb4[j >> 1]), kbv); bb4[j >> 1] = cvtpk(__uint_as_float(bb4[j >> 1]), bbv); }
                    else { kb4[j >> 1] = __float_as_uint(kbv); bb4[j >> 1] = __float_as_uint(bbv); }
                    egp = e_g; }
                *(LAS v4u*)(pKB + c * S32 + 16 * wave) = (v4u){kb4[0], kb4[1], kb4[2], kb4[3]};
                *(LAS v4u*)(pBB + c * S32 + 16 * wave) = (v4u){bb4[0], bb4[1], bb4[2], bb4[3]};
                if (wave == 0) ((LAS float*)(L + GC + (ch % 3) * 256))[c] = eC;
            }
            if (it < NCH && !(pv & 64)) { const int ch = it;
                float kkr8[8], a8[8], red[16]; unsigned vt4[4];
#pragma unroll
                for (int j = 0; j < 8; ++j) { const int tk = ch * 32 + 8 * wave + j; const bool hp = tk > 0;
                    const float r0 = bf2f((unsigned short)raw[j][0]), k0 = bf2f((unsigned short)raw[j][1]), v0 = bf2f((unsigned short)raw[j][2]);
                    const float r1 = !hp ? 0.f : bf2f((unsigned short)(j ? raw[j ? j - 1 : 0][0] : rawp[0])), k1 = !hp ? 0.f : bf2f((unsigned short)(j ? raw[j ? j - 1 : 0][1] : rawp[1])),
                                v1 = !hp ? 0.f : bf2f((unsigned short)(j ? raw[j ? j - 1 : 0][2] : rawp[2]));
                    rm(j) = r0 + (r1 - r0) * mu_r; const float km = k0 + (k1 - k0) * mu_k; const float vmj = v0 + (v1 - v0) * mu_v;
                    if (j & 1) vt4[j >> 1] = cvtpk(__uint_as_float(vt4[j >> 1]), vmj); else vt4[j >> 1] = __float_as_uint(vmj);
                    const float ew = bf2f((unsigned short)raw[j][3]); a8[j] = bf2f((unsigned short)raw[j][4]);
                    kkr8[j] = km * kkc; kt(j) = km * (1.f + (a8[j] - 1.f) * kac);
                    red[j] = kkr8[j] * kkr8[j]; red[8 + j] = rm(j) * kt(j) * rkc;
                    cs(j) = (j ? cs(j ? j - 1 : 0) : 0.f) + ew; }
                *(LAS v4u*)(L + VT + (ch & 3) * I32 + c * S32 + 16 * wave) = (v4u){vt4[0], vt4[1], vt4[2], vt4[3]};
                wave_sum_n<16>(red);
#pragma unroll
                for (int j = 0; j < 8; ++j) { kk(j) = kkr8[j] * __builtin_amdgcn_rsqf(fmaxf(red[j], 1e-24f)); bb(j) = kk(j) * a8[j]; }
                if (lane < 8) { float bo = red[8];
#pragma unroll
                    for (int j = 1; j < 8; ++j) bo = (lane == j) ? red[8 + j] : bo;
                    ((LAS float*)(L + BON + (ch & 3) * 128))[8 * wave + lane] = bo; }
                ((LAS float*)(L + WTOT + (ch & 1) * 2048))[wave * 64 + c] = cs(7);
            }
            if (!(pv & 2) && it + 1 < NCH) RW_LOAD(it + 1);
            if (it >= 4 && !(pv & 4)) { const int ch = it - 4;
                const LAS float* yb = (const LAS float*)(L + YB + (ch & 1) * 8192);
                float y8[8], sm[16];
#pragma unroll
                for (int j = 0; j < 8; ++j) { y8[j] = yb[(8 * wave + j) * 64 + c]; sm[j] = y8[j]; sm[8 + j] = y8[j] * y8[j]; }
                wave_sum_n<16>(sm);
#pragma unroll
                for (int j = 0; j < 8; ++j) { const int i = 8 * wave + j;
                    const float mean = sm[j] * (1.f / 64.f), var = fmaxf(sm[8 + j] * (1.f / 64.f) - mean * mean, 0.f);
                    const float yn = (y8[j] - mean) * __builtin_amdgcn_rsqf(var + RWKV_LN_EPS) * lw + lb;
                    const float o = (yn + bon8[j] * bf2f((unsigned short)vv[j])) * bf2f((unsigned short)gq[j]);
                    F.Y[(m0 + ch * 32 + i) * DM + col] = cvt1(o); }
            }
            if (!(pv & 2) && it + 1 >= 4 && it + 1 < NCH + 4) {
#pragma unroll
                for (int j = 0; j < 8; ++j) gq[j] = __builtin_nontemporal_load(F.EWAG + (m0 + (it - 3) * 32 + 8 * wave + j) * NL + 2048 + col); }
        } else if (wave < 6) {
            if (it >= 3 && it < NCH + 3 && !(pv & 8)) { const int ch = it - 3;
                const LAS unsigned char* pK = L + KAP + (ch % 3) * I64; const LAS unsigned char* pR = L + RH + (ch % 3) * I64; const LAS unsigned char* pKB = L + KBT + (ch % 3) * I32;
                const LAS unsigned char* pBB = L + BBT + (ch % 3) * I32; const LAS unsigned char* pV = L + VT + (ch & 3) * I32; const LAS unsigned char* pM = L + MATS + (ch & 1) * MSET;
                f32x16 X0, X1;
#pragma unroll
                for (int r = 0; r < 16; ++r) { X0[r] = st[r]; X1[r] = st[16 + r]; }
                f32x16 RHS = {}, YT = {}; bf16x8 xb[4];
                xb[0] = acc_frag(X0, 0); xb[1] = acc_frag(X0, 1); xb[2] = acc_frag(X1, 0); xb[3] = acc_frag(X1, 1);
#pragma unroll
                for (int q = 0; q < 4; ++q) { RHS = __builtin_amdgcn_mfma_f32_32x32x16_bf16(frag_perm(pK, S64, l31, 16 * q, hi), xb[q], RHS, 0, 0, 0);
                                              YT = __builtin_amdgcn_mfma_f32_32x32x16_bf16(frag_perm(pR, S64, l31, 16 * q, hi), xb[q], YT, 0, 0, 0); }
                const bf16x8 vf0 = frag_nat(pV, S32, 32 * vh + l31, 0, hi), vf1 = frag_nat(pV, S32, 32 * vh + l31, 16, hi);
                RHS = __builtin_amdgcn_mfma_f32_32x32x16_bf16(frag_nat(pM + AKK, S32, l31, 0, hi), vf0, RHS, 0, 0, 0);
                RHS = __builtin_amdgcn_mfma_f32_32x32x16_bf16(frag_nat(pM + AKK, S32, l31, 16, hi), vf1, RHS, 0, 0, 0);
                YT = __builtin_amdgcn_mfma_f32_32x32x16_bf16(frag_nat(pM + AKR, S32, l31, 0, hi), vf0, YT, 0, 0, 0);
                YT = __builtin_amdgcn_mfma_f32_32x32x16_bf16(frag_nat(pM + AKR, S32, l31, 16, hi), vf1, YT, 0, 0, 0);
                f32x16 U = {};
                { const bf16x8 r0 = acc_frag(RHS, 0), r1 = acc_frag(RHS, 1);
                  U = __builtin_amdgcn_mfma_f32_32x32x16_bf16(frag_perm(pM + TT, S32, l31, 0, hi), r0, U, 0, 0, 0);
                  U = __builtin_amdgcn_mfma_f32_32x32x16_bf16(frag_perm(pM + TT, S32, l31, 16, hi), r1, U, 0, 0, 0); }
                const bf16x8 u0 = acc_frag(U, 0), u1 = acc_frag(U, 1);
                YT = __builtin_amdgcn_mfma_f32_32x32x16_bf16(frag_perm(pM + ABR, S32, l31, 0, hi), u0, YT, 0, 0, 0);
                YT = __builtin_amdgcn_mfma_f32_32x32x16_bf16(frag_perm(pM + ABR, S32, l31, 16, hi), u1, YT, 0, 0, 0);
                LAS float* yb = (LAS float*)(L + YB + (ch & 1) * 8192);
#pragma unroll
                for (int r = 0; r < 16; ++r) yb[crow(r, hi) * 64 + 32 * vh + l31] = YT[r];
                const LAS float* gc = (const LAS float*)(L + GC + (ch % 3) * 256);
#pragma unroll
                for (int r = 0; r < 16; ++r) { X0[r] *= gc[crow(r, hi)]; X1[r] *= gc[32 + crow(r, hi)]; }
                X0 = __builtin_amdgcn_mfma_f32_32x32x16_bf16(frag_nat(pKB, S32, l31, 0, hi), vf0, X0, 0, 0, 0);
                X1 = __builtin_amdgcn_mfma_f32_32x32x16_bf16(frag_nat(pKB, S32, 32 + l31, 0, hi), vf0, X1, 0, 0, 0);
                X0 = __builtin_amdgcn_mfma_f32_32x32x16_bf16(frag_nat(pKB, S32, l31, 16, hi), vf1, X0, 0, 0, 0);
                X1 = __builtin_amdgcn_mfma_f32_32x32x16_bf16(frag_nat(pKB, S32, 32 + l31, 16, hi), vf1, X1, 0, 0, 0);
                X0 = __builtin_amdgcn_mfma_f32_32x32x16_bf16(frag_perm(pBB, S32, l31, 0, hi), u0, X0, 0, 0, 0);
                X1 = __builtin_amdgcn_mfma_f32_32x32x16_bf16(frag_perm(pBB, S32, 32 + l31, 0, hi), u0, X1, 0, 0, 0);
                X0 = __builtin_amdgcn_mfma_f32_32x32x16_bf16(frag_perm(pBB, S32, l31, 16, hi), u1, X0, 0, 0, 0);
                X1 = __builtin_amdgcn_mfma_f32_32x32x16_bf16(frag_perm(pBB, S32, 32 + l31, 16, hi), u1, X1, 0, 0, 0);
#pragma unroll
                for (int r = 0; r < 16; ++r) { st[r] = X0[r]; st[16 + r] = X1[r]; }
            }
        } else {
            if (it >= 2 && it < NCH + 2 && !(pv & 16)) { const int ch = it - 2;
                const LAS unsigned char* pK = L + KAP + (ch % 3) * I64; const LAS unsigned char* pR = L + RH + (ch % 3) * I64; const LAS unsigned char* pKH = L + KH + (ch & 1) * I64; const LAS unsigned char* pBH = L + BH + (ch & 1) * I64;
                LAS unsigned char* pM = L + MATS + (ch & 1) * MSET;
                if (wave == 6) {
#pragma unroll
                    for (int w3 = 0; w3 < 3; ++w3) { const LAS unsigned char* Aimg = (w3 == 0) ? pK : pR; const LAS unsigned char* Bimg = (w3 == 2) ? pBH : pKH;
                        f32x16 d = {};
#pragma unroll
                        for (int q = 0; q < 4; ++q) d = __builtin_amdgcn_mfma_f32_32x32x16_bf16(frag_nat(Aimg, S64, l31, 16 * q, hi), frag_nat(Bimg, S64, l31, 16 * q, hi), d, 0, 0, 0);
                        const int dst = (w3 == 0) ? AKK : (w3 == 1) ? AKR : ABR; const float sg = (w3 == 2) ? -1.f : 1.f;
#pragma unroll
                        for (int r = 0; r < 16; ++r) { const int t = crow(r, hi); const bool keep = (w3 == 0) ? (l31 < t) : (l31 <= t);
                            *(LAS bf16*)(pM + dst + t * S32 + 2 * l31) = cvt1(keep ? sg * d[r] : 0.f); } }
                } else {
                    f32x16 pw = {}, pT = {};
#pragma unroll
                    for (int q = 0; q < 4; ++q) { const bf16x8 fk = frag_nat(pK, S64, l31, 16 * q, hi), fb = frag_nat(pBH, S64, l31, 16 * q, hi);
                        pw = __builtin_amdgcn_mfma_f32_32x32x16_bf16(fk, fb, pw, 0, 0, 0);
                        pT = __builtin_amdgcn_mfma_f32_32x32x16_bf16(fb, fk, pT, 0, 0, 0); }
#pragma unroll
                    for (int r = 0; r < 16; ++r) { pw[r] = (l31 < crow(r, hi)) ? pw[r] : 0.f; pT[r] = (crow(r, hi) < l31) ? pT[r] : 0.f; }
                    f32x16 P;
#pragma unroll
                    for (int r = 0; r < 16; ++r) P[r] = ((crow(r, hi) == l31) ? 1.f : 0.f) - pw[r];
                    if (!(pv & 1))
#pragma unroll
                    for (int k2 = 0; k2 < 5; ++k2) {
                        const bf16x8 t0 = acc_frag(pT, 0), t1 = acc_frag(pT, 1);
                        if (k2 > 0) { const bf16x8 p0 = acc_frag(P, 0), p1 = acc_frag(P, 1);
                            P = __builtin_amdgcn_mfma_f32_32x32x16_bf16(t0, p0, P, 0, 0, 0); P = __builtin_amdgcn_mfma_f32_32x32x16_bf16(t1, p1, P, 0, 0, 0); }
                        if (k2 < 4) { const bf16x8 w0 = acc_frag(pw, 0), w1 = acc_frag(pw, 1); f32x16 nw = {}, nT = {};
                            nw = __builtin_amdgcn_mfma_f32_32x32x16_bf16(t0, w0, nw, 0, 0, 0); nw = __builtin_amdgcn_mfma_f32_32x32x16_bf16(t1, w1, nw, 0, 0, 0);
                            nT = __builtin_amdgcn_mfma_f32_32x32x16_bf16(w0, t0, nT, 0, 0, 0); nT = __builtin_amdgcn_mfma_f32_32x32x16_bf16(w1, t1, nT, 0, 0, 0);
                            pw = nw; pT = nT; }
                    }
#pragma unroll
                    for (int r = 0; r < 16; ++r) *(LAS bf16*)(pM + TT + crow(r, hi) * S32 + 2 * l31) = cvt1(P[r]);
                }
            }
        }
        __syncthreads();
    }
#undef RW_LOAD
#undef rm
#undef kt
#undef kk
#undef bb
#undef cs
}
__device__ __forceinline__ void mix_phase(Frame& F, int qword = CW_QUEUE, int only = 0) {
    LAS int* slot = (LAS int*)(F.lds + LDS_BYTES - 64);
    for (;;) {
        __syncthreads();
        if (F.tid == 0) slot[0] = (int)__hip_atomic_fetch_add(F.ctl + qword, 1u, RLX_AGENT);
        __syncthreads();
        const int it = slot[0];
        if (it >= 128 + 512) break;
        if (it < 128 && only == 2) continue;
        if (it >= 128 && only == 1) break;
        if (it < 128) {
#ifndef SKIP_RWKV
            rwkv_unit(F, it >> 4, it & 15, only ? (PROBE_VAR) : 0);
#endif
        }
        else {
            const int u = it - 128;
            const int qb = 7 - (u >> 6), bh = u & 63, b = bh >> 3, h = bh & 7, g = h >> 2;
            const size_t m0 = (size_t)b * SEQ, q0 = (size_t)qb * 256;
#ifndef SKIP_ATT
            att::attn_body<NP, NP, DM, true, ATT_SD>(F.P + (m0 + q0) * NP + C_Q + h * 128, F.P + m0 * NP + C_AK + g * 128, F.P + m0 * NP + C_AV + g * 128,
                                             F.Y + (m0 + q0) * DM + 1024 + h * 128, F.MASK + (m0 + q0) * 64, (int)q0 + 256, (char*)F.lds, F.wv);
#endif
        }
    }
}
__device__ __forceinline__ void cross_phase(Frame& F) {
    for (int u = F.bid; u < NB * 4 * 8; u += F.G) {
        const int b = u >> 5, h = (u >> 3) & 3, qb = u & 7;
        const size_t m0 = (size_t)b * SEQ + (size_t)qb * 256, k0 = (size_t)b * NMEM;
        att::attn_body<512, 1024, 512, false, 2>(F.QC + m0 * 512 + h * 128, F.MEMKV + k0 * 1024 + h * 128, F.MEMKV + k0 * 1024 + 512 + h * 128,
                                              F.OC + m0 * 512 + h * 128, nullptr, NMEM, (char*)F.lds, F.wv);
    }
}

#define XB_TMO      128
#define XB_XCNT(j)  (256  + 64 * (j))
#define XB_XSUB(j)  (1280 + 64 * (j))
#define XB_XGEN(j)  (2304 + 64 * (j))
#define XB_TOP      3328
#define XB_TOPGEN   3392
#define XCD_BAR_WORDS 3456
#define XB_SPIN_CAP (1u << 18)

__device__ __forceinline__ unsigned xb_ld(unsigned* p)              { return __hip_atomic_load(p, __ATOMIC_RELAXED, __HIP_MEMORY_SCOPE_AGENT); }
__device__ __forceinline__ unsigned xb_add(unsigned* p, unsigned v) { return __hip_atomic_fetch_add(p, v, __ATOMIC_RELAXED, __HIP_MEMORY_SCOPE_AGENT); }
__device__ __forceinline__ unsigned xb_xcc_id() { return (unsigned)__builtin_amdgcn_s_getreg((3 << 11) | 20) & 0xFu; }
#define XB_SPIN(cond, bar) do { unsigned _sp = 0; while (cond) { __builtin_amdgcn_s_sleep(1); \
    if ((++_sp & 255u) == 0u) { if (xb_ld(&(bar)[XB_TMO])) break; if (_sp > XB_SPIN_CAP) { atomicAdd(&(bar)[XB_TMO], 1u); break; } } } } while (0)

struct XcdBarrier {
    unsigned* bar; unsigned x;
    volatile LAS unsigned* st;
};

__device__ __forceinline__ XcdBarrier xcd_barrier_post(unsigned* bar, volatile LAS unsigned* st, const bool leader) {
    XcdBarrier b; b.bar = bar; b.x = xb_xcc_id(); b.st = st;
    if (leader) (void)xb_add(&bar[XB_XCNT(b.x)], 1u);
    return b;
}
__device__ __forceinline__ void xcd_barrier_complete(unsigned* bar, unsigned x, unsigned& nloc, unsigned& nx) {
    const unsigned G = gridDim.x * gridDim.y * gridDim.z;
    unsigned sum, cnt, mine, sp = 0u;
    for (;;) {
        sum = 0u; cnt = 0u; mine = 0u;
#pragma unroll
        for (unsigned j = 0; j < 16; ++j) { const unsigned c = xb_ld(&bar[XB_XCNT(j)]); sum += c; cnt += (c > 0u) ? 1u : 0u; mine = (j == x) ? c : mine; }
        if (sum == G) break;
        __builtin_amdgcn_s_sleep(1);
        if ((++sp & 255u) == 0u) { if (xb_ld(&bar[XB_TMO])) break; if (sp > XB_SPIN_CAP) { atomicAdd(&bar[XB_TMO], 1u); break; } }
    }
    nloc = mine > 0u ? mine : 1u; nx = cnt > 0u ? cnt : 1u;
}

__device__ __forceinline__ void xcd_barrier(const XcdBarrier& b, const bool leader) {
    asm volatile("s_waitcnt vmcnt(0)" ::: "memory");
    __syncthreads();
    if (leader) {
        unsigned* bar = b.bar;
        __builtin_amdgcn_s_waitcnt(0);
        unsigned nloc = b.st[0], nx = b.st[1];
        if (nloc == 0u) { xcd_barrier_complete(bar, b.x, nloc, nx); b.st[0] = nloc; b.st[1] = nx; }
        const unsigned old = xb_add(&bar[XB_XSUB(b.x)], 1u);
        const unsigned gen = old / nloc;
        if (old + 1u == (gen + 1u) * nloc) {
            __builtin_amdgcn_fence(__ATOMIC_RELEASE, "agent");
            asm volatile("s_waitcnt vmcnt(0)" ::: "memory");
            const unsigned og = xb_add(&bar[XB_TOP], 1u);
            const unsigned tg = og / nx;
            if (og + 1u == (tg + 1u) * nx) xb_add(&bar[XB_TOPGEN], 1u);
            else XB_SPIN(xb_ld(&bar[XB_TOPGEN]) == tg, bar);
            __builtin_amdgcn_fence(__ATOMIC_ACQUIRE, "agent");
            xb_add(&bar[XB_XGEN(b.x)], 1u);
            asm volatile("s_waitcnt vmcnt(0)" ::: "memory");
        } else {
            XB_SPIN(xb_ld(&bar[XB_XGEN(b.x)]) == gen, bar);
            __builtin_amdgcn_fence(__ATOMIC_ACQUIRE, "agent");
            asm volatile("s_waitcnt vmcnt(0)" ::: "memory");
        }
    }
    __syncthreads();
}

template <typename Tp> __device__ __forceinline__ Tp* inp_ptr(int i) {
    asm volatile("" : "+s"(i));
    typedef __attribute__((address_space(1))) Tp* gptr_t;
    Tp* p = (Tp*)(gptr_t)(((const __attribute__((address_space(4))) unsigned long long*)__builtin_amdgcn_kernarg_segment_ptr())[i]);
    return p;
}
constexpr int N_PHASES = 14;
__global__ void __launch_bounds__(NWAVES * 64, 2) mk_fwd(Args args) {
    extern __shared__ __attribute__((aligned(16))) unsigned char lds[];
    Frame F;
    F.lds = (LAS unsigned char*)lds;
    F.wv = __builtin_amdgcn_readfirstlane((int)threadIdx.x >> 6);
    F.lane = (int)__builtin_amdgcn_mbcnt_hi(~0u, __builtin_amdgcn_mbcnt_lo(~0u, 0u)); F.tid = F.wv * 64 + F.lane; F.wave = F.wv;
    F.G = gridDim.x; F.bid = blockIdx.x;
#define INP(i) inp_ptr<const float>(i)
#define WSP(off) ((bf16*)(inp_ptr<unsigned char>(27) + (off)))
    F.out = inp_ptr<float>(26); F.ctl = (unsigned*)inp_ptr<unsigned char>(27);
    for (int u = F.tid; u < 32; u += NWAVES * 64) ((LAS unsigned*)(F.lds + MISC_OFF))[u] = 0u;
    __syncthreads();
    XcdBarrier bar = xcd_barrier_post(F.ctl + CW_BAR, (volatile LAS unsigned*)(F.lds + MISC_OFF) + 8, F.tid == 0);
    const int lo = args.ph_lo, hi = args.ph_hi;
#ifndef PHMASK
#define PHMASK 0xFFFF
#endif
#define IN(k) ((((PHMASK) >> (k)) & 1) && lo <= (k) && (k) < hi)
#define SEAM(k) do { if (IN(k) && IN((k) + 1)) xcd_barrier(bar, F.wv == 0 && (int)__builtin_amdgcn_mbcnt_hi(~0u, __builtin_amdgcn_mbcnt_lo(~0u, 0u)) == 0); { int t_ = F.wv * 64 + (int)__builtin_amdgcn_mbcnt_hi(~0u, __builtin_amdgcn_mbcnt_lo(~0u, 0u)); asm volatile("" : "+v"(t_)); F.tid = t_; F.lane = t_ & 63; F.wave = F.wv; } } while (0)
#define PRB(k) ((PROBE_PH) == (k) || ((k) == 11 && (PROBE_PH) == 110) || ((k) == 4 && ((PROBE_PH) == 40 || (PROBE_PH) == 41)) || ((k) == 0 && ((PROBE_PH) == 100 || (PROBE_PH) == 101)))
#define REP(k) for (int rep_ = 0; rep_ < (PRB(k) ? 2 : 1); ++rep_, (PRB(k) && rep_ < 2) ? xcd_barrier(bar, F.wv == 0 && (int)__builtin_amdgcn_mbcnt_hi(~0u, __builtin_amdgcn_mbcnt_lo(~0u, 0u)) == 0) : (void)0)
    using pg8::Gemm; using pg8::StaticOrder;
    REP(0) if (IN(0)) {
        F.x = INP(0); F.mem = INP(1); F.norm_mix = INP(3); F.w_in = INP(4); F.wd_up = INP(7); F.a_up = INP(9); F.g_up = INP(10); F.w_mix = INP(16); F.norm_mem = INP(18);
        F.norm_cross = INP(17); F.norm_mlp = INP(22); F.w_q = INP(19); F.w_kv = INP(20); F.w_o = INP(21); F.w_up = INP(23); F.w_dn = INP(24);
        F.WIN = WSP(WS_WIN); F.WMIX = WSP(WS_WMIX); F.WQ = WSP(WS_WQ); F.WKV = WSP(WS_WKV); F.WO = WSP(WS_WO); F.WUP = WSP(WS_WUP); F.WDN = WSP(WS_WDN); F.WL = WSP(WS_WL);
        F.XN = WSP(WS_XN); F.MEMN = WSP(WS_MEMN);
        p0_prologue(F, rep_ ? (PROBE_PH) - 99 : 3); } SEAM(0);
    REP(1) if (IN(1)) {
        F.XN = WSP(WS_XN); F.WIN = WSP(WS_WIN); F.P = WSP(WS_P); F.MEMN = WSP(WS_MEMN); F.WKV = WSP(WS_WKV); F.MEMKV = WSP(WS_MEMKV);
        { Gemm g{F.XN, F.WIN, T, NP, DM}; StaticOrder S; S.init(T, NP, F.G, F.bid, WGM_P1); pg8::EpiB16<0> E{F.P, NP, nullptr, 0.f, 0.f};
          pg8::gemm_phase<pg8::EpiB16<0>, StaticOrder, true, true>(F.lds, g, S, E, F.wv); }
    } SEAM(1);
    if (IN(2)) { F.P = WSP(WS_P); F.AL = WSP(WS_AL); F.pos = (const int*)INP(2); F.mu = INP(5); prep_phase(F); } SEAM(2);
    REP(3) if (IN(3)) {
        F.AL = WSP(WS_AL); F.WL = WSP(WS_WL); F.EWAG = (bf16*)F.out; F.w0 = INP(6); F.a0 = INP(8); F.P = WSP(WS_P); F.MASK = (unsigned*)WSP(WS_MASK);
#ifndef SKIP_LORA
        { int kl = 256; asm volatile("" : "+s"(kl)); Gemm g{F.AL, F.WL, T, NL, kl, KL, 8, 256}; StaticOrder S; S.init(T, NL, F.G, F.bid); pg8::EpiLora E{F.EWAG, NL, F.w0, F.a0};
          pg8::gemm_phase<pg8::EpiLora, StaticOrder, true, true>(F.lds, g, S, E, F.wv); }
#endif
#ifndef SKIP_IDX
#if PROBE_PH == 30
        { int nrep = 2; asm volatile("" : "+s"(nrep)); for (int rp = 0; rp < nrep; ++rp) indexer_phase(F); }
#else
        indexer_phase(F);
#endif
#endif
    } SEAM(3);
    REP(4) if (IN(4)) { F.P = WSP(WS_P); F.EWAG = (bf16*)F.out; F.MASK = (unsigned*)WSP(WS_MASK); F.Y = WSP(WS_Y); F.mu = INP(5); F.k_k = INP(11); F.k_a = INP(12); F.r_k = INP(13);
        F.lnx_w = INP(14); F.lnx_b = INP(15); if (rep_) F.Y = WSP(WS_XN);
        mix_phase(F, CW_QUEUE + 64 * rep_, rep_ ? (PROBE_PH) - 39 : 0); } SEAM(4);
    if (IN(5)) { F.Y = WSP(WS_Y); F.WMIX = WSP(WS_WMIX); F.x = INP(0); F.XN = WSP(WS_XN); Gemm g{F.Y, F.WMIX, T, DM, DM}; StaticOrder S; S.init(T, DM, F.G, F.bid, WGM_P5); pg8::EpiResB<false, false> E{F.x, F.XN, DM, nullptr, (float*)(F.ctl + CW_SS1), 0.f, 0.f};
        pg8::gemm_phase<pg8::EpiResB<false, false>, StaticOrder, true, true>(F.lds, g, S, E, F.wv); } SEAM(5);
    if (IN(7)) { F.XN = WSP(WS_XN); F.WQ = WSP(WS_WQ); F.QC = WSP(WS_QC); Gemm g{F.XN, F.WQ, T, 512, DM}; StaticOrder S; S.init(T, 512, F.G, F.bid); pg8::EpiB16<0, true> E{F.QC, 512, (const float*)(F.ctl + CW_SS1), 1.f / DM, NORM_EPS};
        pg8::gemm_phase<pg8::EpiB16<0, true>, StaticOrder, true, true>(F.lds, g, S, E, F.wv);
        F.MEMN = WSP(WS_MEMN); F.WKV = WSP(WS_WKV); F.MEMKV = WSP(WS_MEMKV);
        { Gemm g{F.MEMN, F.WKV, TM, 1024, DM}; StaticOrder S; S.init(TM, 1024, F.G, (F.bid + F.G / 2) % F.G); pg8::EpiB16<0> E{F.MEMKV, 1024, nullptr, 0.f, 0.f};
          pg8::gemm_phase<pg8::EpiB16<0>, StaticOrder, true, true>(F.lds, g, S, E, F.wv); }
        F.w_up = INP(23); F.w_dn = INP(24); F.norm_mlp = INP(22); F.WUP = WSP(WS_WUP); F.WDN = WSP(WS_WDN);
        p7_mlp_weights(F, 160, F.G - 160);
    } SEAM(7);
    if (IN(8)) { F.QC = WSP(WS_QC); F.MEMKV = WSP(WS_MEMKV); F.OC = WSP(WS_OC); cross_phase(F); } SEAM(8);
    if (IN(9)) { F.OC = WSP(WS_OC); F.WO = WSP(WS_WO); int kl = 512; asm volatile("" : "+s"(kl)); F.XN = WSP(WS_XN); Gemm g{F.OC, F.WO, T, DM, kl}; StaticOrder S; S.init(T, DM, F.G, F.bid); pg8::EpiResB<true, false> E{nullptr, F.XN, DM, nullptr, (float*)(F.ctl + CW_SS2), 0.f, 0.f};
        pg8::gemm_phase<pg8::EpiResB<true, false>, StaticOrder, true, true>(F.lds, g, S, E, F.wv); } SEAM(9);
    REP(11) if (IN(11)) { F.XN = WSP(WS_XN); F.WUP = WSP(WS_WUP); F.ACT = WSP(WS_ACT); Gemm g{F.XN, F.WUP, T, DFF, DM}; StaticOrder S; S.init(T, DFF, F.G, F.bid, WGM_P11); pg8::EpiB16<2, false, true, true> E{F.ACT, DFF, nullptr, 0.f, 0.f};
        #if PROBE_PH == 110
        if (rep_) { pg8::EpiNull EN{}; pg8::gemm_phase<pg8::EpiNull, StaticOrder, true, true>(F.lds, g, S, EN, F.wv); } else
#endif
        pg8::gemm_phase<pg8::EpiB16<2, false, true, true>, StaticOrder, true, true>(F.lds, g, S, E, F.wv); } SEAM(11);
    if (IN(12)) { F.ACT = WSP(WS_ACT); F.WDN = WSP(WS_WDN); F.XN = WSP(WS_XN); F.norm_final = INP(25);
        Gemm g{F.ACT, F.WDN, T, DM, DFF}; pg8::PanelOrder S{F.bid};
        pg8::EpiFinal E{F.XN, DM, (const float*)(F.ctl + CW_SS2), (float*)(F.ctl + CW_SS3), F.ctl + CW_PCNT, F.norm_final, F.out, 1.f / DM, NORM_EPS, F.ctl + CW_TMO};
        pg8::gemm_phase<pg8::EpiFinal, pg8::PanelOrder, true, true, true>(F.lds, g, S, E, F.wv); }
#undef IN
#undef SEAM
}

extern "C" void kernel_launch(void* const* d_in, const int* in_sizes, int n_in, void* d_out, int out_size, void* d_ws, size_t ws_size, hipStream_t stream) {
    static int grid = 0;
    if (grid == 0) {
        if (n_in != 26 || in_sizes[0] != T * DM || out_size != T * DM || ws_size < WS_END) {
            fprintf(stderr, "kernel_launch: unexpected shapes: n_in %d in0 %d out %d ws %zu (need %zu)\n", n_in, n_in > 0 ? in_sizes[0] : -1, out_size, ws_size, (size_t)WS_END); grid = -1; return; }
        int dev = 0, cus = 0, per_cu = 0;
        if (hipGetDevice(&dev) != hipSuccess || hipDeviceGetAttribute(&cus, hipDeviceAttributeMultiprocessorCount, dev) != hipSuccess) { grid = -1; return; }
        if (hipFuncSetAttribute((const void*)mk_fwd, hipFuncAttributeMaxDynamicSharedMemorySize, LDS_BYTES) != hipSuccess) { fprintf(stderr, "kernel_launch: hipFuncSetAttribute failed\n"); grid = -1; return; }
        if (hipOccupancyMaxActiveBlocksPerMultiprocessor(&per_cu, (const void*)mk_fwd, NWAVES * 64, LDS_BYTES) != hipSuccess || per_cu < 1) { fprintf(stderr, "kernel_launch: occupancy query says %d\n", per_cu); per_cu = 1; }
        (void)hipGetLastError();
        grid = cus;
    }
    if (grid < 0) return;
    (void)hipMemsetAsync((char*)d_ws + WS_CTL, 0, CTL_ZERO_BYTES, stream);
    Args a{};
    for (int i = 0; i < 26; ++i) a.in[i] = d_in[i];
    a.out = (float*)d_out; a.ws = (unsigned char*)d_ws;
#if MK_ONE_LAUNCH
    a.ph_lo = 0; a.ph_hi = N_PHASES;
    void* kargs[] = {&a};
    hipError_t e = hipLaunchCooperativeKernel((const void*)mk_fwd, dim3(grid), dim3(NWAVES * 64), kargs, LDS_BYTES, stream);
    if (e != hipSuccess) fprintf(stderr, "kernel_launch: cooperative launch failed: %s (grid %d)\n", hipGetErrorString(e), grid);
#else
    for (int p = 0; p < N_PHASES; ++p) { a.ph_lo = p; a.ph_hi = p + 1; hipLaunchKernelGGL(mk_fwd, dim3(grid), dim3(NWAVES * 64), LDS_BYTES, stream, a); }
#endif
}
```

```cpp
#include <hip/hip_runtime.h>
#include <hip/hip_cooperative_groups.h>
#include <cstdio>
#include <cstdint>
namespace pg8 {
#define PG8_LAS __attribute__((address_space(3)))
typedef unsigned short bf16_t;
typedef short bf16x8 __attribute__((ext_vector_type(8)));
typedef float f32x4 __attribute__((ext_vector_type(4)));
typedef unsigned u32x4 __attribute__((ext_vector_type(4)));
constexpr int BM = 256, BK = 64, HALF = 128, HTB = HALF * BK * 2  , STAGE_BYTES = 8 * HTB, NXCD = 8, WGM = 4;

__host__ __device__ __forceinline__ int lds_byte(int r, int c) { const int st = (r >> 4) * 2 + (c >> 5), rr = r & 15, cc = c & 31, ob = rr * 64 + cc * 2; return st * 1024 + (ob ^ (((ob >> 9) & 1) << 5)); }
__host__ __device__ __forceinline__ void stage_rc(int b, int& R, int& C) { const int st = b / 1024, sb = b % 1024, swz = sb ^ (((sb >> 9) & 1) << 5); R = (st >> 1) * 16 + swz / 64; C = (st & 1) * 32 + (swz % 64) / 2; }
__host__ __device__ __forceinline__ int perm32(int rho) { const int n = rho >> 4, i = rho & 15; return 8 * (i >> 2) + 4 * n + (i & 3); }

struct Unit { int pm, pn; };
struct Gemm { const bf16_t* A; const bf16_t* Bt; int M, N, K; int ld, kpn, kofs; };

struct StaticOrder {
    int nM, nN, nwg, G, c, wgm;
    __host__ __device__ void init(int M, int N, int G_, int c_, int wgm_ = WGM) { nM = M / BM; nN = N / BM; nwg = nM * nN; G = G_; c = c_; wgm = wgm_; }
    __host__ __device__ bool next(int i, Unit& u) const {
        const long L = (long)i * G + c; if (L >= nwg) return false;
        int wgid = (int)L; { const int q = nwg / NXCD, r = nwg % NXCD, xcd = wgid % NXCD, off = wgid / NXCD; wgid = (xcd < r ? xcd * (q + 1) : r * (q + 1) + (xcd - r) * q) + off; }
        const int nig = wgm * nN, gid = wgid / nig, fm = gid * wgm, gsz = (nM - fm) < wgm ? (nM - fm) : wgm;
        u.pm = fm + ((wgid % nig) % gsz); u.pn = (wgid % nig) / gsz; return true;
    }
    __device__ __forceinline__ void a_ready(const Unit&) const {}
    __device__ __forceinline__ void done(const Unit&) const {}
};

__device__ __forceinline__ unsigned cvt_pk_bf16(float lo, float hi) { unsigned r; asm volatile("v_cvt_pk_bf16_f32 %0, %1, %2" : "=v"(r) : "v"(lo), "v"(hi)); return r; }
typedef float f32x2 __attribute__((ext_vector_type(2)));
__device__ __forceinline__ float fq_sum(float v) {
    { auto rr = __builtin_amdgcn_permlane16_swap(__float_as_uint(v), __float_as_uint(v), false, false); v = __uint_as_float(rr[0]) + __uint_as_float(rr[1]); }
    { auto rr = __builtin_amdgcn_permlane32_swap(__float_as_uint(v), __float_as_uint(v), false, false); v = __uint_as_float(rr[0]) + __uint_as_float(rr[1]); }
    return v;
}
__device__ __forceinline__ void xch8(const u32x4 a, const u32x4 b, const bool lo  , u32x4& d0, u32x4& d1) {
#pragma unroll
    for (int i = 0; i < 4; ++i) {
        const unsigned give = lo ? b[i] : a[i];
        const unsigned r = (unsigned)__builtin_amdgcn_update_dpp(0, (int)give, 0x128  , 0xF, 0xF, false);
        d0[i] = lo ? a[i] : r; d1[i] = lo ? r : b[i]; }
}
__device__ __forceinline__ u32x4 pack8(const f32x4 v0, const f32x4 v1) { u32x4 w; w.x = cvt_pk_bf16(v0[0], v0[1]); w.y = cvt_pk_bf16(v0[2], v0[3]); w.z = cvt_pk_bf16(v1[0], v1[1]); w.w = cvt_pk_bf16(v1[2], v1[3]); return w; }
template <int ACT, bool ROWSCALE = false, bool NTS = false, bool BLK = false> struct EpiB16 {
    static constexpr bool PERM = true, AFTER_DRAIN = false;
    bf16_t* O; int ldc; const float* ss; float inv_n, eps;
    __device__ __forceinline__ void operator()(const f32x4 (&acc)[2][2][4][2], const Unit& u, int wr, int wc, int fr, int fq) const {
        const int rowg = u.pm * BM + wr * 64; const bool lo = fr < 8;
        const size_t rst = BLK ? (size_t)64 : (size_t)ldc;
        bf16_t* sp = BLK ? O + ((size_t)(u.pm * (ldc >> 6) + u.pn * 4 + wc) * 256 + wr * 64 + (fr & 7)) * 64 + (fr >> 3) * 32 + 8 * fq
                         : O + (size_t)(rowg + (fr & 7)) * ldc + u.pn * BM + wc * 64 + (fr >> 3) * 32 + 8 * fq;
#pragma unroll
        for (int ai = 0; ai < 2; ++ai)
#pragma unroll
            for (int m = 0; m < 4; ++m) {
                float rs = 1.f; if (ROWSCALE) rs = __builtin_amdgcn_rsqf(ss[rowg + ai * HALF + m * 16 + fr] * inv_n + eps);
                u32x4 w[2];
#pragma unroll
                for (int bj = 0; bj < 2; ++bj) { f32x4 v0 = acc[ai][bj][m][0], v1 = acc[ai][bj][m][1];
                    if (ROWSCALE) { v0 = v0 * rs; v1 = v1 * rs; }
                    if (ACT == 2) {
#pragma unroll
                        for (int i = 0; i < 4; ++i) { const int ia = (int)__float_as_uint(v0[i]), ib = (int)__float_as_uint(v1[i]);
                            const float a = __uint_as_float((unsigned)(ia > 0 ? ia : 0)), b = __uint_as_float((unsigned)(ib > 0 ? ib : 0)); v0[i] = a * a; v1[i] = b * b; } }
                    w[bj] = pack8(v0, v1); }
                u32x4 d0, d1; xch8(w[0], w[1], lo, d0, d1);
                bf16_t* p = sp + (size_t)(ai * HALF + m * 16) * rst;
                if (NTS) { __builtin_nontemporal_store(d0, (u32x4*)p); __builtin_nontemporal_store(d1, (u32x4*)(p + 8 * rst)); }
                else asm volatile("global_store_dwordx4 %0, %1, off sc1\n\tglobal_store_dwordx4 %2, %3, off sc1\n\ts_nop 1" :: "v"(p), "v"(d0), "v"(p + 8 * rst), "v"(d1) : "memory"); }
    }
};
struct EpiLora {
    static constexpr bool PERM = true, AFTER_DRAIN = false;
    bf16_t* O; int ldc; const float* w0; const float* a0;
    __device__ __forceinline__ void operator()(const f32x4 (&acc)[2][2][4][2], const Unit& u, int wr, int wc, int fr, int fq) const {
        const int rowg = u.pm * BM + wr * 64; const bool lo = fr < 8;
        const int type = u.pn >> 2, cb0 = (u.pn & 3) * BM + wc * 64 + 8 * fq;
        const float* bias = (type == 0) ? w0 : a0;
        const float sc = (type == 0) ? 0.6065306597126334f : 1.0f;
        f32x4 bz[2][2] = {{{0.f, 0.f, 0.f, 0.f}, {0.f, 0.f, 0.f, 0.f}}, {{0.f, 0.f, 0.f, 0.f}, {0.f, 0.f, 0.f, 0.f}}};
        if (type < 2) {
#pragma unroll
            for (int bj = 0; bj < 2; ++bj) { bz[bj][0] = *(const f32x4*)(bias + cb0 + bj * 32); bz[bj][1] = *(const f32x4*)(bias + cb0 + bj * 32 + 4); } }
        bf16_t* sp = O + (size_t)(rowg + (fr & 7)) * ldc + u.pn * BM + wc * 64 + (fr >> 3) * 32 + 8 * fq;
#pragma unroll
        for (int ai = 0; ai < 2; ++ai)
#pragma unroll
            for (int m = 0; m < 4; ++m) { u32x4 w[2];
#pragma unroll
                for (int bj = 0; bj < 2; ++bj) {
                    f32x4 v0 = acc[ai][bj][m][0] + bz[bj][0], v1 = acc[ai][bj][m][1] + bz[bj][1];
                    if (type < 2) {
#pragma unroll
                        for (int i = 0; i < 4; ++i) { v0[i] = sc * __builtin_amdgcn_rcpf(1.f + __expf(-v0[i])); v1[i] = sc * __builtin_amdgcn_rcpf(1.f + __expf(-v1[i])); } }
                    w[bj] = pack8(v0, v1); }
                u32x4 d0, d1; xch8(w[0], w[1], lo, d0, d1);
                bf16_t* p = sp + (size_t)(ai * HALF + m * 16) * ldc;
                asm volatile("global_store_dwordx4 %0, %1, off sc1\n\tglobal_store_dwordx4 %2, %3, off sc1\n\ts_nop 1" :: "v"(p), "v"(d0), "v"(p + (size_t)8 * ldc), "v"(d1) : "memory"); }
    }
};
struct EpiNull {
    static constexpr bool PERM = true, AFTER_DRAIN = false;
    __device__ __forceinline__ void operator()(const f32x4 (&acc)[2][2][4][2], const Unit&, int, int, int, int) const {
#pragma unroll
        for (int ai = 0; ai < 2; ++ai)
#pragma unroll
            for (int bj = 0; bj < 2; ++bj)
#pragma unroll
                for (int m = 0; m < 4; ++m)
#pragma unroll
                    for (int n = 0; n < 2; ++n) asm volatile("" :: "v"(acc[ai][bj][m][n]));
    }
};
template <bool RES_BF16, bool SCALE> struct EpiResB {
    static constexpr bool PERM = true, AFTER_DRAIN = false;
    const float* resf; bf16_t* xn; int ldc; const float* ssin; float* ssout; float inv_n, eps;
    __device__ __forceinline__ void operator()(const f32x4 (&acc)[2][2][4][2], const Unit& u, int wr, int wc, int fr, int fq) const {
        const int rowg = u.pm * BM + wr * 64, colw = u.pn * BM + wc * 64; const bool lo = fr < 8;
        bf16_t* sp = xn + (size_t)(rowg + (fr & 7)) * ldc + colw + (fr >> 3) * 32 + 8 * fq;
        const float* lp = resf + (size_t)(rowg + (fr & 7)) * ldc + colw + 8 * fq + (fr >> 3) * 4;
        float sacc = 0.f;
#pragma unroll
        for (int ai = 0; ai < 2; ++ai)
#pragma unroll
            for (int m = 0; m < 4; ++m) { const int row = rowg + ai * HALF + m * 16 + fr; const size_t go = (size_t)(ai * HALF + m * 16) * ldc; float sq = 0.f;
                if (m == 0) sacc = 0.f;
                float s = 1.f; if (SCALE) s = __builtin_amdgcn_rcpf(ssin[row] * inv_n + eps);
                f32x4 r[2][2];
                if (RES_BF16) { const u32x4 L0 = *(const u32x4*)(sp + go), L1 = *(const u32x4*)(sp + go + (size_t)8 * ldc); u32x4 w[2]; xch8(L0, L1, lo, w[0], w[1]);
#pragma unroll
                    for (int bj = 0; bj < 2; ++bj) {
                        r[bj][0] = (f32x4){__builtin_bit_cast(float, w[bj].x << 16), __builtin_bit_cast(float, w[bj].x & 0xffff0000u), __builtin_bit_cast(float, w[bj].y << 16), __builtin_bit_cast(float, w[bj].y & 0xffff0000u)};
                        r[bj][1] = (f32x4){__builtin_bit_cast(float, w[bj].z << 16), __builtin_bit_cast(float, w[bj].z & 0xffff0000u), __builtin_bit_cast(float, w[bj].w << 16), __builtin_bit_cast(float, w[bj].w & 0xffff0000u)}; } }
                else {
#pragma unroll
                    for (int bj = 0; bj < 2; ++bj) { const u32x4 L0 = __builtin_nontemporal_load((const u32x4*)(lp + go + bj * 32)), L1 = __builtin_nontemporal_load((const u32x4*)(lp + go + bj * 32 + (size_t)8 * ldc));
                        u32x4 w0, w1; xch8(L0, L1, lo, w0, w1); r[bj][0] = __builtin_bit_cast(f32x4, w0); r[bj][1] = __builtin_bit_cast(f32x4, w1); } }
                u32x4 wo[2];
#pragma unroll
                for (int bj = 0; bj < 2; ++bj) {
                    const f32x4 o0 = r[bj][0] + acc[ai][bj][m][0] * s, o1 = r[bj][1] + acc[ai][bj][m][1] * s;
                    sq += (o0[0] * o0[0] + o0[1] * o0[1]) + (o0[2] * o0[2] + o0[3] * o0[3]) + (o1[0] * o1[0] + o1[1] * o1[1]) + (o1[2] * o1[2] + o1[3] * o1[3]);
                    wo[bj] = pack8(o0, o1); }
                u32x4 d0, d1; xch8(wo[0], wo[1], lo, d0, d1);
                *(u32x4*)(sp + go) = d0; *(u32x4*)(sp + go + (size_t)8 * ldc) = d1;
                sq = fq_sum(sq);
                sacc = (fq == m) ? sq : sacc;
                if (m == 3) atomicAdd(ssout + rowg + ai * HALF + 16 * fq + fr, sacc);
                asm volatile("" ::: "memory"); }
    }
};
struct PanelOrder {
    int c;
    __device__ __forceinline__ bool next(int i, Unit& u) const { if (i >= 2 || c >= 256) return false; u.pm = 32 * i + (c & 31); u.pn = c >> 5; return true; }
    __device__ __forceinline__ void a_ready(const Unit&) const {}
    __device__ __forceinline__ void done(const Unit&) const {}
};
struct EpiFinal {
    static constexpr bool PERM = true, AFTER_DRAIN = false;
    const bf16_t* xn; int ldc; const float* ssin; float* ss3; unsigned* pcnt; const float* gain; float* out; float inv_n, eps; unsigned* tmo;
    __device__ __forceinline__ void operator()(const f32x4 (&acc_)[2][2][4][2], const Unit& u, int wr, int wc, int fr, int fq) const {
        f32x4 (&acc)[2][2][4][2] = const_cast<f32x4 (&)[2][2][4][2]>(acc_);
        const int row0 = u.pm * BM + wr * 64 + fr, col0 = u.pn * BM + wc * 64 + 8 * fq; const bool lo = fr < 8;
        float sacc = 0.f;
#pragma unroll
        for (int ai = 0; ai < 2; ++ai)
#pragma unroll
            for (int m = 0; m < 4; ++m) { const int row = row0 + ai * HALF + m * 16; float sq = 0.f;
                const float s = __builtin_amdgcn_rcpf(ssin[row] * inv_n + eps);
                const bf16_t* lp = xn + (size_t)(row - fr + (fr & 7)) * ldc + u.pn * BM + wc * 64 + (fr >> 3) * 32 + 8 * fq;
                u32x4 wx[2]; { const u32x4 L0 = *(const u32x4*)lp, L1 = *(const u32x4*)(lp + (size_t)8 * ldc); xch8(L0, L1, lo, wx[0], wx[1]); }
#pragma unroll
                for (int bj = 0; bj < 2; ++bj) { const u32x4 w = wx[bj];
                    const f32x4 r0 = {__builtin_bit_cast(float, w.x << 16), __builtin_bit_cast(float, w.x & 0xffff0000u), __builtin_bit_cast(float, w.y << 16), __builtin_bit_cast(float, w.y & 0xffff0000u)};
                    const f32x4 r1 = {__builtin_bit_cast(float, w.z << 16), __builtin_bit_cast(float, w.z & 0xffff0000u), __builtin_bit_cast(float, w.w << 16), __builtin_bit_cast(float, w.w & 0xffff0000u)};
                    const f32x4 o0 = r0 + acc[ai][bj][m][0] * s, o1 = r1 + acc[ai][bj][m][1] * s; acc[ai][bj][m][0] = o0; acc[ai][bj][m][1] = o1;
                    sq += (o0[0] * o0[0] + o0[1] * o0[1]) + (o0[2] * o0[2] + o0[3] * o0[3]) + (o1[0] * o1[0] + o1[1] * o1[1]) + (o1[2] * o1[2] + o1[3] * o1[3]); }
                sq = fq_sum(sq);
                sacc = (fq == m) ? sq : sacc;
                if (m == 3) atomicAdd(ss3 + row0 - fr + ai * HALF + 16 * fq + fr, sacc);
                asm volatile("" ::: "memory"); }
        asm volatile("s_waitcnt vmcnt(0)" ::: "memory"); __syncthreads();
        unsigned* cw = pcnt + 64 * u.pm;
        if (wr == 0 && wc == 0) {
            if (fr == 0 && fq == 0) __hip_atomic_fetch_add(cw, 1u, __ATOMIC_RELAXED, __HIP_MEMORY_SCOPE_AGENT);
            unsigned spins = 0;
            while ((unsigned)__builtin_amdgcn_readfirstlane(__hip_atomic_load(cw, __ATOMIC_RELAXED, __HIP_MEMORY_SCOPE_AGENT)) < 8u) {
                __builtin_amdgcn_s_sleep(2);
                if (++spins > (1u << 22)) { if (fr == 0 && fq == 0) __hip_atomic_store(tmo, 1u, __ATOMIC_RELAXED, __HIP_MEMORY_SCOPE_AGENT); break; } }
        }
        __syncthreads();
#pragma unroll
        for (int ai = 0; ai < 2; ++ai)
#pragma unroll
            for (int m = 0; m < 4; ++m) { const int row = row0 + ai * HALF + m * 16;
                const float rs = __builtin_amdgcn_rsqf(__hip_atomic_load(ss3 + row, __ATOMIC_RELAXED, __HIP_MEMORY_SCOPE_AGENT) * inv_n + eps);
                float* p = out + (size_t)(row - fr + (fr & 7)) * ldc + col0 + (fr >> 3) * 4;
#pragma unroll
                for (int bj = 0; bj < 2; ++bj) { const f32x4 g0 = *(const f32x4*)(gain + col0 + bj * 32), g1 = *(const f32x4*)(gain + col0 + bj * 32 + 4);
                    const f32x4 y0 = acc[ai][bj][m][0] * rs * g0, y1 = acc[ai][bj][m][1] * rs * g1;
                    u32x4 d0, d1; xch8(__builtin_bit_cast(u32x4, y0), __builtin_bit_cast(u32x4, y1), lo, d0, d1);
                    __builtin_nontemporal_store(d0, (u32x4*)(p + bj * 32));
                    __builtin_nontemporal_store(d1, (u32x4*)(p + bj * 32 + (size_t)8 * ldc)); } }
    }
};
template <class Epi, class Sched, bool ALIGN_EPI = false, bool SP2 = false, bool ABLK = false>
__device__ __forceinline__ void gemm_phase(PG8_LAS unsigned char* lds, const Gemm g, const Sched& S, const Epi& E, const int wv  ) {
    int tid_ = wv * 64 + (int)__builtin_amdgcn_mbcnt_hi(~0u, __builtin_amdgcn_mbcnt_lo(~0u, 0u)); asm volatile("" : "+v"(tid_));
    const int tid = tid_, wid = __builtin_amdgcn_readfirstlane(tid >> 6), lane = tid & 63, wr = wid >> 2, wc = wid & 3, fr = lane & 15, fq = lane >> 4;
    const int K = g.K, nt = K / BK, LD = g.ld ? g.ld : g.K;
    unsigned voffA[2], voffB[2];
#pragma unroll
    for (int i = 0; i < 2; ++i) { int R, C; stage_rc(tid * 16 + i * 8192, R, C); const int Rb = (R >> 5) * 64 + (Epi::PERM ? perm32(R & 31) : (R & 31));
        voffA[i] = (unsigned)(R * (ABLK ? BK : LD) + C) * 2u; voffB[i] = (unsigned)(Rb * LD + C) * 2u; }
    const size_t kstep = (size_t)(BK * 2);
    const size_t hstep = (size_t)HALF * LD * 2;
    const size_t tstep = 2 * hstep;
    const size_t kstepA = ABLK ? (size_t)BM * BK * 2 : kstep, hstepA = ABLK ? (size_t)HALF * BK * 2 : hstep, tstepA = ABLK ? (size_t)(K / BK) * kstepA : tstep;
    const size_t hstepB = (size_t)32 * LD * 2;
    const unsigned ldsw = (unsigned)wid * 1024u;
    const int aoff = lds_byte(wr * 64 + fr, fq * 8), boff = lds_byte(wc * 32 + fr, fq * 8);
#define PG8_SA(b, h) (((b) * 2 + (h)) * HTB)
#define PG8_SB(b, h) ((4 + (b) * 2 + (h)) * HTB)
#define PG8_STAGE(bufoff, gbase, voff) do { _Pragma("unroll") for (int _i = 0; _i < 2; ++_i) \
        __builtin_amdgcn_global_load_lds((const unsigned*)((const char*)(gbase) + (voff)[_i]), (PG8_LAS unsigned*)(lds + (bufoff) + ldsw + _i * 8192), 16, 0, 0); } while (0)
#define PG8_LDA(dst, b, h) do { _Pragma("unroll") for (int m = 0; m < 4; ++m) _Pragma("unroll") for (int k = 0; k < 2; ++k) dst[m][k] = *(const PG8_LAS bf16x8*)(lds + PG8_SA(b, h) + aoff + m * 2048 + k * 1024); } while (0)
#define PG8_LDB(dst, b, h) do { _Pragma("unroll") for (int n = 0; n < 2; ++n) _Pragma("unroll") for (int k = 0; k < 2; ++k) dst[n][k] = *(const PG8_LAS bf16x8*)(lds + PG8_SB(b, h) + boff + n * 2048 + k * 1024); } while (0)
#define PG8_MMA(ai, bj, At, Bt) do { __builtin_amdgcn_s_setprio(1); _Pragma("unroll") for (int m = 0; m < 4; ++m) _Pragma("unroll") for (int n = 0; n < 2; ++n) _Pragma("unroll") for (int k = 0; k < 2; ++k) \
        acc[ai][bj][m][n] = __builtin_amdgcn_mfma_f32_16x16x32_bf16(Bt[n][k], At[m][k], acc[ai][bj][m][n], 0, 0, 0); __builtin_amdgcn_s_setprio(0); } while (0)
#define PG8_WAIT_V(n) asm volatile("s_waitcnt vmcnt(" #n ")" ::: "memory")
#define PG8_WAIT_L(n) asm volatile("s_waitcnt lgkmcnt(" #n ")" ::: "memory")
#define PG8_BAR __builtin_amdgcn_s_barrier()
#define PG8_SCHED __builtin_amdgcn_sched_barrier(0)
    Unit cur, nxt; int ui = 0;
    if (!S.next(0, cur)) return;
    f32x4 acc[2][2][4][2];
#pragma unroll
    for (int a = 0; a < 2; ++a)
#pragma unroll
        for (int b = 0; b < 2; ++b)
#pragma unroll
            for (int m = 0; m < 4; ++m)
#pragma unroll
                for (int n = 0; n < 2; ++n) acc[a][b][m][n] = (f32x4){0.f, 0.f, 0.f, 0.f};
    bf16x8 At[4][2], B0[2][2], B1[2][2];
#define PG8_KOF(u) ((size_t)((g.kofs && (u).pn >= g.kpn) ? g.kofs : 0))
    const char* cA = (const char*)g.A + (size_t)cur.pm * tstepA + PG8_KOF(cur); const char* cB = (const char*)g.Bt + (size_t)cur.pn * tstep + PG8_KOF(cur);
    S.a_ready(cur);
    if constexpr (SP2) {
        PG8_STAGE(PG8_SB(0, 0), cB, voffB); PG8_STAGE(PG8_SB(0, 1), cB + hstepB, voffB); PG8_STAGE(PG8_SA(0, 0), cA, voffA); PG8_STAGE(PG8_SA(0, 1), cA + hstepA, voffA);
        if (wr == 1) PG8_BAR;
        PG8_WAIT_V(2); PG8_BAR;
        PG8_STAGE(PG8_SB(1, 0), cB + kstep, voffB); PG8_STAGE(PG8_SA(1, 0), cA + kstepA, voffA); PG8_STAGE(PG8_SB(1, 1), cB + hstepB + kstep, voffB);
        PG8_WAIT_V(6); PG8_BAR;
    } else {
        PG8_STAGE(PG8_SB(0, 0), cB, voffB); PG8_STAGE(PG8_SA(0, 0), cA, voffA); PG8_STAGE(PG8_SB(0, 1), cB + hstepB, voffB); PG8_STAGE(PG8_SA(0, 1), cA + hstepA, voffA);
        if (wr == 1) PG8_BAR;
        PG8_WAIT_V(4); PG8_BAR;
        PG8_STAGE(PG8_SB(1, 0), cB + kstep, voffB); PG8_STAGE(PG8_SA(1, 0), cA + kstepA, voffA); PG8_STAGE(PG8_SB(1, 1), cB + hstepB + kstep, voffB);
        PG8_WAIT_V(6); PG8_BAR;
    }
    for (;;) {
        const bool has_next = S.next(ui + 1, nxt);
        const char* nA = has_next ? (const char*)g.A + (size_t)nxt.pm * tstepA + PG8_KOF(nxt) : cA; const char* nB = has_next ? (const char*)g.Bt + (size_t)nxt.pn * tstep + PG8_KOF(nxt) : cB;
        for (int t = 0; t < nt; t += 2) {
            const bool last = (t == nt - 2);
            const char* a1 = cA + (size_t)(t + 1) * kstepA;
            const char* a2 = last ? nA : cA + (size_t)(t + 2) * kstepA; const char* b2 = last ? nB : cB + (size_t)(t + 2) * kstep;
            const char* a3 = a2 + kstepA; const char* b3 = b2 + kstep;
            if (last && has_next) S.a_ready(nxt);
            if constexpr (SP2) {
            PG8_LDB(B0, 0, 0); PG8_LDB(B1, 0, 1); PG8_SCHED; PG8_LDA(At, 0, 0); PG8_STAGE(PG8_SA(1, 1), a1 + hstepA, voffA);
            PG8_WAIT_V(8); PG8_WAIT_L(0); PG8_BAR; PG8_MMA(0, 0, At, B0); PG8_MMA(0, 1, At, B1); PG8_BAR; PG8_SCHED;
            PG8_LDA(At, 0, 1); PG8_STAGE(PG8_SB(0, 0), b2, voffB); PG8_STAGE(PG8_SB(0, 1), b2 + hstepB, voffB); PG8_STAGE(PG8_SA(0, 0), a2, voffA);
            PG8_WAIT_V(8); PG8_WAIT_L(0); PG8_BAR; PG8_MMA(1, 0, At, B0); PG8_MMA(1, 1, At, B1); PG8_BAR; PG8_SCHED;
            PG8_LDB(B0, 1, 0); PG8_LDB(B1, 1, 1); PG8_SCHED; PG8_LDA(At, 1, 0); PG8_STAGE(PG8_SA(0, 1), a2 + hstepA, voffA);
            PG8_WAIT_V(8); PG8_WAIT_L(0); PG8_BAR; PG8_MMA(0, 0, At, B0); PG8_MMA(0, 1, At, B1); PG8_BAR; PG8_SCHED;
            PG8_LDA(At, 1, 1); PG8_STAGE(PG8_SB(1, 0), b3, voffB); PG8_STAGE(PG8_SB(1, 1), b3 + hstepB, voffB); PG8_STAGE(PG8_SA(1, 0), a3, voffA);
            PG8_WAIT_V(8); PG8_WAIT_L(0); PG8_BAR; PG8_MMA(1, 0, At, B0); PG8_MMA(1, 1, At, B1); PG8_BAR; PG8_SCHED;
            } else {
            PG8_LDB(B0, 0, 0); PG8_SCHED; PG8_LDA(At, 0, 0); PG8_STAGE(PG8_SA(1, 1), a1 + hstepA, voffA);
            PG8_WAIT_L(8); PG8_BAR; PG8_WAIT_L(0); PG8_MMA(0, 0, At, B0); PG8_BAR; PG8_SCHED;
            PG8_LDB(B1, 0, 1); PG8_STAGE(PG8_SB(0, 0), b2, voffB);
            PG8_BAR; PG8_WAIT_L(0); PG8_MMA(0, 1, At, B1); PG8_BAR;
            PG8_LDA(At, 0, 1); PG8_STAGE(PG8_SA(0, 0), a2, voffA);
            PG8_BAR; PG8_WAIT_L(0); PG8_MMA(1, 0, At, B0); PG8_BAR; PG8_SCHED;
            PG8_STAGE(PG8_SB(0, 1), b2 + hstepB, voffB);
            PG8_WAIT_V(6); PG8_BAR; PG8_MMA(1, 1, At, B1); PG8_BAR;
            PG8_LDB(B0, 1, 0); PG8_SCHED; PG8_LDA(At, 1, 0); PG8_STAGE(PG8_SA(0, 1), a2 + hstepA, voffA);
            PG8_WAIT_L(8); PG8_BAR; PG8_WAIT_L(0); PG8_MMA(0, 0, At, B0); PG8_BAR; PG8_SCHED;
            PG8_LDB(B1, 1, 1); PG8_STAGE(PG8_SB(1, 0), b3, voffB);
            PG8_BAR; PG8_WAIT_L(0); PG8_MMA(0, 1, At, B1); PG8_BAR;
            PG8_LDA(At, 1, 1); PG8_STAGE(PG8_SA(1, 0), a3, voffA);
            PG8_BAR; PG8_WAIT_L(0); PG8_MMA(1, 0, At, B0); PG8_BAR; PG8_SCHED;
            PG8_STAGE(PG8_SB(1, 1), b3 + hstepB, voffB);
            PG8_WAIT_V(6); PG8_BAR; PG8_MMA(1, 1, At, B1); PG8_BAR;
            }
        }
        if constexpr (ALIGN_EPI) { if (wr == 0) PG8_BAR; }
        if constexpr (!Epi::AFTER_DRAIN) { E(acc, cur, wr, wc, fr, fq); S.done(cur); }
        if (!has_next) break;
#pragma unroll
        for (int a = 0; a < 2; ++a)
#pragma unroll
            for (int b = 0; b < 2; ++b)
#pragma unroll
                for (int m = 0; m < 4; ++m)
#pragma unroll
                    for (int n = 0; n < 2; ++n) acc[a][b][m][n] = (f32x4){0.f, 0.f, 0.f, 0.f};
        cur = nxt; cA = nA; cB = nB; ++ui;
        if constexpr (ALIGN_EPI) { if (wr == 1) PG8_BAR; }
    }
    PG8_WAIT_V(0);
    if constexpr (!ALIGN_EPI) { if (wr == 0) PG8_BAR; }
    PG8_BAR;
    if constexpr (Epi::AFTER_DRAIN) { E.fused(acc, cur, wr, wc, fr, fq, lds, wid, lane); S.done(cur); }
#undef PG8_KOF
#undef PG8_SA
#undef PG8_SB
#undef PG8_STAGE
#undef PG8_LDA
#undef PG8_LDB
#undef PG8_MMA
#undef PG8_WAIT_V
#undef PG8_WAIT_L
#undef PG8_BAR
#undef PG8_SCHED
}
}
namespace att {
typedef unsigned short bf16;
constexpr int   D = 128, NW = 8, QBLK = 32, KVBLK = 64;
constexpr float SCALE = 0.088388347648318440f;
constexpr float THR = 8.f;
constexpr size_t SHM_V = KVBLK * D * 2, SHM_K = KVBLK * D * 2, SHM_ATTN = 2 * SHM_V + 2 * SHM_K + NW * 64 * 4;
using bf16x8 = __attribute__((ext_vector_type(8))) short;
using s16x4  = __attribute__((ext_vector_type(4))) short;
using f32x16 = __attribute__((ext_vector_type(16))) float;
using u32x4  = __attribute__((ext_vector_type(4))) unsigned;
using u32x2  = __attribute__((ext_vector_type(2))) unsigned;
#define KSWZ(row, colB) ((row) * 256 + ((colB) ^ (((row) & 7) << 4)))
#define SBAR() __builtin_amdgcn_sched_barrier(0)
__device__ __forceinline__ int crow(int r, int hi) { return (r & 3) + 8 * (r >> 2) + 4 * hi; }
__device__ __forceinline__ unsigned cvtpk(float lo, float hi) { unsigned r; asm volatile("v_cvt_pk_bf16_f32 %0, %1, %2" : "=v"(r) : "v"(lo), "v"(hi)); return r; }
__device__ __forceinline__ void mask16(f32x16& p, unsigned mw) {
#pragma unroll
  for (int r = 0; r < 16; ++r) { const int cr = (r & 3) + 8 * (r >> 2); const int m = __builtin_amdgcn_sbfe((int)mw, cr, 1); p[r] = __uint_as_float(__float_as_uint(p[r]) & (unsigned)m); }
}
template <bool MASKED>
__device__ __forceinline__ void partialSM(f32x16& p0, f32x16& p1, float& m_reg, float& mn, float& alpha) {
  constexpr float C = SCALE * 1.4426950408889634f;
  float pmax = p0[0];
#pragma unroll
  for (int r = 1; r < 16; ++r) pmax = fmaxf(pmax, p0[r]);
#pragma unroll
  for (int r = 0; r < 16; ++r) pmax = fmaxf(pmax, p1[r]);
  { auto rr = __builtin_amdgcn_permlane32_swap(__float_as_uint(pmax), __float_as_uint(pmax), false, false);
    pmax = fmaxf(__uint_as_float(rr[0]), __uint_as_float(rr[1])); }
  if (__builtin_expect(__all(pmax - m_reg <= THR / SCALE), 1)) { mn = m_reg; alpha = 1.f; }
  else { mn = fmaxf(m_reg, pmax); alpha = __builtin_amdgcn_exp2f((m_reg - mn) * C); m_reg = mn; }
  float mnC = -mn * C;
#pragma unroll
  for (int r = 0; r < 16; ++r) p0[r] = fmaf(p0[r], C, mnC);
#pragma unroll
  for (int r = 0; r < 16; ++r) p1[r] = fmaf(p1[r], C, mnC);
#pragma unroll
  for (int r = 0; r < 16; ++r) p0[r] = __builtin_amdgcn_exp2f(p0[r]);
}
template <bool MASKED>
__device__ __forceinline__ void finishSM(f32x16& p0, f32x16& p1, float alpha, float& l_reg, bf16x8& pa0, bf16x8& pa1, bf16x8& pa2, bf16x8& pa3, unsigned mw0, unsigned mw1) {
#pragma unroll
  for (int r = 0; r < 16; ++r) p1[r] = __builtin_amdgcn_exp2f(p1[r]);
  if (MASKED) { mask16(p0, mw0); mask16(p1, mw1); }
  float ps = 0;
#pragma unroll
  for (int r = 0; r < 16; ++r) ps += p0[r];
#pragma unroll
  for (int r = 0; r < 16; ++r) ps += p1[r];
  { auto rr = __builtin_amdgcn_permlane32_swap(__float_as_uint(ps), __float_as_uint(ps), false, false);
    ps = __uint_as_float(rr[0]) + __uint_as_float(rr[1]); }
  l_reg = l_reg * alpha + ps;
#define PK4(P, BASE, OUT) do { unsigned a0 = cvtpk(P[BASE + 0], P[BASE + 1]), a1 = cvtpk(P[BASE + 2], P[BASE + 3]);   \
    unsigned b0 = cvtpk(P[BASE + 4], P[BASE + 5]), b1 = cvtpk(P[BASE + 6], P[BASE + 7]);                              \
    auto r0 = __builtin_amdgcn_permlane32_swap(a0, b0, false, false); auto r1 = __builtin_amdgcn_permlane32_swap(a1, b1, false, false); \
    u32x4 w = {r0[0], r1[0], r0[1], r1[1]}; OUT = *reinterpret_cast<bf16x8*>(&w); } while (0)
  PK4(p0, 0, pa0); PK4(p0, 8, pa1); PK4(p1, 0, pa2); PK4(p1, 8, pa3);
#undef PK4
}
__device__ __forceinline__ void qkt(f32x16& p0, f32x16& p1, const bf16* Ks, const bf16x8* qr, int r32, int hi) {
  p0 = f32x16{}; p1 = f32x16{};
#pragma unroll
  for (int d0 = 0; d0 < 8; ++d0) { int cb = (d0 * 16 + hi * 8) * 2;
    bf16x8 b0 = *reinterpret_cast<const bf16x8*>((const char*)Ks + KSWZ(r32, cb));
    bf16x8 b1 = *reinterpret_cast<const bf16x8*>((const char*)Ks + KSWZ(32 + r32, cb));
    p0 = __builtin_amdgcn_mfma_f32_32x32x16_bf16(b0, qr[d0], p0, 0, 0, 0);
    p1 = __builtin_amdgcn_mfma_f32_32x32x16_bf16(b1, qr[d0], p1, 0, 0, 0); }
}
__device__ __forceinline__ int v_st(int k, int c) { const int kk = (k & ~0xC) | ((k & 4) << 1) | ((k & 8) >> 1); return ((kk >> 3) * 4 + (c >> 5)) * 512 + ((kk & 7) * 32 + (c & 31)) * 2; }
__device__ __forceinline__ int v_rd_base(int lane) { return ((lane & 3) << 3) | (((lane >> 2) & 3) << 6) | (((lane >> 4) & 1) << 5) | (((lane >> 5) & 1) << 8); }
constexpr int v_rd_off(int d0, int ks, int half) { return d0 * 512 + ks * 4096 + half * 2048; }
template <int OFF> __device__ __forceinline__ s16x4 tr_read(int vb) {
  s16x4 r; asm volatile("ds_read_b64_tr_b16 %0, %1 offset:%2" : "=&v"(r) : "v"(vb), "i"(OFF) : "memory"); return r;
}
template <int D0> __device__ __forceinline__ void pv_one(f32x16& od, int vb, bf16x8 pa0, bf16x8 pa1, bf16x8 pa2, bf16x8 pa3) {
  const s16x4 l0 = tr_read<v_rd_off(D0, 0, 0)>(vb), h0 = tr_read<v_rd_off(D0, 0, 1)>(vb), l1 = tr_read<v_rd_off(D0, 1, 0)>(vb), h1 = tr_read<v_rd_off(D0, 1, 1)>(vb);
  const s16x4 l2 = tr_read<v_rd_off(D0, 2, 0)>(vb), h2 = tr_read<v_rd_off(D0, 2, 1)>(vb), l3 = tr_read<v_rd_off(D0, 3, 0)>(vb), h3 = tr_read<v_rd_off(D0, 3, 1)>(vb);
  asm volatile("s_waitcnt lgkmcnt(0)" ::: "memory"); SBAR();
#define PK(L, H) (bf16x8){L[0], L[1], L[2], L[3], H[0], H[1], H[2], H[3]}
  od = __builtin_amdgcn_mfma_f32_32x32x16_bf16(pa0, PK(l0, h0), od, 0, 0, 0);
  od = __builtin_amdgcn_mfma_f32_32x32x16_bf16(pa1, PK(l1, h1), od, 0, 0, 0);
  od = __builtin_amdgcn_mfma_f32_32x32x16_bf16(pa2, PK(l2, h2), od, 0, 0, 0);
  od = __builtin_amdgcn_mfma_f32_32x32x16_bf16(pa3, PK(l3, h3), od, 0, 0, 0);
#undef PK
}
__device__ __forceinline__ void pv_d0(f32x16* o, int vb, bf16x8 pa0, bf16x8 pa1, bf16x8 pa2, bf16x8 pa3) {
  pv_one<0>(o[0], vb, pa0, pa1, pa2, pa3); pv_one<1>(o[1], vb, pa0, pa1, pa2, pa3); pv_one<2>(o[2], vb, pa0, pa1, pa2, pa3); pv_one<3>(o[3], vb, pa0, pa1, pa2, pa3);
}
template <int LDQ, int LDK, int LDO, bool MASKED, int SDEPTH, bool G4 = false>
__device__ __forceinline__ void attn_body(const bf16* __restrict__ Qb, const bf16* __restrict__ Kh, const bf16* __restrict__ Vh,
                                          bf16* __restrict__ Ob, const unsigned* __restrict__ mrow0, int seq, char* lds, const int wv, unsigned* qctr = nullptr, int* qslot = nullptr, const int qbase = 0) {
  int tid_ = wv * 64 + (int)__builtin_amdgcn_mbcnt_hi(~0u, __builtin_amdgcn_mbcnt_lo(~0u, 0u)); asm volatile("" : "+v"(tid_));
  const int tid = tid_, wid = tid >> 6, lane = tid & 63, r32 = lane & 31, hi = lane >> 5;
  bf16* V_lds = (bf16*)lds; bf16* K_lds = (bf16*)(lds + 2 * SHM_V);
  float* ws = (float*)(lds + 2 * SHM_V + 2 * SHM_K) + wid * 64; float* li_l = ws; float* al_l = ws + 32;
  float m_reg = -1e30f, l_reg = 0; f32x16 o[4] = {}; bf16x8 qr[8];
  const int wq0 = G4 ? (wid & 1) * QBLK : wid * QBLK, whd = G4 ? (wid >> 1) * 128 : 0;
  const bf16* Qw = Qb + (long)(wq0 + r32) * LDQ + whd + hi * 8;
#pragma unroll
  for (int d0 = 0; d0 < 8; ++d0) qr[d0] = *reinterpret_cast<const bf16x8*>(Qw + d0 * 16);
  const int msh = 4 * hi;
  u32x2* mlds = (u32x2*)(lds + SHM_ATTN);
  const int mro = (wq0 + r32) * 33;
#define MLOAD(j) (MASKED ? mlds[mro + (j)] : (u32x2){0u, 0u})
  const int sr = tid >> 4, sc = (tid & 15) * 8, vst0 = v_st(sr, sc), vst1 = v_st(32 + sr, sc);
  const int vb0 = (int)(uintptr_t)V_lds + v_rd_base(lane);
  struct { bf16x8 vs0, vs1, ks0, ks1; } sr_[SDEPTH];
#define SLOAD(i, k0) do { sr_[i].vs0 = *reinterpret_cast<const bf16x8*>(&Vh[(long)((k0) + sr) * LDK + sc]); sr_[i].vs1 = *reinterpret_cast<const bf16x8*>(&Vh[(long)((k0) + 32 + sr) * LDK + sc]); \
    sr_[i].ks0 = *reinterpret_cast<const bf16x8*>(&Kh[(long)((k0) + sr) * LDK + sc]); sr_[i].ks1 = *reinterpret_cast<const bf16x8*>(&Kh[(long)((k0) + 32 + sr) * LDK + sc]); } while (0)
#define SWRITE(b, i) do { *(bf16x8*)((char*)V_lds + (b) * SHM_V + vst0) = sr_[i].vs0;          \
    *(bf16x8*)((char*)V_lds + (b) * SHM_V + vst1) = sr_[i].vs1; int kc = sc * 2;               \
    *(bf16x8*)((char*)K_lds + (b) * SHM_K + KSWZ(sr, kc)) = sr_[i].ks0;                       \
    *(bf16x8*)((char*)K_lds + (b) * SHM_K + KSWZ(32 + sr, kc)) = sr_[i].ks1; } while (0)
#define SWAIT() do { if constexpr (SDEPTH == 2) asm volatile("s_waitcnt vmcnt(4)" ::: "memory"); else asm volatile("s_waitcnt vmcnt(0)" ::: "memory"); } while (0)
#define RESC(a) do { if (__any((a) < 1.f)) { if (hi == 0) al_l[r32] = (a); asm volatile("s_waitcnt lgkmcnt(0)" ::: "memory"); \
    _Pragma("unroll") for (int d = 0; d < 4; ++d) _Pragma("unroll") for (int r = 0; r < 16; ++r) o[d][r] *= al_l[crow(r, hi)]; } } while (0)
  f32x16 pA0, pA1, pB0, pB1; float mnA, mnB, alA, alB; bf16x8 pa0, pa1, pa2, pa3; const int NT = seq / KVBLK;
  u32x2 mwA, mwB;
  constexpr int SE = 0, SO = SDEPTH - 1;
  if constexpr (SDEPTH == 2) {
    int nxt_item = -1; if (qctr && tid == 0) nxt_item = qbase + (int)__hip_atomic_fetch_add(qctr, 1u, __ATOMIC_RELAXED, __HIP_MEMORY_SCOPE_AGENT);
    SLOAD(SE, 0); SLOAD(SO, KVBLK);
    if (MASKED) {
#pragma unroll 4
      for (int i = 0; i < (G4 ? 4 : 16); ++i) { const int idx = tid + 512 * i; mlds[(idx >> 5) * 33 + (idx & 31)] = *reinterpret_cast<const u32x2*>(mrow0 + 2 * idx); }
    }
    asm volatile("s_waitcnt vmcnt(4)" ::: "memory"); SWRITE(0, SE); if (qctr && tid == 0) *qslot = nxt_item; __syncthreads();
    qkt(pA0, pA1, K_lds, qr, r32, hi); partialSM<MASKED>(pA0, pA1, m_reg, mnA, alA);
    if (2 < NT) SLOAD(SE, 2 * KVBLK);
    SWAIT(); SWRITE(1, SO); __syncthreads();
  } else {
    if (MASKED) {
#pragma unroll 4
      for (int i = 0; i < (G4 ? 4 : 16); ++i) { const int idx = tid + 512 * i; mlds[(idx >> 5) * 33 + (idx & 31)] = *reinterpret_cast<const u32x2*>(mrow0 + 2 * idx); }
    }
    SLOAD(SE, 0); asm volatile("s_waitcnt vmcnt(0)" ::: "memory"); SWRITE(0, SE); __syncthreads();
    qkt(pA0, pA1, K_lds, qr, r32, hi); partialSM<MASKED>(pA0, pA1, m_reg, mnA, alA);
    SLOAD(SO, KVBLK);
    SWAIT(); SWRITE(1, SO); __syncthreads();
  }
  for (int j = 1; j + 1 < NT; j += 2) {
    mwA = MLOAD(j - 1);
    SBAR(); qkt(pB0, pB1, (bf16*)((char*)K_lds + SHM_K), qr, r32, hi);
    finishSM<MASKED>(pA0, pA1, alA, l_reg, pa0, pa1, pa2, pa3, mwA[0] >> msh, mwA[1] >> msh); SBAR();
    SLOAD(SO, (j + SDEPTH) * KVBLK); SBAR();
    pv_d0(o, vb0, pa0, pa1, pa2, pa3); partialSM<MASKED>(pB0, pB1, m_reg, mnB, alB);
    __syncthreads(); SWAIT(); SWRITE(0, SE);
    RESC(alB); __syncthreads();
    mwB = MLOAD(j);
    SBAR(); qkt(pA0, pA1, K_lds, qr, r32, hi);
    finishSM<MASKED>(pB0, pB1, alB, l_reg, pa0, pa1, pa2, pa3, mwB[0] >> msh, mwB[1] >> msh); SBAR();
    if (SDEPTH == 1 || j + 3 < NT) SLOAD(SE, (j + 1 + SDEPTH) * KVBLK); SBAR();
    pv_d0(o, vb0 + (int)SHM_V, pa0, pa1, pa2, pa3); partialSM<MASKED>(pA0, pA1, m_reg, mnA, alA);
    __syncthreads(); SWAIT(); SWRITE(1, SO);
    RESC(alA); __syncthreads();
  }
  mwA = MLOAD(NT - 2);
  SBAR(); qkt(pB0, pB1, (bf16*)((char*)K_lds + SHM_K), qr, r32, hi);
  finishSM<MASKED>(pA0, pA1, alA, l_reg, pa0, pa1, pa2, pa3, mwA[0] >> msh, mwA[1] >> msh); SBAR();
  pv_d0(o, vb0, pa0, pa1, pa2, pa3); partialSM<MASKED>(pB0, pB1, m_reg, mnB, alB);
  __syncthreads(); RESC(alB);
  mwB = MLOAD(NT - 1);
  finishSM<MASKED>(pB0, pB1, alB, l_reg, pa0, pa1, pa2, pa3, mwB[0] >> msh, mwB[1] >> msh); SBAR();
  pv_d0(o, vb0 + (int)SHM_V, pa0, pa1, pa2, pa3);
  if (hi == 0) li_l[r32] = l_reg; asm volatile("s_waitcnt lgkmcnt(0)" ::: "memory");
  float rli[16];
#pragma unroll
  for (int r = 0; r < 16; ++r) rli[r] = __builtin_amdgcn_rcpf(li_l[crow(r, hi)]);
  int ln = lane; asm volatile("" : "+v"(ln));
  unsigned short* ost = (unsigned short*)((char*)mlds + (size_t)((G4 ? 64 : 0) + wid * QBLK) * 264);
  { unsigned short* ow_ = ost + (ln >> 5) * (4 * 132) + (ln & 31);
#pragma unroll
  for (int r = 0; r < 16; ++r) { const int orow = crow(r, 0);
#pragma unroll
    for (int d0 = 0; d0 < 4; ++d0) { const float v = o[d0][r] * rli[r]; unsigned u = __float_as_uint(v); u = (u + 0x7fffu + ((u >> 16) & 1u)) >> 16;
      ow_[orow * 132 + d0 * 32] = (unsigned short)u; } } }
  asm volatile("s_waitcnt lgkmcnt(0)" ::: "memory");
  bf16* Ow = Ob + (long)wq0 * LDO + whd;
#pragma unroll
  for (int k = 0; k < 8; ++k) { const int orow = 4 * k + (ln >> 4), ch = ln & 15;
    const u32x2 lo2 = *reinterpret_cast<const u32x2*>(ost + orow * 132 + ch * 8), hi2 = *reinterpret_cast<const u32x2*>(ost + orow * 132 + ch * 8 + 4);
    u32x4 w; w.x = lo2[0]; w.y = lo2[1]; w.z = hi2[0]; w.w = hi2[1];
    if (!MASKED) asm volatile("global_store_dwordx4 %0, %1, off sc1\n\ts_nop 1" :: "v"(Ow + (long)orow * LDO + ch * 8), "v"(w) : "memory");
    else *reinterpret_cast<u32x4*>(Ow + (long)orow * LDO + ch * 8) = w; }
  __syncthreads();
#undef SLOAD
#undef SWRITE
#undef SWAIT
#undef RESC
#undef MLOAD
}
#undef KSWZ
#undef SBAR
}
namespace cg = cooperative_groups;
constexpr int NWAVES = 8;
#ifndef WGM_P1
#define WGM_P1 4
#endif
#ifndef WGM_P11
#define WGM_P11 4
#endif
#ifndef WGM_P5
#define WGM_P5 2
#endif
#ifndef PROBE_PH
#define PROBE_PH -1
#endif
#ifndef ATT_SD
#define ATT_SD 2
#endif
#ifndef MK_ONE_LAUNCH
#define MK_ONE_LAUNCH 1
#endif
constexpr int NB = 8, SEQ = 2048, DM = 2048, T = NB * SEQ, NMEM = 256, TM = NB * NMEM;
constexpr int NIN = 6000, NP = 6144;
constexpr int C_R = 0, C_K = 1024, C_V = 2048, C_XW = 3072, C_XA = 3136, C_XG = 3200, C_Q = 3360, C_AK = 4384, C_AV = 4640, C_QI = 4896, C_KI = 5920, C_WI = 5984;
constexpr int DFF = 8192, NL = 3072, KL = 384;
constexpr float NORM_EPS = 1e-5f, RWKV_LN_EPS = 64e-5f;
constexpr size_t MiB = 1u << 20;
constexpr size_t WS_CTL = 0, CTL_ZERO_BYTES = 384 * 1024;
constexpr size_t WS_WIN = 2 * MiB, WS_WMIX = 26 * MiB, WS_WQ = 34 * MiB, WS_WKV = 36 * MiB, WS_WO = 40 * MiB, WS_WUP = 42 * MiB, WS_WDN = 74 * MiB, WS_WL = 106 * MiB;
constexpr size_t WS_XN = 110 * MiB, WS_MEMN = 174 * MiB, WS_MEMKV = 182 * MiB, WS_AL = 186 * MiB, WS_MASK = 198 * MiB, WS_QC = 202 * MiB, WS_OC = 218 * MiB;
constexpr size_t WS_Y = 236 * MiB, WS_P = 300 * MiB, WS_ACT = 236 * MiB, WS_END = 492 * MiB;
static_assert(WS_WL + (size_t)NL * KL * 2 <= WS_XN && WS_AL + (size_t)T * KL * 2 <= WS_MASK && WS_P + (size_t)T * NP * 2 <= WS_END && WS_ACT + (size_t)T * DFF * 2 <= WS_END, "ws map");
constexpr int CW_QUEUE = 64;
constexpr int CW_P3CNT = 1088;
constexpr int CW_ALCNT = 1024;
constexpr int CW_BAR = 4096;
constexpr int CW_SS1 = 32768, CW_SS2 = CW_SS1 + T, CW_SS3 = CW_SS2 + T, CW_PCNT = CW_SS3 + T + 64, CW_TMO = 2048;
static_assert((CW_PCNT + 64 * 64) * 4 <= (int)CTL_ZERO_BYTES, "control words inside the memset");
constexpr int RING_BYTES = 131072, LDS_BYTES = 163840, MISC_OFF = LDS_BYTES - 256;

#define GAS __attribute__((address_space(1)))
#define LAS __attribute__((address_space(3)))
typedef unsigned short bf16;
typedef unsigned v4u __attribute__((ext_vector_type(4)));
typedef unsigned v2u __attribute__((ext_vector_type(2)));
typedef float f32x4 __attribute__((ext_vector_type(4)));
typedef float f32x16 __attribute__((ext_vector_type(16)));
typedef short bf16x8 __attribute__((ext_vector_type(8)));
typedef GAS unsigned gu32;
#define RLX_AGENT __ATOMIC_RELAXED, __HIP_MEMORY_SCOPE_AGENT
#define LDS_WAIT() asm volatile("s_waitcnt lgkmcnt(0)" ::: "memory")
#define VM_WAIT() asm volatile("s_waitcnt vmcnt(0)" ::: "memory")
__device__ __forceinline__ unsigned f2bf(float f) { unsigned u = __builtin_bit_cast(unsigned, f); return (u + 0x7fffu + ((u >> 16) & 1u)) >> 16; }
__device__ __forceinline__ unsigned pk2(float lo, float hi) { return f2bf(lo) | (f2bf(hi) << 16); }
__device__ __forceinline__ float bf2f(unsigned short h) { return __builtin_bit_cast(float, (unsigned)h << 16); }
__device__ __forceinline__ float bflo(unsigned w) { return __builtin_bit_cast(float, w << 16); }
__device__ __forceinline__ float bfhi(unsigned w) { return __builtin_bit_cast(float, w & 0xffff0000u); }
__device__ __forceinline__ float wave_sum(float v) {
#pragma unroll
    for (int o = 1; o < 64; o <<= 1) v += __shfl_xor(v, o);
    return v;
}
__device__ __forceinline__ float quad_sum(float v) {
    v += __builtin_bit_cast(float, __builtin_amdgcn_update_dpp(0, __builtin_bit_cast(int, v), 0xB1, 0xF, 0xF, false));
    v += __builtin_bit_cast(float, __builtin_amdgcn_update_dpp(0, __builtin_bit_cast(int, v), 0x4E, 0xF, 0xF, false));
    return v;
}

struct Args { const void* in[26]; float* out; unsigned char* ws; int ph_lo, ph_hi; };

struct Frame {
    LAS unsigned char* lds; int tid, lane, wave, G, bid, wv;
    const float *x, *mem; const int* pos;
    const float *norm_mix, *w_in, *mu, *w0, *wd_up, *a0, *a_up, *g_up, *k_k, *k_a, *r_k, *lnx_w, *lnx_b, *w_mix, *norm_cross, *norm_mem, *w_q, *w_kv, *w_o, *norm_mlp, *w_up, *w_dn, *norm_final;
    float* out; unsigned* ctl;
    bf16 *WIN, *WMIX, *WQ, *WKV, *WO, *WUP, *WDN, *WL, *XN, *MEMN, *MEMKV, *AL, *QC, *OC, *Y, *P, *ACT, *EWAG; unsigned* MASK;
};

__device__ __forceinline__ void p0_transpose_item(const float* W, int K, int N, int NPAD, bf16* WT, LAS float* scr, int item, int lane, const float* gain = nullptr) {
    const int nblk = NPAD / 64, kb = item / nblk, nb = item % nblk, k0 = 64 * kb, n0 = 64 * nb;
    const int c4 = (lane & 15) * 4, kr = lane >> 4; const bool ok = (n0 + c4) < N;
    f32x4 v[16];
#pragma unroll
    for (int i = 0; i < 16; ++i) v[i] = ok ? __builtin_nontemporal_load((const f32x4*)(W + (size_t)(k0 + kr + 4 * i) * N + n0 + c4)) : (f32x4){0.f, 0.f, 0.f, 0.f};
#pragma unroll
    for (int i = 0; i < 16; ++i) { LAS float* s = scr + (kr + 4 * i) * 65 + c4; const float gk = gain ? gain[k0 + kr + 4 * i] : 1.f; s[0] = v[i].x * gk; s[1] = v[i].y * gk; s[2] = v[i].z * gk; s[3] = v[i].w * gk; }
    LDS_WAIT(); asm volatile("" ::: "memory");
    const int c = lane & 7;
#pragma unroll
    for (int j = 0; j < 8; ++j) { const int n = (lane >> 3) + 8 * j; const LAS float* s = scr + (8 * c) * 65 + n;
        v4u o; o.x = pk2(s[0 * 65], s[1 * 65]); o.y = pk2(s[2 * 65], s[3 * 65]); o.z = pk2(s[4 * 65], s[5 * 65]); o.w = pk2(s[6 * 65], s[7 * 65]);
        asm volatile("global_store_dwordx4 %0, %1, off sc1\n\ts_nop 1" :: "v"(WT + (size_t)(n0 + n) * K + k0 + 8 * c), "v"(o) : "memory"); }
    LDS_WAIT(); asm volatile("" ::: "memory");
}
__device__ __forceinline__ void rms_row_to_bf16(const float* xrow, const float* g, bf16* orow, int lane) {
    const f32x4* xr = (const f32x4*)xrow + 2 * lane; const f32x4* gr = (const f32x4*)g + 2 * lane;
    f32x4 v[8]; float s = 0.f;
#pragma unroll
    for (int j = 0; j < 4; ++j) { v[2 * j] = __builtin_nontemporal_load(xr + 128 * j); v[2 * j + 1] = __builtin_nontemporal_load(xr + 128 * j + 1);
        s += (v[2 * j].x * v[2 * j].x + v[2 * j].y * v[2 * j].y) + (v[2 * j].z * v[2 * j].z + v[2 * j].w * v[2 * j].w) + (v[2 * j + 1].x * v[2 * j + 1].x + v[2 * j + 1].y * v[2 * j + 1].y) + (v[2 * j + 1].z * v[2 * j + 1].z + v[2 * j + 1].w * v[2 * j + 1].w); }
    const float rstd = 1.f / sqrtf(wave_sum(s) * (1.f / DM) + NORM_EPS);
    v4u* o16 = (v4u*)orow + lane;
#pragma unroll
    for (int j = 0; j < 4; ++j) { const f32x4 g0 = gr[128 * j], g1 = gr[128 * j + 1]; const f32x4 a = v[2 * j], c = v[2 * j + 1]; v4u w;
        w.x = pk2(a.x * rstd * g0.x, a.y * rstd * g0.y); w.y = pk2(a.z * rstd * g0.z, a.w * rstd * g0.w); w.z = pk2(c.x * rstd * g1.x, c.y * rstd * g1.y); w.w = pk2(c.z * rstd * g1.z, c.w * rstd * g1.w);
        asm volatile("global_store_dwordx4 %0, %1, off sc1\n\ts_nop 1" :: "v"(o16 + 64 * j), "v"(w) : "memory"); }
}
__device__ __forceinline__ void p0_prologue(Frame& F, int part = 3) {
    LAS float* scr = (LAS float*)(F.lds + F.wave * 16640);
    const int gw = F.bid * NWAVES + F.wave, NGW = F.G * NWAVES;
    constexpr int I_IN = (DM / 64) * (NP / 64), I_MIX = (DM / 64) * (DM / 64), I_Q = (DM / 64) * (512 / 64), I_KV = (DM / 64) * (1024 / 64), I_O = (512 / 64) * (DM / 64),
                  I_UP = (DM / 64) * (DFF / 64), I_DN = (DFF / 64) * (DM / 64);
    constexpr int NITEMS = I_IN + I_MIX + I_Q + I_KV + I_O;
    if (part & 1)
    for (int it = gw; it < I_IN; it += NGW) p0_transpose_item(F.w_in, DM, NIN, NP, F.WIN, scr, it, F.lane);
    (void)NITEMS;
    if (part & 1)
    for (int idx = F.bid * 512 + F.tid; idx < NL * (KL / 8); idx += F.G * 512) {
        const int n = idx % NL, k0 = (idx / NL) * 8, ty = n >> 10, c = n & 1023; float v[8];
#pragma unroll
        for (int i = 0; i < 8; ++i) { const int k = k0 + i; float x = 0.f;
            if (ty == 0) { if (k < 64) x = F.wd_up[(size_t)k * 1024 + c]; }
            else if (ty == 1) { if (k >= 64 && k < 128) x = F.a_up[(size_t)(k - 64) * 1024 + c]; }
            else { if (k >= 128 && k < 288) x = F.g_up[(size_t)(k - 128) * 1024 + c]; }
            v[i] = x; }
        v4u o; o.x = pk2(v[0], v[1]); o.y = pk2(v[2], v[3]); o.z = pk2(v[4], v[5]); o.w = pk2(v[6], v[7]);
        *(v4u*)(F.WL + (size_t)n * KL + k0) = o;
    }
    if (part & 2)
    for (int m = gw; m < T; m += NGW) rms_row_to_bf16(F.x + (size_t)m * DM, F.norm_mix, F.XN + (size_t)m * DM, F.lane);
}
__device__ __forceinline__ void p3_weights(Frame& F) {
    LAS float* scr = (LAS float*)(F.lds + F.wave * 16640);
    const int gw = F.bid * NWAVES + F.wave, NGW = F.G * NWAVES;
    constexpr int I_MIX = (DM / 64) * (DM / 64), I_Q = (DM / 64) * (512 / 64), I_KV = (DM / 64) * (1024 / 64), I_O = (512 / 64) * (DM / 64);
    for (int it = gw; it < I_MIX + I_Q + I_KV + I_O; it += NGW) {
        int r = it;
        if (r < I_MIX) { p0_transpose_item(F.w_mix, DM, DM, DM, F.WMIX, scr, r, F.lane); continue; } r -= I_MIX;
        if (r < I_Q) { p0_transpose_item(F.w_q, DM, 512, 512, F.WQ, scr, r, F.lane, F.norm_cross); continue; } r -= I_Q;
        if (r < I_KV) { p0_transpose_item(F.w_kv, DM, 1024, 1024, F.WKV, scr, r, F.lane); continue; } r -= I_KV;
        p0_transpose_item(F.w_o, 512, DM, DM, F.WO, scr, r, F.lane);
    }
    for (int mr = gw; mr < TM; mr += NGW) rms_row_to_bf16(F.mem + (size_t)mr * DM, F.norm_mem, F.MEMN + (size_t)mr * DM, F.lane);
}
__device__ __forceinline__ void p7_mlp_weights(Frame& F, int blk0, int nblk) {
    const int me = F.bid - blk0; if (me < 0 || me >= nblk) return;
    LAS float* scr = (LAS float*)(F.lds + F.wave * 16640);
    constexpr int I_UP = (DM / 64) * (DFF / 64), I_DN = (DFF / 64) * (DM / 64);
    for (int it = me * NWAVES + F.wave; it < I_UP; it += nblk * NWAVES) p0_transpose_item(F.w_up, DM, DFF, DFF, F.WUP, scr, it, F.lane, F.norm_mlp);
    (void)I_DN;
}
__device__ __forceinline__ void norm_phase(Frame& F, const float* g) {
    const int gw = F.bid * NWAVES + F.wave, NGW = F.G * NWAVES;
    for (int m = gw; m < T; m += NGW) rms_row_to_bf16(F.out + (size_t)m * DM, g, F.XN + (size_t)m * DM, F.lane);
}
__device__ __forceinline__ void final_norm_phase(Frame& F) {
    const int gw = F.bid * NWAVES + F.wave, NGW = F.G * NWAVES;
    for (int m = gw; m < T; m += NGW) {
        const v4u* xr = (const v4u*)(F.XN + (size_t)m * DM) + F.lane; f32x4* orow = (f32x4*)(F.out + (size_t)m * DM); const f32x4* gr = (const f32x4*)F.norm_final;
        v4u w[4]; float s = 0.f;
#pragma unroll
        for (int j = 0; j < 4; ++j) { w[j] = __builtin_nontemporal_load(xr + 64 * j);
            const float a0 = bflo(w[j].x), a1 = bfhi(w[j].x), a2 = bflo(w[j].y), a3 = bfhi(w[j].y), a4 = bflo(w[j].z), a5 = bfhi(w[j].z), a6 = bflo(w[j].w), a7 = bfhi(w[j].w);
            s += (a0 * a0 + a1 * a1) + (a2 * a2 + a3 * a3) + (a4 * a4 + a5 * a5) + (a6 * a6 + a7 * a7); }
        const float rstd = 1.f / sqrtf(wave_sum(s) * (1.f / DM) + NORM_EPS);
#pragma unroll
        for (int j = 0; j < 4; ++j) { const int c4 = (64 * j + F.lane) * 2; const f32x4 g0 = gr[c4], g1 = gr[c4 + 1];
            __builtin_nontemporal_store((f32x4){bflo(w[j].x) * rstd * g0.x, bfhi(w[j].x) * rstd * g0.y, bflo(w[j].y) * rstd * g0.z, bfhi(w[j].y) * rstd * g0.w}, orow + c4);
            __builtin_nontemporal_store((f32x4){bflo(w[j].z) * rstd * g1.x, bfhi(w[j].z) * rstd * g1.y, bflo(w[j].w) * rstd * g1.z, bfhi(w[j].w) * rstd * g1.w}, orow + c4 + 1); }
    }
}

__device__ __forceinline__ void prep_phase(Frame& F) {
    const int gw = F.bid * NWAVES + F.wave, NGW = F.G * NWAVES, lane = F.lane;
    constexpr int NU = 8;
    const bool lora_l = lane < 36, pad_l = lane < 48;
    const int j0 = lane * 8;
    f32x4 mu0 = {0.f, 0.f, 0.f, 0.f}, mu1 = mu0;
    if (lora_l) { mu0 = *(const f32x4*)(F.mu + C_XW + j0); mu1 = *(const f32x4*)(F.mu + C_XW + j0 + 4); }
    for (int mb = gw; mb < T; mb += NU * NGW) {
        v4u cu[NU], pv[NU]; bool val[NU];
#pragma unroll
        for (int u = 0; u < NU; ++u) { const int mm = mb + u * NGW; val[u] = mm < T; const int ms = val[u] ? mm : mb; const bf16* prow = F.P + (size_t)ms * NP;
            cu[u] = (v4u){0u, 0u, 0u, 0u}; pv[u] = cu[u];
            if (lora_l) { cu[u] = *(const v4u*)(prow + C_XW + j0); if ((ms & (SEQ - 1)) > 0) pv[u] = *(const v4u*)(prow - NP + C_XW + j0); } }
#pragma unroll
        for (int u = 0; u < NU; ++u) { const int mm = mb + u * NGW; if (!val[u]) continue;
            if (pad_l) { unsigned o[4] = {0u, 0u, 0u, 0u};
                if (lora_l) { const unsigned cw[4] = {cu[u].x, cu[u].y, cu[u].z, cu[u].w}, pw_[4] = {pv[u].x, pv[u].y, pv[u].z, pv[u].w};
                    const float mu8[8] = {mu0.x, mu0.y, mu0.z, mu0.w, mu1.x, mu1.y, mu1.z, mu1.w};
#pragma unroll
                    for (int e = 0; e < 4; ++e) { float v2[2];
#pragma unroll
                        for (int q = 0; q < 2; ++q) { const float xc = q ? bfhi(cw[e]) : bflo(cw[e]), xp = q ? bfhi(pw_[e]) : bflo(pw_[e]); const float xm = xc + (xp - xc) * mu8[2 * e + q];
                            float v = xm;
                            if (j0 < 64) v = 1.f - 2.f * __builtin_amdgcn_rcpf(1.f + __expf(2.f * xm));
                            else if (j0 >= 128) v = __builtin_amdgcn_rcpf(1.f + __expf(-xm));
                            v2[q] = v; }
                        o[e] = pk2(v2[0], v2[1]); } }
                { const v4u ov = {o[0], o[1], o[2], o[3]}; asm volatile("global_store_dwordx4 %0, %1, off sc1\n\ts_nop 1" :: "v"(F.AL + (size_t)mm * KL + j0), "v"(ov) : "memory"); } }
        }
    }
    asm volatile("s_waitcnt vmcnt(0)" ::: "memory"); __syncthreads();
    if (F.tid == 0) __hip_atomic_fetch_add(F.ctl + CW_ALCNT, 1u, RLX_AGENT);
}

__device__ __forceinline__ void count_ge4(int& cnt, unsigned k0, unsigned k1, unsigned k2, unsigned k3, unsigned cand) {
    unsigned long long m0, m1, m2, m3;
    asm volatile(
        "v_cmp_ge_u32_e64 %1, %5, %9\n\t"
        "v_cmp_ge_u32_e64 %2, %6, %9\n\t"
        "v_cmp_ge_u32_e64 %3, %7, %9\n\t"
        "v_cmp_ge_u32_e64 %4, %8, %9\n\t"
        "v_addc_co_u32_e64 %0, vcc, 0, %0, %1\n\t"
        "v_addc_co_u32_e64 %0, vcc, 0, %0, %2\n\t"
        "v_addc_co_u32_e64 %0, vcc, 0, %0, %3\n\t"
        "v_addc_co_u32_e64 %0, vcc, 0, %0, %4"
        : "+v"(cnt), "=&s"(m0), "=&s"(m1), "=&s"(m2), "=&s"(m3) : "v"(k0), "v"(k1), "v"(k2), "v"(k3), "v"(cand) : "vcc");
}
struct IdxPre { bf16x8 af[4]; v4u wa, wc; v4u s0, s1; };
__device__ __forceinline__ void indexer_pre(Frame& F, int b, int qblk, IdxPre& p) {
    int t_ = F.wv * 64 + (int)__builtin_amdgcn_mbcnt_hi(~0u, __builtin_amdgcn_mbcnt_lo(~0u, 0u)); asm volatile("" : "+v"(t_));
    const int tid = t_, lane = tid & 63, wave = F.wv, col = lane & 31, hf = lane >> 5;
    const int q0 = qblk * 16, t0 = q0 + 2 * wave, my_t = t0 + hf;
    const bf16* Pb = F.P + (size_t)b * SEQ * NP;
    { const int rho = col, sel = (rho >> 2) & 1, head = (rho & 3) + 4 * (rho >> 3);
      const bf16* qrow = Pb + (size_t)(t0 + sel) * NP + C_QI + head * 64 + hf * 8;
#pragma unroll
      for (int s = 0; s < 4; ++s) p.af[s] = *(const bf16x8*)(qrow + 16 * s); }
    { const v4u* wr = (const v4u*)(Pb + (size_t)my_t * NP + C_WI); p.wa = wr[0]; p.wc = wr[1]; }
    const int srow = tid >> 3, sc16 = tid & 7;
    const bf16* ksrc = Pb + (size_t)srow * NP + C_KI + sc16 * 8;
    p.s0 = *(const v4u*)(ksrc); p.s1 = *(const v4u*)(ksrc + (size_t)64 * NP);
}
__device__ __forceinline__ void indexer_unit(Frame& F, int b, int qblk, IdxPre& pre, const bool has_next, const int nb, const int nqblk) {
    int t_ = F.wv * 64 + (int)__builtin_amdgcn_mbcnt_hi(~0u, __builtin_amdgcn_mbcnt_lo(~0u, 0u)); asm volatile("" : "+v"(t_));
    const int tid = t_, lane = tid & 63, wave = F.wv, col = lane & 31, hf = lane >> 5;
    const int q0 = qblk * 16, t0 = q0 + 2 * wave, my_t = t0 + hf;
    const bf16* Pb = F.P + (size_t)b * SEQ * NP;
    LAS unsigned char* L = F.lds;
    bf16x8 af[4];
#pragma unroll
    for (int s = 0; s < 4; ++s) af[s] = pre.af[s];
    float wq[16];
    { const v4u a = pre.wa, c = pre.wc;
      wq[0] = bflo(a.x); wq[1] = bfhi(a.x); wq[2] = bflo(a.y); wq[3] = bfhi(a.y); wq[4] = bflo(a.z); wq[5] = bfhi(a.z); wq[6] = bflo(a.w); wq[7] = bfhi(a.w);
      wq[8] = bflo(c.x); wq[9] = bfhi(c.x); wq[10] = bflo(c.y); wq[11] = bfhi(c.y); wq[12] = bflo(c.z); wq[13] = bfhi(c.z); wq[14] = bflo(c.w); wq[15] = bfhi(c.w); }
    const int nch = (q0 + 15) / 128 + 1;
    const int srow = tid >> 3, sc16 = tid & 7;
    const bf16* ksrc = Pb + (size_t)srow * NP + C_KI + sc16 * 8;
    v4u st0 = pre.s0, st1 = pre.s1;
    *(LAS v4u*)(L + srow * 144 + sc16 * 16) = st0; *(LAS v4u*)(L + (srow + 64) * 144 + sc16 * 16) = st1;
    __syncthreads();
    unsigned key[64];
#pragma unroll
    for (int ch = 0; ch < 16; ++ch) {
        if (ch < nch) {
            const bool more = (ch + 1 < nch);
            if (more) { st0 = *(const v4u*)(ksrc + (size_t)(128 * (ch + 1)) * NP); st1 = *(const v4u*)(ksrc + (size_t)(128 * (ch + 1) + 64) * NP); }
            const LAS unsigned char* kb0 = L + (ch & 1) * 18432 + col * 144 + hf * 16;
#pragma unroll
            for (int sub = 0; sub < 4; ++sub) { const int kb = 4 * ch + sub;
                f32x16 c = {};
#pragma unroll
                for (int s = 0; s < 4; ++s) { const bf16x8 bfr = *(const LAS bf16x8*)(kb0 + sub * 32 * 144 + s * 32); c = __builtin_amdgcn_mfma_f32_32x32x16_bf16(af[s], bfr, c, 0, 0, 0); }
                float sc = 0.f;
#pragma unroll
                for (int r = 0; r < 16; ++r) { const int ci = (int)__float_as_uint(c[r]); sc = fmaf(__uint_as_float((unsigned)(ci > 0 ? ci : 0)), wq[r], sc); }
                unsigned u = __float_as_uint(sc); u = (u & 0x80000000u) ? ~u : (u | 0x80000000u);
                key[kb] = (kb * 32 + col <= my_t) ? u : 0u; }
            if (more) { LAS unsigned char* dst = L + ((ch + 1) & 1) * 18432; *(LAS v4u*)(dst + srow * 144 + sc16 * 16) = st0; *(LAS v4u*)(dst + (srow + 64) * 144 + sc16 * 16) = st1; }
            __syncthreads();
        } else {
#pragma unroll
            for (int sub = 0; sub < 4; ++sub) key[4 * ch + sub] = 0u;
        }
    }
    if (has_next) indexer_pre(F, nb, nqblk, pre);
    bool done = (my_t + 1 <= 256);
    unsigned tau = done ? 1u : 0u;
    const int nch8 = (q0 + 15) / 256 + 1;
#define IDX_SEARCH(NG) for (int bit = 31; bit >= 0; --bit) { \
        if (__all(done)) break; \
        const unsigned cand = tau | (1u << bit); \
        int cnt = 0; \
        _Pragma("unroll") for (int g8 = 0; g8 < (NG); ++g8) { \
            _Pragma("unroll") for (int j = 0; j < 8; j += 4) count_ge4(cnt, key[8 * g8 + j], key[8 * g8 + j + 1], key[8 * g8 + j + 2], key[8 * g8 + j + 3], cand); } \
        cnt += __builtin_amdgcn_update_dpp(0, cnt, 0xB1, 0xF, 0xF, false); cnt += __builtin_amdgcn_update_dpp(0, cnt, 0x4E, 0xF, 0xF, false); \
        cnt += __builtin_amdgcn_update_dpp(0, cnt, 0x141, 0xF, 0xF, false); cnt += __builtin_amdgcn_update_dpp(0, cnt, 0x140, 0xF, 0xF, false); \
        { auto rr = __builtin_amdgcn_permlane16_swap((unsigned)cnt, (unsigned)cnt, false, false); cnt = (int)(rr[0] + rr[1]); } \
        if (!done && cnt >= 256) { tau = cand; if (cnt == 256) done = true; } }
    switch (nch8) { case 1: IDX_SEARCH(1) break; case 2: IDX_SEARCH(2) break; case 3: IDX_SEARCH(3) break; case 4: IDX_SEARCH(4) break;
                    case 5: IDX_SEARCH(5) break; case 6: IDX_SEARCH(6) break; case 7: IDX_SEARCH(7) break; default: IDX_SEARCH(8) break; }
#undef IDX_SEARCH
    unsigned* ma = F.MASK + (size_t)(b * SEQ + t0) * 64;
    unsigned wa = 0u, wb = 0u;
#pragma unroll
    for (int kb = 0; kb < 64; ++kb) {
        const unsigned long long bal = __ballot(key[kb] >= tau);
        asm volatile("s_nop 4\n\tv_writelane_b32 %0, %2, %4\n\tv_writelane_b32 %1, %3, %4" : "+v"(wa), "+v"(wb) : "s"((unsigned)bal), "s"((unsigned)(bal >> 32)), "i"(kb));
    }
    __hip_atomic_store(ma + lane, wa, RLX_AGENT); __hip_atomic_store(ma + 64 + lane, wb, RLX_AGENT);
    __syncthreads();
}
__device__ __forceinline__ void indexer_phase(Frame& F) {
    const int nrounds = (NB * (SEQ / 16) + F.G - 1) / F.G;
    IdxPre pre;
    { const int j0 = F.bid; if (j0 < NB * (SEQ / 16)) indexer_pre(F, j0 & 7, j0 >> 3, pre); }
    for (int i = 0; i < nrounds; ++i) {
        const int j = i * F.G + ((i & 1) ? (F.G - 1 - F.bid) : F.bid), jn = (i + 1) * F.G + (((i + 1) & 1) ? (F.G - 1 - F.bid) : F.bid);
        const bool has_next = (i + 1 < nrounds) && (jn < NB * (SEQ / 16));
        if (j < NB * (SEQ / 16)) indexer_unit(F, j & 7, j >> 3, pre, has_next, jn & 7, jn >> 3);
    }
}

template <int CTRL> __device__ __forceinline__ float dppx(float v) { return __builtin_bit_cast(float, __builtin_amdgcn_update_dpp(0, __builtin_bit_cast(int, v), CTRL, 0xF, 0xF, false)); }
__device__ __forceinline__ float row16_sum(float v) {
    v += dppx<0xB1>(v); v += dppx<0x4E>(v); v += dppx<0x141>(v); v += dppx<0x140>(v); return v;
}
__device__ __forceinline__ void row16_sum2(float& a, float& b) {
    asm volatile("s_nop 1\n\t"
        "v_add_f32_dpp %0, %0, %0 quad_perm:[1,0,3,2] row_mask:0xf bank_mask:0xf\n\t"
        "v_add_f32_dpp %1, %1, %1 quad_perm:[1,0,3,2] row_mask:0xf bank_mask:0xf\n\t"
        "s_nop 0\n\t"
        "v_add_f32_dpp %0, %0, %0 quad_perm:[2,3,0,1] row_mask:0xf bank_mask:0xf\n\t"
        "v_add_f32_dpp %1, %1, %1 quad_perm:[2,3,0,1] row_mask:0xf bank_mask:0xf\n\t"
        "s_nop 0\n\t"
        "v_add_f32_dpp %0, %0, %0 row_half_mirror row_mask:0xf bank_mask:0xf\n\t"
        "v_add_f32_dpp %1, %1, %1 row_half_mirror row_mask:0xf bank_mask:0xf\n\t"
        "s_nop 0\n\t"
        "v_add_f32_dpp %0, %0, %0 row_mirror row_mask:0xf bank_mask:0xf\n\t"
        "v_add_f32_dpp %1, %1, %1 row_mirror row_mask:0xf bank_mask:0xf\n\t"
        "s_nop 1"
        : "+v"(a), "+v"(b));
}
__device__ __forceinline__ float wave_sum_d(float v) { v = row16_sum(v); v += __shfl_xor(v, 16); v += __shfl_xor(v, 32); return v; }
namespace rw {
typedef short bf16x8 __attribute__((ext_vector_type(8)));
typedef short s16x4 __attribute__((ext_vector_type(4)));
typedef float f32x16 __attribute__((ext_vector_type(16)));
constexpr int KAP = 0, RH = 13824, KBT = 27648, BBT = 43008, VT = 58368, KH = 78848, BH = 88064, MATS = 97280, YB = 122880, GC = 139264, WTOT = 140032, BON = 144128;
constexpr int I64 = 4608, I32 = 5120, M32 = 2560, MSET = 12800;
constexpr int AKK = 0, AKR = 2560, ABR = 5120, TT = 7680, SCR = 10240;
constexpr int S64 = 144, S32 = 80;
typedef float f32x2_t __attribute__((ext_vector_type(2))); typedef __bf16 bf16x2_t __attribute__((ext_vector_type(2)));
__device__ __forceinline__ unsigned cvtpk(float lo, float hi) { f32x2_t v = {lo, hi}; bf16x2_t b = __builtin_convertvector(v, bf16x2_t); return __builtin_bit_cast(unsigned, b); }
__device__ __forceinline__ unsigned short cvt1(float x) { return (unsigned short)cvtpk(x, 0.f); }
__device__ __forceinline__ bf16x8 frag_nat(const LAS unsigned char* base, int stride, int row, int kb, int h) { return *(const LAS bf16x8*)(base + row * stride + (kb + 8 * h) * 2); }
__device__ __forceinline__ bf16x8 frag_perm(const LAS unsigned char* base, int stride, int row, int kb, int h) {
    const s16x4 lo = *(const LAS s16x4*)(base + row * stride + (kb + 4 * h) * 2), hi = *(const LAS s16x4*)(base + row * stride + (kb + 8 + 4 * h) * 2);
    return (bf16x8){lo[0], lo[1], lo[2], lo[3], hi[0], hi[1], hi[2], hi[3]};
}
__device__ __forceinline__ bf16x8 acc_frag(const f32x16& x, int s) {
    typedef unsigned u32x4 __attribute__((ext_vector_type(4)));
    u32x4 w; w.x = cvtpk(x[8 * s + 0], x[8 * s + 1]); w.y = cvtpk(x[8 * s + 2], x[8 * s + 3]); w.z = cvtpk(x[8 * s + 4], x[8 * s + 5]); w.w = cvtpk(x[8 * s + 6], x[8 * s + 7]);
    return __builtin_bit_cast(bf16x8, w);
}
__device__ __forceinline__ int crow(int r, int hi) { return (r & 3) + 8 * (r >> 2) + 4 * hi; }
}

#ifndef PROBE_VAR
#define PROBE_VAR 0
#endif
__device__ __forceinline__ void wave_sum2(float& a, float& b) {
    row16_sum2(a, b);
    const float a1 = __shfl_xor(a, 16), b1 = __shfl_xor(b, 16); a += a1; b += b1;
    const float a2 = __shfl_xor(a, 32), b2 = __shfl_xor(b, 32); a += a2; b += b2;
}
template <int N> __device__ __forceinline__ void wave_sum_n(float (&v)[N]) {
#pragma unroll
    for (int i = 0; i < N; ++i) v[i] += dppx<0xB1>(v[i]);
#pragma unroll
    for (int i = 0; i < N; ++i) v[i] += dppx<0x4E>(v[i]);
#pragma unroll
    for (int i = 0; i < N; ++i) v[i] += dppx<0x141>(v[i]);
#pragma unroll
    for (int i = 0; i < N; ++i) v[i] += dppx<0x140>(v[i]);
#pragma unroll
    for (int i = 0; i < N; ++i) { auto rr = __builtin_amdgcn_permlane16_swap(__float_as_uint(v[i]), __float_as_uint(v[i]), false, false);
        v[i] = __uint_as_float(rr[0]) + __uint_as_float(rr[1]); }
#pragma unroll
    for (int i = 0; i < N; ++i) { auto rr = __builtin_amdgcn_permlane32_swap(__float_as_uint(v[i]), __float_as_uint(v[i]), false, false);
        v[i] = __uint_as_float(rr[0]) + __uint_as_float(rr[1]); }
}
#define TS_LANE(j) (32 * ((j) & 1) + 16 * (((j) >> 1) & 1) + 8 * (((j) >> 2) & 1) + 4 * (((j) >> 3) & 1))
__device__ __forceinline__ float wave_sum16_t(const float (&v)[16], const int lane) {
    const bool b2 = lane & 4, b3 = lane & 8;
    float a[8], b[4], c[2], d;
#pragma unroll
    for (int i = 0; i < 8; ++i) { auto rr = __builtin_amdgcn_permlane32_swap(__float_as_uint(v[2 * i]), __float_as_uint(v[2 * i + 1]), false, false);
        a[i] = __uint_as_float(rr[0]) + __uint_as_float(rr[1]); }
#pragma unroll
    for (int i = 0; i < 4; ++i) { auto rr = __builtin_amdgcn_permlane16_swap(__float_as_uint(a[2 * i]), __float_as_uint(a[2 * i + 1]), false, false);
        b[i] = __uint_as_float(rr[0]) + __uint_as_float(rr[1]); }
#pragma unroll
    for (int i = 0; i < 2; ++i) { const float keep = b3 ? b[2 * i + 1] : b[2 * i], give = b3 ? b[2 * i] : b[2 * i + 1]; c[i] = keep + dppx<0x128>(give); }
    { const float keep = b2 ? c[1] : c[0], give = b2 ? c[0] : c[1]; d = keep + dppx<0x1B>(dppx<0x141>(give)); }
    d += dppx<0x4E>(d); d += dppx<0xB1>(d);
    return d;
}
__device__ __forceinline__ float bcast_lane(float d, int j) { return __uint_as_float((unsigned)__builtin_amdgcn_readlane((int)__float_as_uint(d), j)); }
__device__ __forceinline__ void rwkv_unit(Frame& F, int b, int h, const int pv = 0) {
    using namespace rw;
    int t_ = F.wv * 64 + (int)__builtin_amdgcn_mbcnt_hi(~0u, __builtin_amdgcn_mbcnt_lo(~0u, 0u)); asm volatile("" : "+v"(t_));
    const int lane = t_ & 63, wave = __builtin_amdgcn_readfirstlane(t_ >> 6), l31 = lane & 31, hi = lane >> 5;
    LAS unsigned char* L = F.lds;
    const int c = lane, col = h * 64 + c;
    const float mu_r = F.mu[C_R + col], mu_k = F.mu[C_K + col], mu_v = F.mu[C_V + col];
    const float kkc = F.k_k[col], kac = F.k_a[col], rkc = F.r_k[col], lw = F.lnx_w[col], lb = F.lnx_b[col];
    const size_t m0 = (size_t)b * SEQ;
    const int vh = wave & 1;
    constexpr int NCH = SEQ / 32;
    float st[40];
#pragma unroll
    for (int i = 0; i < 40; ++i) st[i] = 0.f;
#define rm(j) st[(j)]
#define kt(j) st[8 + (j)]
#define kk(j) st[16 + (j)]
#define bb(j) st[24 + (j)]
#define cs(j) st[32 + (j)]
    unsigned raw[8][5]; unsigned rawp[3]; unsigned gq[8];
    const auto rsP = __builtin_amdgcn_make_buffer_rsrc((void*)F.P, 0, T * NP * 2, 0x00020000);
    const auto rsE = __builtin_amdgcn_make_buffer_rsrc((void*)F.EWAG, 0, T * NL * 2, 0x00020000);
    const auto rsY = __builtin_amdgcn_make_buffer_rsrc((void*)F.Y, 0, T * DM * 2, 0x00020000);
    const int vo = col * 2;
#define BLD(rs, so, aux) ((unsigned)__builtin_amdgcn_raw_buffer_load_b16(rs, vo, (int)(so), aux))
#define RW_LOAD(ch) do { { const int tk0 = (ch) * 32 + 8 * wave; const unsigned so = (unsigned)(((int)m0 + tk0 - (tk0 > 0 ? 1 : 0)) * (NP * 2)); rawp[0] = BLD(rsP, so + C_R * 2, 0); rawp[1] = BLD(rsP, so + C_K * 2, 0); rawp[2] = BLD(rsP, so + C_V * 2, 0); } \
        _Pragma("unroll") for (int j = 0; j < 8; ++j) { const int mt = (int)m0 + (ch) * 32 + 8 * wave + j; const unsigned sp = (unsigned)(mt * (NP * 2)), se = (unsigned)(mt * (NL * 2)); \
        raw[j][0] = BLD(rsP, sp + C_R * 2, 2); raw[j][1] = BLD(rsP, sp + C_K * 2, 2); raw[j][2] = BLD(rsP, sp + C_V * 2, 2); \
        raw[j][3] = BLD(rsE, se, 2); raw[j][4] = BLD(rsE, se + 1024 * 2, 2); } } while (0)
    if (pv & 128) return;
    if (wave < 4) RW_LOAD(0);
    for (int it = 0; it < NCH + 4; ++it) {
        if (wave < 4) {
            bf16x8 vv = {}; float bon8[8];
#pragma unroll
            for (int j = 0; j < 8; ++j) bon8[j] = 0.f;
            if (it >= 4) { const int ch = it - 4; vv = *(const LAS bf16x8*)(L + VT + (ch & 3) * I32 + c * S32 + 16 * wave);
#pragma unroll
                for (int j = 0; j < 8; ++j) bon8[j] = ((const LAS float*)(L + BON + (ch & 3) * 128))[8 * wave + j]; }
            if (it >= 1 && it <= NCH && !(pv & 32)) { const int ch = it - 1; const LAS float* wt = (const LAS float*)(L + WTOT + (ch & 1) * 2048);
                float off = 0.f, tot = 0.f;
#pragma unroll
                for (int w2 = 0; w2 < 4; ++w2) { const float x = wt[w2 * 64 + c]; tot += x; off += (w2 < wave) ? x : 0.f; }
                const float lgC = -tot;
                LAS unsigned char* pK = L + KAP + (ch % 3) * I64; LAS unsigned char* pR = L + RH + (ch % 3) * I64; LAS unsigned char* pKH = L + KH + (ch & 1) * I64; LAS unsigned char* pBH = L + BH + (ch & 1) * I64;
                LAS unsigned char* pKB = L + KBT + (ch % 3) * I32; LAS unsigned char* pBB = L + BBT + (ch % 3) * I32;
                const float eC = __expf(lgC); float egp = __expf(-off);
                unsigned kb4[4], bb4[4];
#pragma unroll
                for (int j = 0; j < 8; ++j) { const int i = 8 * wave + j;
                    const float e_g = __expf(-(off + cs(j))), e_m = __builtin_amdgcn_rcpf(e_g), e_c = eC * e_m;
                    *(LAS bf16*)(pK + i * S64 + 2 * c) = cvt1(kk(j) * egp); *(LAS bf16*)(pR + i * S64 + 2 * c) = cvt1(rm(j) * e_g);
                    *(LAS bf16*)(pKH + i * S64 + 2 * c) = cvt1(kt(j) * e_m); *(LAS bf16*)(pBH + i * S64 + 2 * c) = cvt1(bb(j) * e_m);
                    const float kbv = kt(j) * e_c, bbv = -bb(j) * e_c;
                    if (j & 1) { kb4[j >> 1] = cvtpk(__uint_as_float(kb4[j >> 1]), kbv); bb4[j >> 1] = cvtpk(__uint_as_float(bb4[j >> 1]), bbv); }
                    else { kb4[j >> 1] = __float_as_uint(kbv); bb4[j >> 1] = __float_as_uint(bbv); }
                    egp = e_g; }
                *(LAS v4u*)(pKB + c * S32 + 16 * wave) = (v4u){kb4[0], kb4[1], kb4[2], kb4[3]};
                *(LAS v4u*)(pBB + c * S32 + 16 * wave) = (v4u){bb4[0], bb4[1], bb4[2], bb4[3]};
                if (wave == 0) ((LAS float*)(L + GC + (ch % 3) * 256))[c] = eC;
            }
            if (it < NCH && !(pv & 64)) { const int ch = it;
                float kkr8[8], a8[8], red[16]; unsigned vt4[4];
#pragma unroll
                for (int j = 0; j < 8; ++j) { const int tk = ch * 32 + 8 * wave + j; const bool hp = tk > 0;
                    const float r0 = bf2f((unsigned short)raw[j][0]), k0 = bf2f((unsigned short)raw[j][1]), v0 = bf2f((unsigned short)raw[j][2]);
                    const float r1 = !hp ? 0.f : bf2f((unsigned short)(j ? raw[j ? j - 1 : 0][0] : rawp[0])), k1 = !hp ? 0.f : bf2f((unsigned short)(j ? raw[j ? j - 1 : 0][1] : rawp[1])),
                                v1 = !hp ? 0.f : bf2f((unsigned short)(j ? raw[j ? j - 1 : 0][2] : rawp[2]));
                    rm(j) = r0 + (r1 - r0) * mu_r; const float km = k0 + (k1 - k0) * mu_k; const float vmj = v0 + (v1 - v0) * mu_v;
                    if (j & 1) vt4[j >> 1] = cvtpk(__uint_as_float(vt4[j >> 1]), vmj); else vt4[j >> 1] = __float_as_uint(vmj);
                    const float ew = bf2f((unsigned short)raw[j][3]); a8[j] = bf2f((unsigned short)raw[j][4]);
                    kkr8[j] = km * kkc; kt(j) = km * (1.f + (a8[j] - 1.f) * kac);
                    red[j] = kkr8[j] * kkr8[j]; red[8 + j] = rm(j) * kt(j) * rkc;
                    cs(j) = (j ? cs(j ? j - 1 : 0) : 0.f) + ew; }
                *(LAS v4u*)(L + VT + (ch & 3) * I32 + c * S32 + 16 * wave) = (v4u){vt4[0], vt4[1], vt4[2], vt4[3]};
                const float rd = wave_sum16_t(red, lane);
#pragma unroll
                for (int j = 0; j < 8; ++j) { kk(j) = kkr8[j] * __builtin_amdgcn_rsqf(fmaxf(bcast_lane(rd, TS_LANE(j)), 1e-24f)); bb(j) = kk(j) * a8[j]; }
                if ((lane & 7) == 4) ((LAS float*)(L + BON + (ch & 3) * 128))[8 * wave + ((lane >> 5) | (((lane >> 4) & 1) << 1) | (((lane >> 3) & 1) << 2))] = rd;
                ((LAS float*)(L + WTOT + (ch & 1) * 2048))[wave * 64 + c] = cs(7);
            }
            if (!(pv & 2) && it + 1 < NCH) RW_LOAD(it + 1);
            if (it >= 4 && !(pv & 4)) { const int ch = it - 4;
                const LAS float* yb = (const LAS float*)(L + YB + (ch & 1) * 8192);
                float y8[8], sm[16];
#pragma unroll
                for (int j = 0; j < 8; ++j) { y8[j] = yb[(8 * wave + j) * 64 + c]; sm[j] = y8[j]; sm[8 + j] = y8[j] * y8[j]; }
                const float sd = wave_sum16_t(sm, lane);
#pragma unroll
                for (int j = 0; j < 8; ++j) { const int i = 8 * wave + j;
                    const float mean = bcast_lane(sd, TS_LANE(j)) * (1.f / 64.f), var = fmaxf(bcast_lane(sd, TS_LANE(8 + j)) * (1.f / 64.f) - mean * mean, 0.f);
                    const float yn = (y8[j] - mean) * __builtin_amdgcn_rsqf(var + RWKV_LN_EPS) * lw + lb;
                    const float o = (yn + bon8[j] * bf2f((unsigned short)vv[j])) * bf2f((unsigned short)gq[j]);
                    __builtin_amdgcn_raw_buffer_store_b16((short)cvt1(o), rsY, vo, (int)(((int)m0 + ch * 32 + i) * (DM * 2)), 0); }
            }
            if (!(pv & 2) && it + 1 >= 4 && it + 1 < NCH + 4) {
#pragma unroll
                for (int j = 0; j < 8; ++j) gq[j] = BLD(rsE, (unsigned)(((int)m0 + (it - 3) * 32 + 8 * wave + j) * (NL * 2)) + 2048 * 2, 2); }
        } else if (wave < 6) {
            if (it >= 3 && it < NCH + 3 && !(pv & 8)) { const int ch = it - 3;
                const LAS unsigned char* pK = L + KAP + (ch % 3) * I64; const LAS unsigned char* pR = L + RH + (ch % 3) * I64; const LAS unsigned char* pKB = L + KBT + (ch % 3) * I32;
                const LAS unsigned char* pBB = L + BBT + (ch % 3) * I32; const LAS unsigned char* pV = L + VT + (ch & 3) * I32; const LAS unsigned char* pM = L + MATS + (ch & 1) * MSET;
                f32x16 X0, X1;
#pragma unroll
                for (int r = 0; r < 16; ++r) { X0[r] = st[r]; X1[r] = st[16 + r]; }
                f32x16 RHS = {}, YT = {}; bf16x8 xb[4];
                xb[0] = acc_frag(X0, 0); xb[1] = acc_frag(X0, 1); xb[2] = acc_frag(X1, 0); xb[3] = acc_frag(X1, 1);
#pragma unroll
                for (int q = 0; q < 4; ++q) { RHS = __builtin_amdgcn_mfma_f32_32x32x16_bf16(frag_perm(pK, S64, l31, 16 * q, hi), xb[q], RHS, 0, 0, 0);
                                              YT = __builtin_amdgcn_mfma_f32_32x32x16_bf16(frag_perm(pR, S64, l31, 16 * q, hi), xb[q], YT, 0, 0, 0); }
                const bf16x8 vf0 = frag_nat(pV, S32, 32 * vh + l31, 0, hi), vf1 = frag_nat(pV, S32, 32 * vh + l31, 16, hi);
                RHS = __builtin_amdgcn_mfma_f32_32x32x16_bf16(frag_nat(pM + AKK, S32, l31, 0, hi), vf0, RHS, 0, 0, 0);
                RHS = __builtin_amdgcn_mfma_f32_32x32x16_bf16(frag_nat(pM + AKK, S32, l31, 16, hi), vf1, RHS, 0, 0, 0);
                YT = __builtin_amdgcn_mfma_f32_32x32x16_bf16(frag_nat(pM + AKR, S32, l31, 0, hi), vf0, YT, 0, 0, 0);
                YT = __builtin_amdgcn_mfma_f32_32x32x16_bf16(frag_nat(pM + AKR, S32, l31, 16, hi), vf1, YT, 0, 0, 0);
                f32x16 U = {};
                { const bf16x8 r0 = acc_frag(RHS, 0), r1 = acc_frag(RHS, 1);
                  U = __builtin_amdgcn_mfma_f32_32x32x16_bf16(frag_perm(pM + TT, S32, l31, 0, hi), r0, U, 0, 0, 0);
                  U = __builtin_amdgcn_mfma_f32_32x32x16_bf16(frag_perm(pM + TT, S32, l31, 16, hi), r1, U, 0, 0, 0); }
                const bf16x8 u0 = acc_frag(U, 0), u1 = acc_frag(U, 1);
                YT = __builtin_amdgcn_mfma_f32_32x32x16_bf16(frag_perm(pM + ABR, S32, l31, 0, hi), u0, YT, 0, 0, 0);
                YT = __builtin_amdgcn_mfma_f32_32x32x16_bf16(frag_perm(pM + ABR, S32, l31, 16, hi), u1, YT, 0, 0, 0);
                LAS float* yb = (LAS float*)(L + YB + (ch & 1) * 8192);
#pragma unroll
                for (int r = 0; r < 16; ++r) yb[crow(r, hi) * 64 + 32 * vh + l31] = YT[r];
                const LAS float* gc = (const LAS float*)(L + GC + (ch % 3) * 256);
#pragma unroll
                for (int r = 0; r < 16; ++r) { X0[r] *= gc[crow(r, hi)]; X1[r] *= gc[32 + crow(r, hi)]; }
                X0 = __builtin_amdgcn_mfma_f32_32x32x16_bf16(frag_nat(pKB, S32, l31, 0, hi), vf0, X0, 0, 0, 0);
                X1 = __builtin_amdgcn_mfma_f32_32x32x16_bf16(frag_nat(pKB, S32, 32 + l31, 0, hi), vf0, X1, 0, 0, 0);
                X0 = __builtin_amdgcn_mfma_f32_32x32x16_bf16(frag_nat(pKB, S32, l31, 16, hi), vf1, X0, 0, 0, 0);
                X1 = __builtin_amdgcn_mfma_f32_32x32x16_bf16(frag_nat(pKB, S32, 32 + l31, 16, hi), vf1, X1, 0, 0, 0);
                X0 = __builtin_amdgcn_mfma_f32_32x32x16_bf16(frag_perm(pBB, S32, l31, 0, hi), u0, X0, 0, 0, 0);
                X1 = __builtin_amdgcn_mfma_f32_32x32x16_bf16(frag_perm(pBB, S32, 32 + l31, 0, hi), u0, X1, 0, 0, 0);
                X0 = __builtin_amdgcn_mfma_f32_32x32x16_bf16(frag_perm(pBB, S32, l31, 16, hi), u1, X0, 0, 0, 0);
                X1 = __builtin_amdgcn_mfma_f32_32x32x16_bf16(frag_perm(pBB, S32, 32 + l31, 16, hi), u1, X1, 0, 0, 0);
#pragma unroll
                for (int r = 0; r < 16; ++r) { st[r] = X0[r]; st[16 + r] = X1[r]; }
            }
        } else {
            if (it >= 2 && it < NCH + 2 && !(pv & 16)) { const int ch = it - 2;
                const LAS unsigned char* pK = L + KAP + (ch % 3) * I64; const LAS unsigned char* pR = L + RH + (ch % 3) * I64; const LAS unsigned char* pKH = L + KH + (ch & 1) * I64; const LAS unsigned char* pBH = L + BH + (ch & 1) * I64;
                LAS unsigned char* pM = L + MATS + (ch & 1) * MSET;
                if (wave == 6) {
#pragma unroll
                    for (int w3 = 0; w3 < 3; ++w3) { const LAS unsigned char* Aimg = (w3 == 0) ? pK : pR; const LAS unsigned char* Bimg = (w3 == 2) ? pBH : pKH;
                        f32x16 d = {};
#pragma unroll
                        for (int q = 0; q < 4; ++q) d = __builtin_amdgcn_mfma_f32_32x32x16_bf16(frag_nat(Aimg, S64, l31, 16 * q, hi), frag_nat(Bimg, S64, l31, 16 * q, hi), d, 0, 0, 0);
                        const int dst = (w3 == 0) ? AKK : (w3 == 1) ? AKR : ABR; const float sg = (w3 == 2) ? -1.f : 1.f;
#pragma unroll
                        for (int r = 0; r < 16; ++r) { const int t = crow(r, hi); const bool keep = (w3 == 0) ? (l31 < t) : (l31 <= t);
                            *(LAS bf16*)(pM + dst + t * S32 + 2 * l31) = cvt1(keep ? sg * d[r] : 0.f); } }
                } else {
                    f32x16 pw = {}, pT = {};
#pragma unroll
                    for (int q = 0; q < 4; ++q) { const bf16x8 fk = frag_nat(pK, S64, l31, 16 * q, hi), fb = frag_nat(pBH, S64, l31, 16 * q, hi);
                        pw = __builtin_amdgcn_mfma_f32_32x32x16_bf16(fk, fb, pw, 0, 0, 0);
                        pT = __builtin_amdgcn_mfma_f32_32x32x16_bf16(fb, fk, pT, 0, 0, 0); }
#pragma unroll
                    for (int r = 0; r < 16; ++r) { pw[r] = (l31 < crow(r, hi)) ? pw[r] : 0.f; pT[r] = (crow(r, hi) < l31) ? pT[r] : 0.f; }
                    f32x16 P;
#pragma unroll
                    for (int r = 0; r < 16; ++r) P[r] = ((crow(r, hi) == l31) ? 1.f : 0.f) - pw[r];
                    if (!(pv & 1))
#pragma unroll
                    for (int k2 = 0; k2 < 5; ++k2) {
                        const bf16x8 t0 = acc_frag(pT, 0), t1 = acc_frag(pT, 1);
                        if (k2 > 0) { const bf16x8 p0 = acc_frag(P, 0), p1 = acc_frag(P, 1);
                            P = __builtin_amdgcn_mfma_f32_32x32x16_bf16(t0, p0, P, 0, 0, 0); P = __builtin_amdgcn_mfma_f32_32x32x16_bf16(t1, p1, P, 0, 0, 0); }
                        if (k2 < 4) { const bf16x8 w0 = acc_frag(pw, 0), w1 = acc_frag(pw, 1); f32x16 nw = {}, nT = {};
                            nw = __builtin_amdgcn_mfma_f32_32x32x16_bf16(t0, w0, nw, 0, 0, 0); nw = __builtin_amdgcn_mfma_f32_32x32x16_bf16(t1, w1, nw, 0, 0, 0);
                            nT = __builtin_amdgcn_mfma_f32_32x32x16_bf16(w0, t0, nT, 0, 0, 0); nT = __builtin_amdgcn_mfma_f32_32x32x16_bf16(w1, t1, nT, 0, 0, 0);
                            pw = nw; pT = nT; }
                    }
#pragma unroll
                    for (int r = 0; r < 16; ++r) *(LAS bf16*)(pM + TT + crow(r, hi) * S32 + 2 * l31) = cvt1(P[r]);
                }
            }
        }
        __syncthreads();
    }
#undef RW_LOAD
#undef BLD
#undef rm
#undef kt
#undef kk
#undef bb
#undef cs
}
__device__ __forceinline__ void mix_phase(Frame& F, int qword = CW_QUEUE, int only = 0) {
    LAS int* slot = (LAS int*)(F.lds + LDS_BYTES - 64);
    bool first = (only == 0);
    const int qb0 = (only == 0) ? F.G : 0;
    if (F.tid == 0) slot[1] = -1;
    for (;;) {
        __syncthreads();
        if (F.tid == 0) { const int pre = slot[1]; slot[0] = first ? F.bid : (pre >= 0) ? pre : qb0 + (int)__hip_atomic_fetch_add(F.ctl + qword, 1u, RLX_AGENT); slot[1] = -1; }
        first = false;
        __syncthreads();
        const int it = slot[0];
        constexpr int N_CPY = (DFF / 64) * (DM / 64) / NWAVES;
        if (it >= 128 + 512 + (only == 0 ? N_CPY : 0)) break;
        if (it >= 128 + 512) { p0_transpose_item(F.w_dn, DFF, DM, DM, F.WDN, (LAS float*)(F.lds + F.wv * 16640), (it - 128 - 512) * NWAVES + F.wv, F.wv * 0 + (int)__builtin_amdgcn_mbcnt_hi(~0u, __builtin_amdgcn_mbcnt_lo(~0u, 0u))); continue; }
        if (it < 128 && only == 2) continue;
        if (it >= 128 && only == 1) break;
        if (it < 128) {
#ifndef SKIP_RWKV
            rwkv_unit(F, it >> 4, it & 15, only ? (PROBE_VAR) : 0);
#endif
        }
        else {
            const int u = it - 128;
            const int q64 = 31 - (u >> 4), bg = u & 15, b = bg >> 1, g = bg & 1;
            const size_t m0 = (size_t)b * SEQ, q0 = (size_t)q64 * 64;
            const int ntl = (q64 + 2) & ~1;
#ifndef SKIP_ATT
#if PROBE_PH == 41
            if (only == 2 && (PROBE_VAR) == 5 && (u & 1)) continue;
            if (only == 2 && (PROBE_VAR) >= 1) att::attn_body<NP, NP, DM, false, ATT_SD>(F.P + (m0 + q0) * NP + C_Q + g * 512, F.P + m0 * NP + C_AK + g * 128, F.P + m0 * NP + C_AV + g * 128,
                                             F.Y + (m0 + q0) * DM + 1024 + g * 512, F.MASK + (m0 + q0) * 64, (PROBE_VAR) == 2 ? 2048 : ((PROBE_VAR) == 3 || (PROBE_VAR) == 5) ? 256 : (int)q0 + 256, (char*)F.lds, F.wv); else
#endif
            att::attn_body<NP, NP, DM, true, ATT_SD, true>(F.P + (m0 + q0) * NP + C_Q + g * 512, F.P + m0 * NP + C_AK + g * 128, F.P + m0 * NP + C_AV + g * 128,
                                             F.Y + (m0 + q0) * DM + 1024 + g * 512, F.MASK + (m0 + q0) * 64, ntl * 64, (char*)F.lds, F.wv, only == 0 ? F.ctl + qword : nullptr, (int*)(F.lds + LDS_BYTES - 64) + 1, qb0);
#endif
        }
    }
}
__device__ __forceinline__ void cross_phase(Frame& F) {
    for (int u = F.bid; u < NB * 4 * 8; u += F.G) {
        const int b = u >> 5, h = (u >> 3) & 3, qb = u & 7;
        const size_t m0 = (size_t)b * SEQ + (size_t)qb * 256, k0 = (size_t)b * NMEM;
        att::attn_body<512, 1024, 512, false, 2>(F.QC + m0 * 512 + h * 128, F.MEMKV + k0 * 1024 + h * 128, F.MEMKV + k0 * 1024 + 512 + h * 128,
                                              F.OC + m0 * 512 + h * 128, nullptr, NMEM, (char*)F.lds, F.wv);
    }
}

#define XB_TMO      128
#define XB_XCNT(j)  (256  + 64 * (j))
#define XB_XSUB(j)  (1280 + 64 * (j))
#define XB_XGEN(j)  (2304 + 64 * (j))
#define XB_TOP      3328
#define XB_TOPGEN   3392
#define XCD_BAR_WORDS 3456
#define XB_SPIN_CAP (1u << 18)

__device__ __forceinline__ unsigned xb_ld(unsigned* p)              { return __hip_atomic_load(p, __ATOMIC_RELAXED, __HIP_MEMORY_SCOPE_AGENT); }
__device__ __forceinline__ unsigned xb_add(unsigned* p, unsigned v) { return __hip_atomic_fetch_add(p, v, __ATOMIC_RELAXED, __HIP_MEMORY_SCOPE_AGENT); }
__device__ __forceinline__ unsigned xb_xcc_id() { return (unsigned)__builtin_amdgcn_s_getreg((3 << 11) | 20) & 0xFu; }
#define XB_SPIN(cond, bar) do { unsigned _sp = 0; while (cond) { __builtin_amdgcn_s_sleep(1); \
    if ((++_sp & 255u) == 0u) { if (xb_ld(&(bar)[XB_TMO])) break; if (_sp > XB_SPIN_CAP) { atomicAdd(&(bar)[XB_TMO], 1u); break; } } } } while (0)

struct XcdBarrier {
    unsigned* bar; unsigned x;
    volatile LAS unsigned* st;
};

__device__ __forceinline__ XcdBarrier xcd_barrier_post(unsigned* bar, volatile LAS unsigned* st, const bool leader) {
    XcdBarrier b; b.bar = bar; b.x = xb_xcc_id(); b.st = st;
    if (leader) (void)xb_add(&bar[XB_XCNT(b.x)], 1u);
    return b;
}
__device__ __forceinline__ void xcd_barrier_complete(unsigned* bar, unsigned x, unsigned& nloc, unsigned& nx) {
    const unsigned G = gridDim.x * gridDim.y * gridDim.z;
    unsigned sum, cnt, mine, sp = 0u;
    for (;;) {
        sum = 0u; cnt = 0u; mine = 0u;
#pragma unroll
        for (unsigned j = 0; j < 16; ++j) { const unsigned c = xb_ld(&bar[XB_XCNT(j)]); sum += c; cnt += (c > 0u) ? 1u : 0u; mine = (j == x) ? c : mine; }
        if (sum == G) break;
        __builtin_amdgcn_s_sleep(1);
        if ((++sp & 255u) == 0u) { if (xb_ld(&bar[XB_TMO])) break; if (sp > XB_SPIN_CAP) { atomicAdd(&bar[XB_TMO], 1u); break; } }
    }
    nloc = mine > 0u ? mine : 1u; nx = cnt > 0u ? cnt : 1u;
}

__device__ __forceinline__ void xcd_barrier(const XcdBarrier& b, const bool leader) {
    asm volatile("s_waitcnt vmcnt(0)" ::: "memory");
    __syncthreads();
    if (leader) {
        unsigned* bar = b.bar;
        __builtin_amdgcn_s_waitcnt(0);
        unsigned nloc = b.st[0], nx = b.st[1];
        if (nloc == 0u) { xcd_barrier_complete(bar, b.x, nloc, nx); b.st[0] = nloc; b.st[1] = nx; }
        const unsigned old = xb_add(&bar[XB_XSUB(b.x)], 1u);
        const unsigned gen = old / nloc;
        if (old + 1u == (gen + 1u) * nloc) {
            __builtin_amdgcn_fence(__ATOMIC_RELEASE, "agent");
            asm volatile("s_waitcnt vmcnt(0)" ::: "memory");
            const unsigned og = xb_add(&bar[XB_TOP], 1u);
            const unsigned tg = og / nx;
            if (og + 1u == (tg + 1u) * nx) xb_add(&bar[XB_TOPGEN], 1u);
            else XB_SPIN(xb_ld(&bar[XB_TOPGEN]) == tg, bar);
            __builtin_amdgcn_fence(__ATOMIC_ACQUIRE, "agent");
            xb_add(&bar[XB_XGEN(b.x)], 1u);
            asm volatile("s_waitcnt vmcnt(0)" ::: "memory");
        } else {
            XB_SPIN(xb_ld(&bar[XB_XGEN(b.x)]) == gen, bar);
            __builtin_amdgcn_fence(__ATOMIC_ACQUIRE, "agent");
            asm volatile("s_waitcnt vmcnt(0)" ::: "memory");
        }
    }
    __syncthreads();
}

namespace pg8 {
template <int KIND> __device__ __forceinline__ void rope_group(f32x4 (&acc)[2][2][4][2], const int bj, const int* pos, const int rowg, const int fr, const int fq) {
    const bool active = (KIND == 1) || (fq < 2), is_x1 = (KIND == 1) ? (fq < 2) : (fq == 0);
    const float sgn = is_x1 ? -1.f : 1.f;
    float invf[8];
#pragma unroll
    for (int i = 0; i < 8; ++i) { const float fe = (KIND == 1) ? (float)(8 * (fq & 1) + i) * (1.f / 16.f) : (float)i * (1.f / 8.f); invf[i] = exp2f(-fe * 18.931568569324174f); }
#pragma unroll
    for (int ai = 0; ai < 2; ++ai)
#pragma unroll
        for (int m = 0; m < 4; ++m) {
            const float posf = (float)pos[rowg + ai * HALF + m * 16 + fr];
#pragma unroll
            for (int n = 0; n < 2; ++n)
#pragma unroll
                for (int i = 0; i < 4; ++i) {
                    const float own = (bj == 0) ? acc[ai][0][m][n][i] : acc[ai][1][m][n][i];
                    float other;
                    if (KIND == 1) { auto rr = __builtin_amdgcn_permlane32_swap(__float_as_uint(own), __float_as_uint(own), false, false); other = __uint_as_float((fq < 2) ? rr[1] : rr[0]); }
                    else { auto rr = __builtin_amdgcn_permlane16_swap(__float_as_uint(own), __float_as_uint(own), false, false); other = __uint_as_float((fq & 1) ? rr[0] : rr[1]); }
                    const float ang = posf * invf[4 * n + i]; const float k = rintf(ang * 0.15915494309189535f);
                    float r = fmaf(-k, 6.2831854820251465f, ang); r = fmaf(-k, -1.7484555e-7f, r);
                    const float rot = own * __cosf(r) + sgn * other * __sinf(r);
                    const float res = active ? rot : own;
                    if (bj == 0) acc[ai][0][m][n][i] = res; else acc[ai][1][m][n][i] = res; }
            __builtin_amdgcn_sched_barrier(0);
        }
}
struct EpiP1 {
    static constexpr bool PERM = true, AFTER_DRAIN = false;
    bf16_t* O; int ldc; const int* pos;
    __device__ __forceinline__ void operator()(const f32x4 (&acc_)[2][2][4][2], const Unit& u, int wr, int wc, int fr, int fq) const {
        f32x4 (&acc)[2][2][4][2] = const_cast<f32x4 (&)[2][2][4][2]>(acc_);
        const int rowg = u.pm * BM + wr * 64; const bool lo = fr < 8;
        int fqo = fq; asm volatile("" : "+v"(fqo));
        const int g0 = u.pn * BM + wc * 64, g1 = g0 + 32;
        const bool a0 = (g0 >= C_Q && g0 < C_Q + 1024 && ((g0 - C_Q) & 127) == 0) || (g0 >= C_AK && g0 < C_AK + 256 && ((g0 - C_AK) & 127) == 0);
        const bool a1 = (g1 >= C_Q && g1 < C_Q + 1024 && ((g1 - C_Q) & 127) == 0) || (g1 >= C_AK && g1 < C_AK + 256 && ((g1 - C_AK) & 127) == 0);
        const bool i0 = (g0 >= C_QI && g0 < C_QI + 1024 && ((g0 - C_QI) & 63) == 0) || g0 == C_KI;
        const bool i1 = (g1 >= C_QI && g1 < C_QI + 1024 && ((g1 - C_QI) & 63) == 0) || g1 == C_KI;
        if (a0) rope_group<1>(acc, 0, pos, rowg, fr, fqo); else if (a1) rope_group<1>(acc, 1, pos, rowg, fr, fqo);
        else if (i0) rope_group<2>(acc, 0, pos, rowg, fr, fqo); else if (i1) rope_group<2>(acc, 1, pos, rowg, fr, fqo);
        bf16_t* sp = O + (size_t)(rowg + (fr & 7)) * ldc + u.pn * BM + wc * 64 + (fr >> 3) * 32 + 8 * fq;
#pragma unroll
        for (int ai = 0; ai < 2; ++ai)
#pragma unroll
            for (int m = 0; m < 4; ++m) {
                u32x4 w[2];
#pragma unroll
                for (int bj = 0; bj < 2; ++bj) w[bj] = pack8(acc[ai][bj][m][0], acc[ai][bj][m][1]);
                u32x4 d0, d1; xch8(w[0], w[1], lo, d0, d1);
                bf16_t* p = sp + (size_t)(ai * HALF + m * 16) * ldc;
                __builtin_nontemporal_store(d0, (u32x4*)p); __builtin_nontemporal_store(d1, (u32x4*)(p + (size_t)8 * ldc)); }
    }
};
}
template <typename Tp> __device__ __forceinline__ Tp* inp_ptr(int i) {
    asm volatile("" : "+s"(i));
    typedef __attribute__((address_space(1))) Tp* gptr_t;
    Tp* p = (Tp*)(gptr_t)(((const __attribute__((address_space(4))) unsigned long long*)__builtin_amdgcn_kernarg_segment_ptr())[i]);
    return p;
}
constexpr int N_PHASES = 14;
__global__ void __launch_bounds__(NWAVES * 64, 2) mk_fwd(Args args) {
    extern __shared__ __attribute__((aligned(16))) unsigned char lds[];
    Frame F;
    F.lds = (LAS unsigned char*)lds;
    F.wv = __builtin_amdgcn_readfirstlane((int)threadIdx.x >> 6);
    F.lane = (int)__builtin_amdgcn_mbcnt_hi(~0u, __builtin_amdgcn_mbcnt_lo(~0u, 0u)); F.tid = F.wv * 64 + F.lane; F.wave = F.wv;
    F.G = gridDim.x; F.bid = blockIdx.x;
#define INP(i) inp_ptr<const float>(i)
#define WSP(off) ((bf16*)(inp_ptr<unsigned char>(27) + (off)))
    F.out = inp_ptr<float>(26); F.ctl = (unsigned*)inp_ptr<unsigned char>(27);
    for (int u = F.tid; u < 32; u += NWAVES * 64) ((LAS unsigned*)(F.lds + MISC_OFF))[u] = 0u;
    __syncthreads();
    XcdBarrier bar = xcd_barrier_post(F.ctl + CW_BAR, (volatile LAS unsigned*)(F.lds + MISC_OFF) + 8, F.tid == 0);
    const int lo = args.ph_lo, hi = args.ph_hi;
#ifndef PHMASK
#define PHMASK 0xFFFF
#endif
#define IN(k) ((((PHMASK) >> (k)) & 1) && lo <= (k) && (k) < hi)
#define SEAM(k) do { if (IN(k) && IN((k) + 1)) xcd_barrier(bar, F.wv == 0 && (int)__builtin_amdgcn_mbcnt_hi(~0u, __builtin_amdgcn_mbcnt_lo(~0u, 0u)) == 0); { int t_ = F.wv * 64 + (int)__builtin_amdgcn_mbcnt_hi(~0u, __builtin_amdgcn_mbcnt_lo(~0u, 0u)); asm volatile("" : "+v"(t_)); F.tid = t_; F.lane = t_ & 63; F.wave = F.wv; } } while (0)
#define PRB(k) ((PROBE_PH) == (k) || ((k) == 1 && (PROBE_PH) == 112) || ((k) == 11 && (PROBE_PH) == 110) || ((k) == 4 && ((PROBE_PH) == 40 || (PROBE_PH) == 41)) || ((k) == 0 && ((PROBE_PH) == 100 || (PROBE_PH) == 101)))
#define REP(k) for (int rep_ = 0; rep_ < (PRB(k) ? 2 : 1); ++rep_, (PRB(k) && rep_ < 2) ? xcd_barrier(bar, F.wv == 0 && (int)__builtin_amdgcn_mbcnt_hi(~0u, __builtin_amdgcn_mbcnt_lo(~0u, 0u)) == 0) : (void)0)
    using pg8::Gemm; using pg8::StaticOrder;
    REP(0) if (IN(0)) {
        F.x = INP(0); F.mem = INP(1); F.norm_mix = INP(3); F.w_in = INP(4); F.wd_up = INP(7); F.a_up = INP(9); F.g_up = INP(10); F.w_mix = INP(16); F.norm_mem = INP(18);
        F.norm_cross = INP(17); F.norm_mlp = INP(22); F.w_q = INP(19); F.w_kv = INP(20); F.w_o = INP(21); F.w_up = INP(23); F.w_dn = INP(24);
        F.WIN = WSP(WS_WIN); F.WMIX = WSP(WS_WMIX); F.WQ = WSP(WS_WQ); F.WKV = WSP(WS_WKV); F.WO = WSP(WS_WO); F.WUP = WSP(WS_WUP); F.WDN = WSP(WS_WDN); F.WL = WSP(WS_WL);
        F.XN = WSP(WS_XN); F.MEMN = WSP(WS_MEMN);
        p0_prologue(F, rep_ ? (PROBE_PH) - 99 : 3); } SEAM(0);
    REP(1) if (IN(1)) {
        F.XN = WSP(WS_XN); F.WIN = WSP(WS_WIN); F.P = WSP(WS_P); F.MEMN = WSP(WS_MEMN); F.WKV = WSP(WS_WKV); F.MEMKV = WSP(WS_MEMKV); F.pos = (const int*)INP(2);
        { Gemm g{F.XN, F.WIN, T, NP, DM}; StaticOrder S; S.init(T, NP, F.G, F.bid, WGM_P1); pg8::EpiP1 E{F.P, NP, F.pos};
#if PROBE_PH == 112
          if (rep_) { pg8::EpiNull EN{}; pg8::gemm_phase<pg8::EpiNull, StaticOrder, true, true>(F.lds, g, S, EN, F.wv); } else
#endif
          pg8::gemm_phase<pg8::EpiP1, StaticOrder, true, true>(F.lds, g, S, E, F.wv); }
    } SEAM(1);
    if (IN(2)) { F.P = WSP(WS_P); F.AL = WSP(WS_AL); F.pos = (const int*)INP(2); F.mu = INP(5); prep_phase(F); }
    { int t_ = F.wv * 64 + (int)__builtin_amdgcn_mbcnt_hi(~0u, __builtin_amdgcn_mbcnt_lo(~0u, 0u)); asm volatile("" : "+v"(t_)); F.tid = t_; F.lane = t_ & 63; F.wave = F.wv; }
    REP(3) if (IN(3)) {
        F.AL = WSP(WS_AL); F.WL = WSP(WS_WL); F.EWAG = (bf16*)F.out; F.w0 = INP(6); F.a0 = INP(8); F.P = WSP(WS_P); F.MASK = (unsigned*)WSP(WS_MASK);
#ifndef SKIP_IDX
#if PROBE_PH == 30
        { int nrep = 1 + (PROBE_VAR); asm volatile("" : "+s"(nrep)); for (int rp = 0; rp < nrep; ++rp) indexer_phase(F); }
#else
        indexer_phase(F);
#endif
#endif
        F.w_mix = INP(16); F.w_q = INP(19); F.w_kv = INP(20); F.w_o = INP(21); F.norm_cross = INP(17); F.mem = INP(1); F.norm_mem = INP(18); F.MEMN = WSP(WS_MEMN); F.WMIX = WSP(WS_WMIX); F.WQ = WSP(WS_WQ); F.WKV = WSP(WS_WKV); F.WO = WSP(WS_WO);
        { int t_ = F.wv * 64 + (int)__builtin_amdgcn_mbcnt_hi(~0u, __builtin_amdgcn_mbcnt_lo(~0u, 0u)); asm volatile("" : "+v"(t_)); F.tid = t_; F.lane = t_ & 63; F.wave = F.wv; }
        __syncthreads();
        { int t_ = F.wv * 64 + (int)__builtin_amdgcn_mbcnt_hi(~0u, __builtin_amdgcn_mbcnt_lo(~0u, 0u)); asm volatile("" : "+v"(t_)); F.tid = t_; F.lane = t_ & 63; F.wave = F.wv; }
        if (F.tid == 0) { unsigned spins = 0;
            while (__hip_atomic_load(F.ctl + CW_ALCNT, RLX_AGENT) < (unsigned)F.G) { __builtin_amdgcn_s_sleep(4); if (++spins > (1u << 22)) { __hip_atomic_store(F.ctl + CW_TMO, 1u, RLX_AGENT); break; } }
            __builtin_amdgcn_fence(__ATOMIC_ACQUIRE, "agent"); asm volatile("s_waitcnt vmcnt(0)" ::: "memory"); }
        __syncthreads();
#ifndef SKIP_LORA
        { int kl = 256; asm volatile("" : "+s"(kl)); Gemm g{F.AL, F.WL, T, NL, kl, KL, 8, 256}; StaticOrder S; S.init(T, NL, F.G, F.bid); pg8::EpiLora E{F.EWAG, NL, F.w0, F.a0};
          pg8::gemm_phase<pg8::EpiLora, StaticOrder, true, true>(F.lds, g, S, E, F.wv); }
#endif
        asm volatile("s_waitcnt vmcnt(0)" ::: "memory"); __syncthreads();
        { int t_ = F.wv * 64 + (int)__builtin_amdgcn_mbcnt_hi(~0u, __builtin_amdgcn_mbcnt_lo(~0u, 0u)); asm volatile("" : "+v"(t_)); F.tid = t_; F.lane = t_ & 63; F.wave = F.wv; }
        if (F.tid == 0) __hip_atomic_fetch_add(F.ctl + CW_P3CNT, 1u, RLX_AGENT);
        p3_weights(F);
        { int t_ = F.wv * 64 + (int)__builtin_amdgcn_mbcnt_hi(~0u, __builtin_amdgcn_mbcnt_lo(~0u, 0u)); asm volatile("" : "+v"(t_)); F.tid = t_; F.lane = t_ & 63; F.wave = F.wv; }
        if (F.tid == 0) { unsigned spins = 0;
            while (__hip_atomic_load(F.ctl + CW_P3CNT, RLX_AGENT) < (unsigned)F.G) { __builtin_amdgcn_s_sleep(4); if (++spins > (1u << 22)) { __hip_atomic_store(F.ctl + CW_TMO, 1u, RLX_AGENT); break; } }
            __builtin_amdgcn_fence(__ATOMIC_ACQUIRE, "agent"); asm volatile("s_waitcnt vmcnt(0)" ::: "memory"); }
        __syncthreads();
    }
    { int t_ = F.wv * 64 + (int)__builtin_amdgcn_mbcnt_hi(~0u, __builtin_amdgcn_mbcnt_lo(~0u, 0u)); asm volatile("" : "+v"(t_)); F.tid = t_; F.lane = t_ & 63; F.wave = F.wv; }

    REP(4) if (IN(4)) { F.w_dn = INP(24); F.WDN = WSP(WS_WDN); F.P = WSP(WS_P); F.EWAG = (bf16*)F.out; F.MASK = (unsigned*)WSP(WS_MASK); F.Y = WSP(WS_Y); F.mu = INP(5); F.k_k = INP(11); F.k_a = INP(12); F.r_k = INP(13);
        F.lnx_w = INP(14); F.lnx_b = INP(15); if (rep_) F.Y = WSP(WS_XN);
        mix_phase(F, CW_QUEUE + 64 * rep_, rep_ ? (PROBE_PH) - 39 : 0); } SEAM(4);
    if (IN(5)) { F.Y = WSP(WS_Y); F.WMIX = WSP(WS_WMIX); F.x = INP(0); F.XN = WSP(WS_XN); Gemm g{F.Y, F.WMIX, T, DM, DM}; StaticOrder S; S.init(T, DM, F.G, F.bid, WGM_P5); pg8::EpiResB<false, false> E{F.x, F.XN, DM, nullptr, (float*)(F.ctl + CW_SS1), 0.f, 0.f};
        pg8::gemm_phase<pg8::EpiResB<false, false>, StaticOrder, true, true>(F.lds, g, S, E, F.wv); } SEAM(5);
    if (IN(7)) { F.XN = WSP(WS_XN); F.WQ = WSP(WS_WQ); F.QC = WSP(WS_QC); Gemm g{F.XN, F.WQ, T, 512, DM}; StaticOrder S; S.init(T, 512, F.G, F.bid); pg8::EpiB16<0, true> E{F.QC, 512, (const float*)(F.ctl + CW_SS1), 1.f / DM, NORM_EPS};
        pg8::gemm_phase<pg8::EpiB16<0, true>, StaticOrder, true, true>(F.lds, g, S, E, F.wv);
        F.MEMN = WSP(WS_MEMN); F.WKV = WSP(WS_WKV); F.MEMKV = WSP(WS_MEMKV);
        { Gemm g{F.MEMN, F.WKV, TM, 1024, DM}; StaticOrder S; S.init(TM, 1024, F.G, (F.bid + F.G / 2) % F.G); pg8::EpiB16<0> E{F.MEMKV, 1024, nullptr, 0.f, 0.f};
          pg8::gemm_phase<pg8::EpiB16<0>, StaticOrder, true, true>(F.lds, g, S, E, F.wv); }
        F.w_up = INP(23); F.w_dn = INP(24); F.norm_mlp = INP(22); F.WUP = WSP(WS_WUP); F.WDN = WSP(WS_WDN);
        p7_mlp_weights(F, 160, F.G - 160);
    } SEAM(7);
    if (IN(8)) { F.QC = WSP(WS_QC); F.MEMKV = WSP(WS_MEMKV); F.OC = WSP(WS_OC); cross_phase(F); } SEAM(8);
    if (IN(9)) { F.OC = WSP(WS_OC); F.WO = WSP(WS_WO); int kl = 512; asm volatile("" : "+s"(kl)); F.XN = WSP(WS_XN); Gemm g{F.OC, F.WO, T, DM, kl}; StaticOrder S; S.init(T, DM, F.G, F.bid); pg8::EpiResB<true, false> E{nullptr, F.XN, DM, nullptr, (float*)(F.ctl + CW_SS2), 0.f, 0.f};
        pg8::gemm_phase<pg8::EpiResB<true, false>, StaticOrder, true, true>(F.lds, g, S, E, F.wv); } SEAM(9);
    REP(11) if (IN(11)) { F.XN = WSP(WS_XN); F.WUP = WSP(WS_WUP); F.ACT = WSP(WS_ACT); Gemm g{F.XN, F.WUP, T, DFF, DM}; StaticOrder S; S.init(T, DFF, F.G, F.bid, WGM_P11); pg8::EpiB16<2, false, true, true> E{F.ACT, DFF, nullptr, 0.f, 0.f};
        #if PROBE_PH == 110
        if (rep_) { pg8::EpiNull EN{}; pg8::gemm_phase<pg8::EpiNull, StaticOrder, true, true>(F.lds, g, S, EN, F.wv); } else
#endif
        pg8::gemm_phase<pg8::EpiB16<2, false, true, true>, StaticOrder, true, true>(F.lds, g, S, E, F.wv); } SEAM(11);
    if (IN(12)) { F.ACT = WSP(WS_ACT); F.WDN = WSP(WS_WDN); F.XN = WSP(WS_XN); F.norm_final = INP(25);
        Gemm g{F.ACT, F.WDN, T, DM, DFF}; pg8::PanelOrder S{F.bid};
        pg8::EpiFinal E{F.XN, DM, (const float*)(F.ctl + CW_SS2), (float*)(F.ctl + CW_SS3), F.ctl + CW_PCNT, F.norm_final, F.out, 1.f / DM, NORM_EPS, F.ctl + CW_TMO};
        pg8::gemm_phase<pg8::EpiFinal, pg8::PanelOrder, true, true, true>(F.lds, g, S, E, F.wv); }
#undef IN
#undef SEAM
}

extern "C" void kernel_launch(void* const* d_in, const int* in_sizes, int n_in, void* d_out, int out_size, void* d_ws, size_t ws_size, hipStream_t stream) {
    static int grid = 0;
    if (grid == 0) {
        if (n_in != 26 || in_sizes[0] != T * DM || out_size != T * DM || ws_size < WS_END) {
            fprintf(stderr, "kernel_launch: unexpected shapes: n_in %d in0 %d out %d ws %zu (need %zu)\n", n_in, n_in > 0 ? in_sizes[0] : -1, out_size, ws_size, (size_t)WS_END); grid = -1; return; }
        int dev = 0, cus = 0, per_cu = 0;
        if (hipGetDevice(&dev) != hipSuccess || hipDeviceGetAttribute(&cus, hipDeviceAttributeMultiprocessorCount, dev) != hipSuccess) { grid = -1; return; }
        if (hipFuncSetAttribute((const void*)mk_fwd, hipFuncAttributeMaxDynamicSharedMemorySize, LDS_BYTES) != hipSuccess) { fprintf(stderr, "kernel_launch: hipFuncSetAttribute failed\n"); grid = -1; return; }
        if (hipOccupancyMaxActiveBlocksPerMultiprocessor(&per_cu, (const void*)mk_fwd, NWAVES * 64, LDS_BYTES) != hipSuccess || per_cu < 1) { fprintf(stderr, "kernel_launch: occupancy query says %d\n", per_cu); per_cu = 1; }
        (void)hipGetLastError();
        grid = cus;
    }
    if (grid < 0) return;
    (void)hipMemsetAsync((char*)d_ws + WS_CTL, 0, CTL_ZERO_BYTES, stream);
    Args a{};
    for (int i = 0; i < 26; ++i) a.in[i] = d_in[i];
    a.out = (float*)d_out; a.ws = (unsigned char*)d_ws;
#if MK_ONE_LAUNCH
    a.ph_lo = 0; a.ph_hi = N_PHASES;
    void* kargs[] = {&a};
    hipError_t e = hipLaunchCooperativeKernel((const void*)mk_fwd, dim3(grid), dim3(NWAVES * 64), kargs, LDS_BYTES, stream);
    if (e != hipSuccess) fprintf(stderr, "kernel_launch: cooperative launch failed: %s (grid %d)\n", hipGetErrorString(e), grid);
#else
    for (int p = 0; p < N_PHASES; ++p) { a.ph_lo = p; a.ph_hi = p + 1; hipLaunchKernelGGL(mk_fwd, dim3(grid), dim3(NWAVES * 64), LDS_BYTES, stream, a); }
#endif
}
```
